# Optimizing an MI355X kernel written in HIP

```python
import jax, jax.numpy as jnp
from jax import lax
import numpy as np

D_MODEL = 1024
BATCH = 32
SEQ = 2048
DEPTH = 1

HEAD_DIM = 64
NSA_HEADS = 8
NSA_KV = 2
DSA_HEADS = 8
IDX_HEADS = 4
IDX_DIM = 64
CMP_LEN = 32
CMP_STRIDE = 16
CMP_HIDDEN = 2 * HEAD_DIM
SLC_LEN = 64
SLC_TOPN = 16
WIN = 512
DSA_TOPK = 256
D_FF = 4 * D_MODEL
D_MIX = (NSA_HEADS + DSA_HEADS) * HEAD_DIM
ROPE_THETA = 10000.0
EPS = 1e-6
Q_BLOCK = 128
SLC_Q_BLOCK = 16
NEG = -1e30
NSA_COLS = [NSA_HEADS * HEAD_DIM] + [NSA_KV * HEAD_DIM] * 6 + [NSA_HEADS * 3]
DSA_COLS = [DSA_HEADS * HEAD_DIM, HEAD_DIM, HEAD_DIM, IDX_HEADS * IDX_DIM, IDX_DIM, IDX_HEADS]
IN_COLS = NSA_COLS + DSA_COLS
D_IN = sum(IN_COLS)

kernel_name = 'hybrid_nsa_dsa_parallel_block'


def rms_norm(x, g):
    xf = x.astype(jnp.float32)
    y = xf * lax.rsqrt(jnp.mean(xf * xf, axis=-1, keepdims=True) + EPS)
    return (y * g.astype(jnp.float32)).astype(x.dtype)


def rope(x, pos):
    half = x.shape[-1] // 2
    inv = ROPE_THETA ** (-jnp.arange(half, dtype=jnp.float32) / half)
    ang = pos.astype(jnp.float32)[:, :, None] * inv
    cos = jnp.cos(ang)[:, :, None, :]
    sin = jnp.sin(ang)[:, :, None, :]
    xf = x.astype(jnp.float32)
    x1, x2 = xf[..., :half], xf[..., half:]
    return jnp.concatenate([x1 * cos - x2 * sin, x2 * cos + x1 * sin], axis=-1).astype(x.dtype)


def masked_softmax(s, mask):
    s = jnp.where(mask, s.astype(jnp.float32), NEG)
    return jax.nn.softmax(s, axis=-1) * mask.astype(jnp.float32)


def compress(kv, pe, w1, w2):
    B, T, G, dh = kv.shape
    n_cmp = (T - CMP_LEN) // CMP_STRIDE + 1
    blk = np.arange(n_cmp)[:, None] * CMP_STRIDE + np.arange(CMP_LEN)[None, :]
    blocks = kv[:, blk] + pe[None, None, :, None, :]
    flat = blocks.transpose(0, 1, 3, 2, 4).reshape(B, n_cmp, G, CMP_LEN * dh)
    return jax.nn.gelu(flat @ w1) @ w2


def nsa_attention(q, kc, vc, ks, vs, kw, vw, gate_logits, pe_k, pe_v, w1k, w2k, w1v, w2v):
    B, T, H, dh = q.shape
    G = kc.shape[2]
    R = H // G
    scale = dh ** -0.5
    q_t = q.reshape(B, T, G, R, dh).transpose(0, 2, 3, 1, 4)
    t_idx = np.arange(T)

    k_cmp = compress(kc, pe_k, w1k, w2k)
    v_cmp = compress(vc, pe_v, w1v, w2v)
    n_cmp = k_cmp.shape[1]
    cmp_start = np.arange(n_cmp) * CMP_STRIDE
    cmp_end = cmp_start + CMP_LEN - 1
    mask_c = jnp.asarray(cmp_end[None, :] <= t_idx[:, None])
    s_c = jnp.einsum('bgrtd,bngd->bgrtn', q_t, k_cmp) * scale
    p_c = masked_softmax(s_c, mask_c)
    o_cmp = jnp.einsum('bgrtn,bngd->bgrtd', p_c.astype(v_cmp.dtype), v_cmp)

    n_slc = T // SLC_LEN
    n_sel = min(SLC_TOPN, n_slc)
    slc_start = np.arange(n_slc) * SLC_LEN
    slc_end = slc_start + SLC_LEN - 1
    overlap = ((cmp_start[:, None] <= slc_end[None, :]) & (cmp_end[:, None] >= slc_start[None, :])).astype(np.float32)
    imp = jnp.einsum('bgrtn,nj->bgtj', p_c, jnp.asarray(overlap))
    j = np.arange(n_slc)[None, :]
    cur = (t_idx // SLC_LEN)[:, None]
    valid = jnp.asarray(j <= cur)
    forced = jnp.asarray((j == 0) | (j == cur) | (j == cur - 1))
    sel_score = jnp.where(valid, jnp.where(forced, jnp.inf, imp), -jnp.inf)
    _, sel = lax.top_k(sel_score, n_sel)

    kb = ks.reshape(B, n_slc, SLC_LEN, G, dh).transpose(0, 3, 1, 2, 4)
    vb = vs.reshape(B, n_slc, SLC_LEN, G, dh).transpose(0, 3, 1, 2, 4)
    nq = T // SLC_Q_BLOCK
    n_key = n_sel * SLC_LEN
    q_ch = q_t.reshape(B, G, R, nq, SLC_Q_BLOCK, dh).transpose(3, 0, 1, 2, 4, 5)
    i_ch = sel.reshape(B, G, nq, SLC_Q_BLOCK, n_sel).transpose(2, 0, 1, 3, 4)
    t_ch = jnp.arange(T, dtype=jnp.int32).reshape(nq, SLC_Q_BLOCK)
    bi = jnp.arange(B)[:, None, None, None]
    gi = jnp.arange(G)[None, :, None, None]

    def sel_chunk(args):
        qc, ic, tc = args
        kg = kb[bi, gi, ic].reshape(B, G, SLC_Q_BLOCK, n_key, dh)
        vg = vb[bi, gi, ic].reshape(B, G, SLC_Q_BLOCK, n_key, dh)
        kpos = (ic[..., None] * SLC_LEN + jnp.arange(SLC_LEN)).reshape(B, G, SLC_Q_BLOCK, n_key)
        mask = (kpos <= tc[None, None, :, None])[:, :, None]
        s = jnp.einsum('bgrqd,bgqkd->bgrqk', qc, kg) * scale
        p = masked_softmax(s, mask)
        return jnp.einsum('bgrqk,bgqkd->bgrqd', p.astype(vg.dtype), vg)

    o_slc = lax.map(sel_chunk, (q_ch, i_ch, t_ch))
    o_slc = o_slc.transpose(1, 2, 3, 0, 4, 5).reshape(B, G, R, T, dh)

    kp = jnp.pad(kw, ((0, 0), (WIN, 0), (0, 0), (0, 0)))
    vp = jnp.pad(vw, ((0, 0), (WIN, 0), (0, 0), (0, 0)))
    nb = T // Q_BLOCK
    span = WIN + Q_BLOCK
    q_b = q_t.reshape(B, G, R, nb, Q_BLOCK, dh).transpose(3, 0, 1, 2, 4, 5)

    def win_block(args):
        qb, bidx = args
        s0 = bidx * Q_BLOCK
        kk = lax.dynamic_slice_in_dim(kp, s0, span, axis=1)
        vv = lax.dynamic_slice_in_dim(vp, s0, span, axis=1)
        kpos = s0 - WIN + jnp.arange(span)
        tq = s0 + jnp.arange(Q_BLOCK)
        mask = (kpos[None, :] <= tq[:, None]) & (kpos[None, :] > tq[:, None] - WIN) & (kpos[None, :] >= 0)
        s = jnp.einsum('bgrqd,bsgd->bgrqs', qb, kk) * scale
        p = masked_softmax(s, mask)
        return jnp.einsum('bgrqs,bsgd->bgrqd', p.astype(vv.dtype), vv)

    o_win = lax.map(win_block, (q_b, jnp.arange(nb)))
    o_win = o_win.transpose(1, 2, 3, 0, 4, 5).reshape(B, G, R, T, dh)

    g = jax.nn.sigmoid(gate_logits.astype(jnp.float32)).reshape(B, T, G, R, 3)
    g = g.transpose(0, 2, 3, 1, 4).astype(q.dtype)
    o = g[..., 0:1] * o_cmp + g[..., 1:2] * o_slc + g[..., 2:3] * o_win
    return o.transpose(0, 3, 1, 2, 4).reshape(B, T, H * dh)


def dsa_attention(q, k, v, q_idx, k_idx, w_idx):
    B, T, H, dh = q.shape
    k_top = min(DSA_TOPK, T // 4)
    scale = dh ** -0.5
    idx_scale = (IDX_HEADS ** -0.5) * (IDX_DIM ** -0.5)
    nb = T // Q_BLOCK
    bi = jnp.arange(B)[:, None, None]
    key_pos = jnp.arange(T)

    def blocks(a):
        return a.reshape((B, nb, Q_BLOCK) + a.shape[2:]).swapaxes(0, 1)

    def dsa_block(args):
        qb, qib, wb, bidx = args
        tq = bidx * Q_BLOCK + jnp.arange(Q_BLOCK)
        logits = jnp.einsum('bqhd,bsd->bqhs', qib, k_idx).astype(jnp.float32)
        score = jnp.einsum('bqh,bqhs->bqs', wb.astype(jnp.float32) * idx_scale, jax.nn.relu(logits))
        score = jnp.where(key_pos[None, None, :] <= tq[None, :, None], score, -jnp.inf)
        _, sel = lax.top_k(score, k_top)
        kg = k[bi, sel]
        vg = v[bi, sel]
        mask = (sel <= tq[None, :, None])[:, None]
        s = jnp.einsum('bqhd,bqkd->bhqk', qb, kg) * scale
        p = masked_softmax(s, mask)
        return jnp.einsum('bhqk,bqkd->bqhd', p.astype(vg.dtype), vg)

    o = lax.map(dsa_block, (blocks(q), blocks(q_idx), blocks(w_idx), jnp.arange(nb)))
    return o.swapaxes(0, 1).reshape(B, T, H * dh)


def setup_inputs(seed: int = 0) -> dict:
    key = jax.random.key(seed)
    ks = jax.random.split(key, 20)

    def nrm(k, shape, s):
        return jax.random.normal(k, shape, jnp.float32) * s

    x = nrm(ks[0], (BATCH, SEQ, D_MODEL), 1.0)
    c = nrm(ks[1], (BATCH, D_MODEL), 1.0)
    start = jax.random.randint(ks[2], (BATCH, 1), 0, 4096, dtype=jnp.int32)
    positions = start + jnp.arange(SEQ, dtype=jnp.int32)[None, :]
    return {
        'x': x,
        'c': c,
        'positions': positions,
        'w_ada': nrm(ks[3], (DEPTH, D_MODEL, 6 * D_MODEL), 0.1 * D_MODEL ** -0.5),
        'b_ada': nrm(ks[4], (DEPTH, 6 * D_MODEL), 0.01),
        'g_pre_mix': 1.0 + nrm(ks[5], (DEPTH, D_MODEL), 0.05),
        'g_post_mix': 1.0 + nrm(ks[6], (DEPTH, D_MODEL), 0.05),
        'g_pre_ffn': 1.0 + nrm(ks[7], (DEPTH, D_MODEL), 0.05),
        'g_post_ffn': 1.0 + nrm(ks[8], (DEPTH, D_MODEL), 0.05),
        'w_in': nrm(ks[9], (DEPTH, D_MODEL, D_IN), D_MODEL ** -0.5),
        'cmp_pe_k': nrm(ks[10], (DEPTH, CMP_LEN, HEAD_DIM), 0.02),
        'cmp_pe_v': nrm(ks[11], (DEPTH, CMP_LEN, HEAD_DIM), 0.02),
        'cmp_w1_k': nrm(ks[12], (DEPTH, CMP_LEN * HEAD_DIM, CMP_HIDDEN), (CMP_LEN * HEAD_DIM) ** -0.5),
        'cmp_w2_k': nrm(ks[13], (DEPTH, CMP_HIDDEN, HEAD_DIM), CMP_HIDDEN ** -0.5),
        'cmp_w1_v': nrm(ks[14], (DEPTH, CMP_LEN * HEAD_DIM, CMP_HIDDEN), (CMP_LEN * HEAD_DIM) ** -0.5),
        'cmp_w2_v': nrm(ks[15], (DEPTH, CMP_HIDDEN, HEAD_DIM), CMP_HIDDEN ** -0.5),
        'w_out': nrm(ks[16], (DEPTH, D_MIX, D_MODEL), D_MIX ** -0.5),
        'w_up': nrm(ks[17], (DEPTH, D_MODEL, D_FF), D_MODEL ** -0.5),
        'w_down': nrm(ks[18], (DEPTH, D_FF, D_MODEL), D_FF ** -0.5),
    }


def reference(x, c, positions, w_ada, b_ada, g_pre_mix, g_post_mix, g_pre_ffn, g_post_ffn,
              w_in, cmp_pe_k, cmp_pe_v, cmp_w1_k, cmp_w2_k, cmp_w1_v, cmp_w2_v,
              w_out, w_up, w_down):
    B, T, _ = x.shape
    splits = np.cumsum(IN_COLS)[:-1].tolist()

    def heads(a, n):
        return a.reshape(B, T, n, -1)

    for l in range(DEPTH):
        mod = c @ w_ada[l] + b_ada[l]
        sh1, sc1, gt1, sh2, sc2, gt2 = jnp.split(mod, 6, axis=-1)

        h = rms_norm(x, g_pre_mix[l]) * (1.0 + sc1[:, None]) + sh1[:, None]
        proj = h @ w_in[l]
        (q_n, kc, vc, ksl, vsl, kw, vw, gl,
         q_d, k_d, v_d, qi, ki, wi) = jnp.split(proj, splits, axis=-1)

        o_nsa = nsa_attention(
            rope(heads(q_n, NSA_HEADS), positions),
            rope(heads(kc, NSA_KV), positions), heads(vc, NSA_KV),
            rope(heads(ksl, NSA_KV), positions), heads(vsl, NSA_KV),
            rope(heads(kw, NSA_KV), positions), heads(vw, NSA_KV),
            gl, cmp_pe_k[l], cmp_pe_v[l], cmp_w1_k[l], cmp_w2_k[l], cmp_w1_v[l], cmp_w2_v[l])

        o_dsa = dsa_attention(
            rope(heads(q_d, DSA_HEADS), positions),
            rope(k_d[:, :, None, :], positions)[:, :, 0],
            v_d,
            rope(heads(qi, IDX_HEADS), positions),
            rope(ki[:, :, None, :], positions)[:, :, 0],
            wi)

        o = jnp.concatenate([o_nsa, o_dsa], axis=-1) @ w_out[l]
        x = x + gt1[:, None] * rms_norm(o, g_post_mix[l])

        h = rms_norm(x, g_pre_ffn[l]) * (1.0 + sc2[:, None]) + sh2[:, None]
        y = jnp.square(jax.nn.relu(h @ w_up[l])) @ w_down[l]
        x = x + gt2[:, None] * rms_norm(y, g_post_ffn[l])
    return x
```

```cpp
#include <hip/hip_runtime.h>
#include <hip/hip_cooperative_groups.h>
#include <cstdio>
#include <cstdint>
namespace cg = cooperative_groups;
#define DI __device__ __forceinline__
namespace pg8 {
#define PG8_LAS __attribute__((address_space(3)))
typedef unsigned short bf16_t;
typedef short bf16x8 __attribute__((ext_vector_type(8)));
typedef float f32x4 __attribute__((ext_vector_type(4)));
typedef unsigned u32x4 __attribute__((ext_vector_type(4)));
constexpr int BM = 256, BK = 64, HALF = 128, HTB = HALF * BK * 2  , STAGE_BYTES = 8 * HTB, NXCD = 8, WGM = 8;

__host__ __device__ __forceinline__ int lds_byte(int r, int c) { const int st = (r >> 4) * 2 + (c >> 5), rr = r & 15, cc = c & 31, ob = rr * 64 + cc * 2; return st * 1024 + (ob ^ (((ob >> 9) & 1) << 5)); }
__host__ __device__ __forceinline__ void stage_rc(int b, int& R, int& C) { const int st = b / 1024, sb = b % 1024, swz = sb ^ (((sb >> 9) & 1) << 5); R = (st >> 1) * 16 + swz / 64; C = (st & 1) * 32 + (swz % 64) / 2; }
__host__ __device__ __forceinline__ int perm32(int rho) { const int n = rho >> 4, i = rho & 15; return 8 * (i >> 2) + 4 * n + (i & 3); }

struct Unit { int pm, pn; };
struct Gemm { const bf16_t* A; const bf16_t* Bt; int M, N, K; };

struct StaticOrder {
    int nM, nN, nwg, G, c;
    __host__ __device__ void init(int M, int N, int G_, int c_) { nM = M / BM; nN = N / BM; nwg = nM * nN; G = G_; c = c_; }
    __host__ __device__ bool next(int i, Unit& u) const {
        const long L = (long)i * G + c; if (L >= nwg) return false;
        int wgid = (int)L; { const int q = nwg / NXCD, r = nwg % NXCD, xcd = wgid % NXCD, off = wgid / NXCD; wgid = (xcd < r ? xcd * (q + 1) : r * (q + 1) + (xcd - r) * q) + off; }
        const int nig = WGM * nN, gid = wgid / nig, fm = gid * WGM, gsz = (nM - fm) < WGM ? (nM - fm) : WGM;
        u.pm = fm + ((wgid % nig) % gsz); u.pn = (wgid % nig) / gsz; return true;
    }
    __device__ __forceinline__ void a_ready(const Unit&) const {}
    __device__ __forceinline__ void done(const Unit&) const {}
};


typedef float f32x2 __attribute__((ext_vector_type(2)));
typedef unsigned u32x2 __attribute__((ext_vector_type(2)));
typedef __bf16 bf16x2_t __attribute__((ext_vector_type(2)));
__device__ __forceinline__ unsigned cvt_pk_bf16(float lo, float hi) { f32x2 v = {lo, hi}; bf16x2_t b = __builtin_convertvector(v, bf16x2_t); return __builtin_bit_cast(unsigned, b); }

template <int ACT  > struct EpiStore {
    static constexpr bool PERM = true, AFTER_DRAIN = false;
    bf16_t* O; int ldc;
    __device__ __forceinline__ void operator()(const f32x4 (&acc)[2][2][4][2], const Unit& u, int wr, int wc, int fr, int fq) const {
        const int row0 = u.pm * BM + wr * 64 + fr; const int col0 = u.pn * BM + wc * 32 + 8 * fq;
#pragma unroll
        for (int ai = 0; ai < 2; ++ai)
#pragma unroll
            for (int m = 0; m < 4; ++m) { bf16_t* rowp = O + (size_t)(row0 + ai * HALF + m * 16) * ldc + col0;
#pragma unroll
                for (int bj = 0; bj < 2; ++bj) { f32x4 v0 = acc[ai][bj][m][0], v1 = acc[ai][bj][m][1];
                    if (ACT == 1) {
#pragma unroll
                        for (int i = 0; i < 4; ++i) { const float a = v0[i] > 0.f ? v0[i] : 0.f, b = v1[i] > 0.f ? v1[i] : 0.f; v0[i] = a * a; v1[i] = b * b; } }
                    u32x4 w; w.x = cvt_pk_bf16(v0[0], v0[1]); w.y = cvt_pk_bf16(v0[2], v0[3]); w.z = cvt_pk_bf16(v1[0], v1[1]); w.w = cvt_pk_bf16(v1[2], v1[3]);
                    *(u32x4*)(rowp + bj * HALF) = w; } }
    }
};

struct EpiProj {
    static constexpr bool PERM = true, AFTER_DRAIN = false;
    bf16_t* P; float* MISC; const float* CS;
    __device__ __forceinline__ void operator()(const f32x4 (&acc)[2][2][4][2], const Unit& u, int wr, int wc, int fr, int fq) const {
        const int row0 = u.pm * BM + wr * 64 + fr; const int qd = 4 * (wc & 1) + fq;
        constexpr unsigned long long ROPE_MASK = 0x00000007DFF333FFull;
        constexpr float QSCALE = 0.125f * 1.4426950408889634f;
#pragma unroll
        for (int ai = 0; ai < 2; ++ai)
#pragma unroll
            for (int m = 0; m < 4; ++m) {
                const int row = row0 + ai * HALF + m * 16;
                const f32x4 c01 = *(const f32x4*)(CS + (size_t)row * 64 + 8 * qd), c23 = *(const f32x4*)(CS + (size_t)row * 64 + 8 * qd + 4);
                const float cs[4] = {c01[0], c01[2], c23[0], c23[2]}, sn[4] = {c01[1], c01[3], c23[1], c23[3]};
#pragma unroll
                for (int bj = 0; bj < 2; ++bj) {
                    const int hb = u.pn * 4 + bj * 2 + (wc >> 1);
                    const f32x4 v0 = acc[ai][bj][m][0], v1 = acc[ai][bj][m][1];
                    if (hb == 35) {
                        if (qd < 4) { *(f32x4*)(MISC + (size_t)row * 32 + 8 * qd) = v0; *(f32x4*)(MISC + (size_t)row * 32 + 8 * qd + 4) = v1; }
                    } else if ((ROPE_MASK >> hb) & 1ull) {
                        const float sc = (hb < 8 || (hb >= 20 && hb < 28)) ? QSCALE : 1.0f;
                        float o1[4], o2[4];
#pragma unroll
                        for (int i = 0; i < 4; ++i) { o1[i] = (v0[i] * cs[i] - v1[i] * sn[i]) * sc; o2[i] = (v1[i] * cs[i] + v0[i] * sn[i]) * sc; }
                        bf16_t* rp = P + (size_t)row * 2304 + hb * 64 + 4 * qd;
                        u32x2 a, b; a.x = cvt_pk_bf16(o1[0], o1[1]); a.y = cvt_pk_bf16(o1[2], o1[3]); b.x = cvt_pk_bf16(o2[0], o2[1]); b.y = cvt_pk_bf16(o2[2], o2[3]);
                        *(u32x2*)rp = a; *(u32x2*)(rp + 32) = b;
                    } else {
                        u32x4 w; w.x = cvt_pk_bf16(v0[0], v0[1]); w.y = cvt_pk_bf16(v0[2], v0[3]); w.z = cvt_pk_bf16(v1[0], v1[1]); w.w = cvt_pk_bf16(v1[2], v1[3]);
                        *(u32x4*)(P + (size_t)row * 2304 + hb * 64 + 8 * qd) = w;
                    }
                }
            }
    }
};
template <class Epi, class Sched, bool ALIGN_EPI = false, bool SP2 = false>
__device__ __forceinline__ void gemm_phase(PG8_LAS unsigned char* lds, const Gemm g, const Sched& S, const Epi& E) {
    const int tid = threadIdx.x, wid = __builtin_amdgcn_readfirstlane(tid >> 6), lane = tid & 63, wr = wid >> 2, wc = wid & 3, fr = lane & 15, fq = lane >> 4;
    const int K = g.K, nt = K / BK;
    unsigned voffA[2], voffB[2];
#pragma unroll
    for (int i = 0; i < 2; ++i) { int R, C; stage_rc(tid * 16 + i * 8192, R, C); const int Rb = Epi::PERM ? ((R & ~31) + perm32(R & 31)) : R;
        voffA[i] = (unsigned)(R * K + C) * 2u; voffB[i] = (unsigned)(Rb * K + C) * 2u; }
    const size_t kstep = (size_t)(BK * 2);
    const size_t hstep = (size_t)HALF * K * 2;
    const size_t tstep = 2 * hstep;
    const unsigned ldsw = (unsigned)wid * 1024u;
    const int aoff = lds_byte(wr * 64 + fr, fq * 8), boff = lds_byte(wc * 32 + fr, fq * 8);
#define PG8_SA(b, h) (((b) * 2 + (h)) * HTB)
#define PG8_SB(b, h) ((4 + (b) * 2 + (h)) * HTB)
#define PG8_STAGE(bufoff, gbase, voff) do { _Pragma("unroll") for (int _i = 0; _i < 2; ++_i) \
        __builtin_amdgcn_global_load_lds((const unsigned*)((const char*)(gbase) + (voff)[_i]), (PG8_LAS unsigned*)(lds + (bufoff) + ldsw + _i * 8192), 16, 0, 0); } while (0)
#define PG8_LDA(dst, b, h) do { _Pragma("unroll") for (int m = 0; m < 4; ++m) _Pragma("unroll") for (int k = 0; k < 2; ++k) dst[m][k] = *(const PG8_LAS bf16x8*)(lds + PG8_SA(b, h) + aoff + m * 2048 + k * 1024); } while (0)
#define PG8_LDB(dst, b, h) do { _Pragma("unroll") for (int n = 0; n < 2; ++n) _Pragma("unroll") for (int k = 0; k < 2; ++k) dst[n][k] = *(const PG8_LAS bf16x8*)(lds + PG8_SB(b, h) + boff + n * 2048 + k * 1024); } while (0)
#define PG8_MMA(ai, bj, At, Bt) do { __builtin_amdgcn_s_setprio(1); _Pragma("unroll") for (int m = 0; m < 4; ++m) _Pragma("unroll") for (int n = 0; n < 2; ++n) _Pragma("unroll") for (int k = 0; k < 2; ++k) \
        acc[ai][bj][m][n] = __builtin_amdgcn_mfma_f32_16x16x32_bf16(Bt[n][k], At[m][k], acc[ai][bj][m][n], 0, 0, 0); __builtin_amdgcn_s_setprio(0); } while (0)
#define PG8_WAIT_V(n) asm volatile("s_waitcnt vmcnt(" #n ")" ::: "memory")
#define PG8_WAIT_L(n) asm volatile("s_waitcnt lgkmcnt(" #n ")" ::: "memory")
#define PG8_BAR __builtin_amdgcn_s_barrier()
#define PG8_SCHED __builtin_amdgcn_sched_barrier(0)
    Unit cur, nxt; int ui = 0;
    if (!S.next(0, cur)) return;
    f32x4 acc[2][2][4][2];
#pragma unroll
    for (int a = 0; a < 2; ++a)
#pragma unroll
        for (int b = 0; b < 2; ++b)
#pragma unroll
            for (int m = 0; m < 4; ++m)
#pragma unroll
                for (int n = 0; n < 2; ++n) acc[a][b][m][n] = (f32x4){0.f, 0.f, 0.f, 0.f};
    bf16x8 At[4][2], B0[2][2], B1[2][2];
    const char* cA = (const char*)g.A + (size_t)cur.pm * tstep; const char* cB = (const char*)g.Bt + (size_t)cur.pn * tstep;
    S.a_ready(cur);
    if constexpr (SP2) {
        PG8_STAGE(PG8_SB(0, 0), cB, voffB); PG8_STAGE(PG8_SB(0, 1), cB + hstep, voffB); PG8_STAGE(PG8_SA(0, 0), cA, voffA); PG8_STAGE(PG8_SA(0, 1), cA + hstep, voffA);
        if (wr == 1) PG8_BAR;
        PG8_WAIT_V(2); PG8_BAR;
        PG8_STAGE(PG8_SB(1, 0), cB + kstep, voffB); PG8_STAGE(PG8_SA(1, 0), cA + kstep, voffA); PG8_STAGE(PG8_SB(1, 1), cB + hstep + kstep, voffB);
        PG8_WAIT_V(6); PG8_BAR;
    } else {
        PG8_STAGE(PG8_SB(0, 0), cB, voffB); PG8_STAGE(PG8_SA(0, 0), cA, voffA); PG8_STAGE(PG8_SB(0, 1), cB + hstep, voffB); PG8_STAGE(PG8_SA(0, 1), cA + hstep, voffA);
        if (wr == 1) PG8_BAR;
        PG8_WAIT_V(4); PG8_BAR;
        PG8_STAGE(PG8_SB(1, 0), cB + kstep, voffB); PG8_STAGE(PG8_SA(1, 0), cA + kstep, voffA); PG8_STAGE(PG8_SB(1, 1), cB + hstep + kstep, voffB);
        PG8_WAIT_V(6); PG8_BAR;
    }
    for (;;) {
        const bool has_next = S.next(ui + 1, nxt);
        const char* nA = has_next ? (const char*)g.A + (size_t)nxt.pm * tstep : cA; const char* nB = has_next ? (const char*)g.Bt + (size_t)nxt.pn * tstep : cB;
        for (int t = 0; t < nt; t += 2) {
            const bool last = (t == nt - 2);
            const char* a1 = cA + (size_t)(t + 1) * kstep;
            const char* a2 = last ? nA : cA + (size_t)(t + 2) * kstep; const char* b2 = last ? nB : cB + (size_t)(t + 2) * kstep;
            const char* a3 = a2 + kstep; const char* b3 = b2 + kstep;
            if (last && has_next) S.a_ready(nxt);
            if constexpr (SP2) {
            PG8_LDB(B0, 0, 0); PG8_LDB(B1, 0, 1); PG8_SCHED; PG8_LDA(At, 0, 0); PG8_STAGE(PG8_SA(1, 1), a1 + hstep, voffA);
            PG8_WAIT_V(8); PG8_WAIT_L(0); PG8_BAR; PG8_MMA(0, 0, At, B0); PG8_MMA(0, 1, At, B1); PG8_BAR; PG8_SCHED;
            PG8_LDA(At, 0, 1); PG8_STAGE(PG8_SB(0, 0), b2, voffB); PG8_STAGE(PG8_SB(0, 1), b2 + hstep, voffB); PG8_STAGE(PG8_SA(0, 0), a2, voffA);
            PG8_WAIT_V(8); PG8_WAIT_L(0); PG8_BAR; PG8_MMA(1, 0, At, B0); PG8_MMA(1, 1, At, B1); PG8_BAR; PG8_SCHED;
            PG8_LDB(B0, 1, 0); PG8_LDB(B1, 1, 1); PG8_SCHED; PG8_LDA(At, 1, 0); PG8_STAGE(PG8_SA(0, 1), a2 + hstep, voffA);
            PG8_WAIT_V(8); PG8_WAIT_L(0); PG8_BAR; PG8_MMA(0, 0, At, B0); PG8_MMA(0, 1, At, B1); PG8_BAR; PG8_SCHED;
            PG8_LDA(At, 1, 1); PG8_STAGE(PG8_SB(1, 0), b3, voffB); PG8_STAGE(PG8_SB(1, 1), b3 + hstep, voffB); PG8_STAGE(PG8_SA(1, 0), a3, voffA);
            PG8_WAIT_V(8); PG8_WAIT_L(0); PG8_BAR; PG8_MMA(1, 0, At, B0); PG8_MMA(1, 1, At, B1); PG8_BAR; PG8_SCHED;
            } else {
            PG8_LDB(B0, 0, 0); PG8_SCHED; PG8_LDA(At, 0, 0); PG8_STAGE(PG8_SA(1, 1), a1 + hstep, voffA);
            PG8_WAIT_L(8); PG8_BAR; PG8_WAIT_L(0); PG8_MMA(0, 0, At, B0); PG8_BAR; PG8_SCHED;
            PG8_LDB(B1, 0, 1); PG8_STAGE(PG8_SB(0, 0), b2, voffB);
            PG8_BAR; PG8_WAIT_L(0); PG8_MMA(0, 1, At, B1); PG8_BAR;
            PG8_LDA(At, 0, 1); PG8_STAGE(PG8_SA(0, 0), a2, voffA);
            PG8_BAR; PG8_WAIT_L(0); PG8_MMA(1, 0, At, B0); PG8_BAR; PG8_SCHED;
            PG8_STAGE(PG8_SB(0, 1), b2 + hstep, voffB);
            PG8_WAIT_V(6); PG8_BAR; PG8_MMA(1, 1, At, B1); PG8_BAR;
            PG8_LDB(B0, 1, 0); PG8_SCHED; PG8_LDA(At, 1, 0); PG8_STAGE(PG8_SA(0, 1), a2 + hstep, voffA);
            PG8_WAIT_L(8); PG8_BAR; PG8_WAIT_L(0); PG8_MMA(0, 0, At, B0); PG8_BAR; PG8_SCHED;
            PG8_LDB(B1, 1, 1); PG8_STAGE(PG8_SB(1, 0), b3, voffB);
            PG8_BAR; PG8_WAIT_L(0); PG8_MMA(0, 1, At, B1); PG8_BAR;
            PG8_LDA(At, 1, 1); PG8_STAGE(PG8_SA(1, 0), a3, voffA);
            PG8_BAR; PG8_WAIT_L(0); PG8_MMA(1, 0, At, B0); PG8_BAR; PG8_SCHED;
            PG8_STAGE(PG8_SB(1, 1), b3 + hstep, voffB);
            PG8_WAIT_V(6); PG8_BAR; PG8_MMA(1, 1, At, B1); PG8_BAR;
            }
        }
        if constexpr (ALIGN_EPI) { if (wr == 0) PG8_BAR; }
        if constexpr (!Epi::AFTER_DRAIN) { E(acc, cur, wr, wc, fr, fq); S.done(cur); }
        if (!has_next) break;
#pragma unroll
        for (int a = 0; a < 2; ++a)
#pragma unroll
            for (int b = 0; b < 2; ++b)
#pragma unroll
                for (int m = 0; m < 4; ++m)
#pragma unroll
                    for (int n = 0; n < 2; ++n) acc[a][b][m][n] = (f32x4){0.f, 0.f, 0.f, 0.f};
        cur = nxt; cA = nA; cB = nB; ++ui;
        if constexpr (ALIGN_EPI) { if (wr == 1) PG8_BAR; }
    }
    PG8_WAIT_V(0);
    if constexpr (!ALIGN_EPI) { if (wr == 0) PG8_BAR; }
    PG8_BAR;
    if constexpr (Epi::AFTER_DRAIN) { E.fused(acc, cur, wr, wc, fr, fq, lds, wid, lane); S.done(cur); }
#undef PG8_SA
#undef PG8_SB
#undef PG8_STAGE
#undef PG8_LDA
#undef PG8_LDB
#undef PG8_MMA
#undef PG8_WAIT_V
#undef PG8_WAIT_L
#undef PG8_BAR
#undef PG8_SCHED
}
}

constexpr int NB = 32, T = 2048, D = 1024, M = NB * T, FF = 4096, NPROJ = 2304, PP = NPROJ;
constexpr int HB_QN = 0, HB_KC = 8, HB_VC = 10, HB_KSL = 12, HB_VSL = 14, HB_KW = 16, HB_VW = 18, HB_QD = 20, HB_KD = 28, HB_VD = 29, HB_QI = 30, HB_KI = 34, HB_MISC = 35;
constexpr int NWAVES = 8, NTHR = 512;
constexpr float RMS_EPS = 1e-6f;

constexpr size_t MiB = 1u << 20;
constexpr size_t WS_CTL = 0, CTL_ZERO_BYTES = 64 * 1024;
constexpr size_t WS_MOD = 1 * MiB;
constexpr size_t WS_BIASC = 1 * MiB + 800 * 1024;
constexpr size_t WS_CS = 2 * MiB;
constexpr size_t WS_WIN = 18 * MiB;
constexpr size_t WS_WOUT = 23 * MiB;
constexpr size_t WS_WUP = 25 * MiB;
constexpr size_t WS_WDOWN = 33 * MiB;
constexpr size_t WS_W1K = 41 * MiB, WS_W1V = 41 * MiB + 512 * 1024;
constexpr size_t WS_W2K = 42 * MiB, WS_W2V = 42 * MiB + 64 * 1024;
constexpr size_t WS_KCMP = 43 * MiB, WS_VCMP = 44 * MiB;
constexpr size_t WS_MISC = 45 * MiB;
constexpr size_t WS_XN = 64 * MiB;
constexpr size_t WS_P = 192 * MiB;
constexpr size_t WS_SC = 480 * MiB;
constexpr size_t WS_END = 992 * MiB;
constexpr int SC_TILES_PER_B = 528;

constexpr int RING_BYTES = 131072;
constexpr int MISC_OFF = RING_BYTES + 320;
constexpr int LDS_BYTES = 147456;

#define LAS __attribute__((address_space(3)))
typedef unsigned short bf16;
typedef short bf16x8 __attribute__((ext_vector_type(8)));
typedef short s16x4 __attribute__((ext_vector_type(4)));
typedef float f32x4 __attribute__((ext_vector_type(4)));
typedef float f32x16 __attribute__((ext_vector_type(16)));
typedef unsigned u32x4 __attribute__((ext_vector_type(4)));
typedef unsigned u32x2 __attribute__((ext_vector_type(2)));
typedef unsigned long long u64;
#define MFMA32(a, b, c) __builtin_amdgcn_mfma_f32_32x32x16_bf16((a), (b), (c), 0, 0, 0)
#define LDS_WAIT() asm volatile("s_waitcnt lgkmcnt(0)" ::: "memory")

DI unsigned pk2(float lo, float hi) { return pg8::cvt_pk_bf16(lo, hi); }
DI float bf2f(unsigned short v) { return __uint_as_float((unsigned)v << 16); }
DI int crow(int r, int hi) { return (r & 3) + 8 * (r >> 2) + 4 * hi; }
DI float wave_sum(float v) {
#pragma unroll
    for (int o = 1; o < 64; o <<= 1) v += __shfl_xor(v, o);
    return v;
}
DI int launder(int x) { asm volatile("" : "+v"(x)); return x; }
DI float fast_exp2(float x) { return __builtin_amdgcn_exp2f(x); }
DI float gelu_tanh(float x) {
    const float u = 0.7978845608028654f * (x + 0.044715f * x * x * x);
    const float e = __expf(2.0f * u);
    const float th = 1.0f - 2.0f / (e + 1.0f);
    return 0.5f * x * (1.0f + th);
}

struct Frame {
    LAS unsigned char* lds;
    volatile LAS unsigned* MISC;
    unsigned char* ws;
    int tid, lane, wave, G, bid;
};
struct Args { const void* in[19]; float* out; unsigned char* ws; int ph_lo, ph_hi, coop, pad; };
#define WSP(type, off) ((type*)(F.ws + (off)))
#define INP(type, i) ((const type*)A.in[i])

DI int q_next(Frame& F, unsigned* ctr) {
    __syncthreads();
    if (F.tid == 0) F.MISC[0] = __hip_atomic_fetch_add(ctr, 1u, __ATOMIC_RELAXED, __HIP_MEMORY_SCOPE_AGENT);
    __syncthreads();
    return (int)F.MISC[0];
}

DI int proj_src_col(int n) {
    const int hb = n >> 6, p = n & 63;
    if (hb == 35) return p < 24 ? 1280 + p : (p < 28 ? 2264 + (p - 24) : -1);
    const int base = hb < 20 ? 64 * hb : 1304 + 64 * (hb - 20);
    constexpr u64 ROPE_MASK = 0x00000007DFF333FFull;
    int d = p;
    if ((ROPE_MASK >> hb) & 1ull) { const int q = p >> 3, i = p & 7; d = i < 4 ? 4 * q + i : 32 + 4 * q + (i - 4); }
    return base + d;
}
template <bool PERMUTE> DI void transpose_item(const float* W, int ldw, int K, int N, bf16* WT, LAS float* scr, int item, int lane) {
    const int nblk = N / 32, kb = item / nblk, nb = item % nblk, k0 = 64 * kb, n0 = 32 * nb;
    const int ncol = n0 + (lane & 31); const int src = PERMUTE ? proj_src_col(ncol) : ncol;
#pragma unroll 8
    for (int i = 0; i < 32; ++i) { const int kk = 2 * i + (lane >> 5); scr[kk * 33 + (lane & 31)] = src >= 0 ? W[(size_t)(k0 + kk) * ldw + src] : 0.f; }
    LDS_WAIT();
    const int cch = lane & 7;
#pragma unroll
    for (int j = 0; j < 4; ++j) { const int n = (lane >> 3) + 8 * j; const LAS float* s = scr + (8 * cch) * 33 + n;
        u32x4 o; o.x = pk2(s[0 * 33], s[1 * 33]); o.y = pk2(s[2 * 33], s[3 * 33]); o.z = pk2(s[4 * 33], s[5 * 33]); o.w = pk2(s[6 * 33], s[7 * 33]);
        *(u32x4*)(WT + (size_t)(n0 + n) * K + k0 + 8 * cch) = o; }
    LDS_WAIT();
}
DI void phase_p0(Frame& F, const Args& A) {
    LAS float* scr = (LAS float*)(F.lds + F.wave * 16384);
    const int gw = F.bid * NWAVES + F.wave, NGW = F.G * NWAVES;
    constexpr int I_IN = (D / 64) * (NPROJ / 32), I_OUT = (D / 64) * (D / 32), I_UP = (D / 64) * (FF / 32), I_DN = (FF / 64) * (D / 32), I_W1 = (2048 / 64) * (128 / 32), I_W2 = (128 / 64) * (64 / 32);
    constexpr int NITEMS = I_IN + I_OUT + I_UP + I_DN + 2 * I_W1 + 2 * I_W2;
    for (int it = gw; it < NITEMS; it += NGW) {
        int r = it;
        if (r < I_IN) { transpose_item<true>(INP(float, 9), 2268, D, NPROJ, WSP(bf16, WS_WIN), scr, r, F.lane); continue; } r -= I_IN;
        if (r < I_OUT) { transpose_item<false>(INP(float, 16), D, D, D, WSP(bf16, WS_WOUT), scr, r, F.lane); continue; } r -= I_OUT;
        if (r < I_UP) { transpose_item<false>(INP(float, 17), FF, D, FF, WSP(bf16, WS_WUP), scr, r, F.lane); continue; } r -= I_UP;
        if (r < I_DN) { transpose_item<false>(INP(float, 18), D, FF, D, WSP(bf16, WS_WDOWN), scr, r, F.lane); continue; } r -= I_DN;
        if (r < I_W1) { transpose_item<false>(INP(float, 12), 128, 2048, 128, WSP(bf16, WS_W1K), scr, r, F.lane); continue; } r -= I_W1;
        if (r < I_W1) { transpose_item<false>(INP(float, 14), 128, 2048, 128, WSP(bf16, WS_W1V), scr, r, F.lane); continue; } r -= I_W1;
        if (r < I_W2) { transpose_item<false>(INP(float, 13), 64, 128, 64, WSP(bf16, WS_W2K), scr, r, F.lane); continue; } r -= I_W2;
        transpose_item<false>(INP(float, 15), 64, 128, 64, WSP(bf16, WS_W2V), scr, r, F.lane);
    }
    const int gt = F.bid * NTHR + F.tid, NGT = F.G * NTHR;
    for (int idx = gt; idx < NB * 6 * D; idx += NGT) {
        const int b = idx / (6 * D), j = idx % (6 * D);
        const float* cb = INP(float, 1) + b * D; const float* wp = INP(float, 3) + j;
        float a0 = 0.f, a1 = 0.f, a2 = 0.f, a3 = 0.f;
#pragma unroll 4
        for (int k = 0; k < D; k += 4) {
            a0 = fmaf(cb[k], wp[(size_t)k * (6 * D)], a0); a1 = fmaf(cb[k + 1], wp[(size_t)(k + 1) * (6 * D)], a1);
            a2 = fmaf(cb[k + 2], wp[(size_t)(k + 2) * (6 * D)], a2); a3 = fmaf(cb[k + 3], wp[(size_t)(k + 3) * (6 * D)], a3);
        }
        WSP(float, WS_MOD)[idx] = INP(float, 4)[j] + ((a0 + a1) + (a2 + a3));
    }
    for (int idx = gt; idx < M * 32; idx += NGT) {
        const int m = idx >> 5, d = idx & 31;
        const float inv = powf(10000.0f, -(float)d / 32.0f);
        const float ang = (float)INP(int, 2)[m] * inv;
        WSP(float, WS_CS)[2 * (size_t)idx] = cosf(ang); WSP(float, WS_CS)[2 * (size_t)idx + 1] = sinf(ang);
    }
    if (gw < 4) {
        const int kv = gw >> 1, j = (gw & 1) * 64 + F.lane;
        const float* pe = kv ? INP(float, 11) : INP(float, 10); const float* w1 = kv ? INP(float, 14) : INP(float, 12);
        float a0 = 0.f, a1 = 0.f;
#pragma unroll 4
        for (int k = 0; k < 2048; k += 2) { a0 = fmaf(pe[k], w1[(size_t)k * 128 + j], a0); a1 = fmaf(pe[k + 1], w1[(size_t)(k + 1) * 128 + j], a1); }
        WSP(float, WS_BIASC)[kv * 128 + j] = a0 + a1;
    }
}

DI void phase_e0(Frame& F, const Args& A) {
    const int gw = F.bid * NWAVES + F.wave, NGW = F.G * NWAVES;
    const int per = (M + NGW - 1) / NGW; const int r0 = gw * per, r1 = (r0 + per < M) ? r0 + per : M;
    for (int m = r0; m < r1; ++m) {
        const int b = m / T;
        const f32x4* xr = (const f32x4*)(INP(float, 0) + (size_t)m * D) + F.lane;
        const float* mod = WSP(float, WS_MOD) + (size_t)b * 6 * D;
        f32x4 v[4]; float s = 0.f;
#pragma unroll
        for (int j = 0; j < 4; ++j) { v[j] = xr[64 * j]; s += (v[j].x * v[j].x + v[j].y * v[j].y) + (v[j].z * v[j].z + v[j].w * v[j].w); }
        const float rstd = 1.0f / sqrtf(wave_sum(s) * (1.0f / D) + RMS_EPS);
        u64* o8 = (u64*)(WSP(bf16, WS_XN) + (size_t)m * D) + F.lane;
#pragma unroll
        for (int j = 0; j < 4; ++j) {
            const int col = 4 * F.lane + 256 * j;
            const f32x4 g = *(const f32x4*)(INP(float, 5) + col), sc = *(const f32x4*)(mod + D + col), sh = *(const f32x4*)(mod + col);
            const f32x4 h = v[j] * rstd * g * (sc + 1.0f) + sh;
            o8[64 * j] = (u64)pk2(h.x, h.y) | ((u64)pk2(h.z, h.w) << 32);
        }
    }
}

DI void phase_e1(Frame& F, const Args& A, const bf16* OPROJ) {
    const int gw = F.bid * NWAVES + F.wave, NGW = F.G * NWAVES;
    const int per = (M + NGW - 1) / NGW; const int r0 = gw * per, r1 = (r0 + per < M) ? r0 + per : M;
    for (int m = r0; m < r1; ++m) {
        const int b = m / T;
        const f32x4* xr = (const f32x4*)(INP(float, 0) + (size_t)m * D) + F.lane;
        const u64* orow = (const u64*)(OPROJ + (size_t)m * D) + F.lane;
        const float* mod = WSP(float, WS_MOD) + (size_t)b * 6 * D;
        f32x4 o[4]; float s = 0.f;
#pragma unroll
        for (int j = 0; j < 4; ++j) { const u64 w = orow[64 * j];
            o[j].x = bf2f((unsigned short)w); o[j].y = bf2f((unsigned short)(w >> 16)); o[j].z = bf2f((unsigned short)(w >> 32)); o[j].w = bf2f((unsigned short)(w >> 48));
            s += (o[j].x * o[j].x + o[j].y * o[j].y) + (o[j].z * o[j].z + o[j].w * o[j].w); }
        const float rstd = 1.0f / sqrtf(wave_sum(s) * (1.0f / D) + RMS_EPS);
        f32x4 x2[4]; float s2 = 0.f;
        f32x4* outr = (f32x4*)(A.out + (size_t)m * D) + F.lane;
#pragma unroll
        for (int j = 0; j < 4; ++j) {
            const int col = 4 * F.lane + 256 * j;
            const f32x4 g = *(const f32x4*)(INP(float, 6) + col), gt = *(const f32x4*)(mod + 2 * D + col);
            x2[j] = xr[64 * j] + gt * (o[j] * rstd * g);
            outr[64 * j] = x2[j];
            s2 += (x2[j].x * x2[j].x + x2[j].y * x2[j].y) + (x2[j].z * x2[j].z + x2[j].w * x2[j].w);
        }
        const float rstd2 = 1.0f / sqrtf(wave_sum(s2) * (1.0f / D) + RMS_EPS);
        u64* o8 = (u64*)(WSP(bf16, WS_XN) + (size_t)m * D) + F.lane;
#pragma unroll
        for (int j = 0; j < 4; ++j) {
            const int col = 4 * F.lane + 256 * j;
            const f32x4 g = *(const f32x4*)(INP(float, 7) + col), sc = *(const f32x4*)(mod + 4 * D + col), sh = *(const f32x4*)(mod + 3 * D + col);
            const f32x4 h = x2[j] * rstd2 * g * (sc + 1.0f) + sh;
            o8[64 * j] = (u64)pk2(h.x, h.y) | ((u64)pk2(h.z, h.w) << 32);
        }
    }
}
DI void phase_e2(Frame& F, const Args& A, const bf16* Y) {
    const int gw = F.bid * NWAVES + F.wave, NGW = F.G * NWAVES;
    const int per = (M + NGW - 1) / NGW; const int r0 = gw * per, r1 = (r0 + per < M) ? r0 + per : M;
    for (int m = r0; m < r1; ++m) {
        const int b = m / T;
        const u64* yrow = (const u64*)(Y + (size_t)m * D) + F.lane;
        const float* mod = WSP(float, WS_MOD) + (size_t)b * 6 * D;
        f32x4 y[4]; float s = 0.f;
#pragma unroll
        for (int j = 0; j < 4; ++j) { const u64 w = yrow[64 * j];
            y[j].x = bf2f((unsigned short)w); y[j].y = bf2f((unsigned short)(w >> 16)); y[j].z = bf2f((unsigned short)(w >> 32)); y[j].w = bf2f((unsigned short)(w >> 48));
            s += (y[j].x * y[j].x + y[j].y * y[j].y) + (y[j].z * y[j].z + y[j].w * y[j].w); }
        const float rstd = 1.0f / sqrtf(wave_sum(s) * (1.0f / D) + RMS_EPS);
        f32x4* outr = (f32x4*)(A.out + (size_t)m * D) + F.lane;
#pragma unroll
        for (int j = 0; j < 4; ++j) {
            const int col = 4 * F.lane + 256 * j;
            const f32x4 g = *(const f32x4*)(INP(float, 8) + col), gt = *(const f32x4*)(mod + 5 * D + col);
            outr[64 * j] = outr[64 * j] + gt * (y[j] * rstd * g);
        }
    }
}

constexpr int KT_STRIDE = 144, KT_BYTES = 64 * KT_STRIDE, VT_BYTES = 64 * 128;
DI int vt_off(int row, int colbyte) { return row * 128 + (colbyte ^ (((row >> 1) & 1) << 6)); }
struct KVRegs { u32x4 k, v; };
DI void kv_load(KVRegs& r, const bf16* Kg, const bf16* Vg, int tid) {
    const int row = tid >> 3, ch = tid & 7;
    r.k = *(const u32x4*)(Kg + (size_t)row * PP + ch * 8); r.v = *(const u32x4*)(Vg + (size_t)row * PP + ch * 8);
}
DI void kv_store(LAS unsigned char* Kl, LAS unsigned char* Vl, const KVRegs& r, int tid) {
    const int row = tid >> 3, ch = tid & 7;
    *(LAS u32x4*)(Kl + row * KT_STRIDE + ch * 16) = r.k; *(LAS u32x4*)(Vl + vt_off(row, ch * 16)) = r.v;
}
typedef short v4i16_t __attribute__((ext_vector_type(4)));
DI s16x4 vtr(LAS const unsigned char* p) { return __builtin_bit_cast(s16x4, __builtin_amdgcn_ds_read_tr16_b64_v4i16((LAS v4i16_t*)p)); }
DI bf16x8 pack8(const f32x16& p, const int base) {
    u32x4 w; w.x = pk2(p[base], p[base + 1]); w.y = pk2(p[base + 2], p[base + 3]); w.z = pk2(p[base + 4], p[base + 5]); w.w = pk2(p[base + 6], p[base + 7]);
    return __builtin_bit_cast(bf16x8, w);
}
struct LaneAddr { int kb, vb0, vb1; };
DI LaneAddr lane_addr(int lane) {
    const int r32 = lane & 31, hi = lane >> 5, a = lane & 15, g1 = (lane >> 4) & 1, swz = (a >> 3) & 1;
    const int common = (4 * hi + (a >> 2)) * 128 + 32 * g1 + 8 * (a & 3);
    LaneAddr la; la.kb = r32 * KT_STRIDE + hi * 16; la.vb0 = common + 64 * swz; la.vb1 = common + 64 * (1 - swz);
    return la;
}
DI f32x16 qk_block(LAS const unsigned char* lds, const int koff, const bf16x8 (&qr)[4], const LaneAddr& la) {
    f32x16 s;
#pragma unroll
    for (int i = 0; i < 16; ++i) s[i] = 0.f;
    LAS const unsigned char* kb = lds + la.kb;
#pragma unroll
    for (int st = 0; st < 4; ++st) { const bf16x8 a = *(LAS const bf16x8*)(kb + (koff + st * 32)); s = MFMA32(a, qr[st], s); }
    return s;
}
DI void pv_step(f32x16 (&o)[2], LAS const unsigned char* lds, const int voff, const bf16x8 pw, const LaneAddr& la) {
    { const s16x4 lo = vtr(lds + la.vb0 + voff), hh = vtr(lds + la.vb0 + (voff + 1024));
      const bf16x8 vf = __builtin_shufflevector(lo, hh, 0, 1, 2, 3, 4, 5, 6, 7); o[0] = MFMA32(vf, pw, o[0]); }
    { const s16x4 lo = vtr(lds + la.vb1 + voff), hh = vtr(lds + la.vb1 + (voff + 1024));
      const bf16x8 vf = __builtin_shufflevector(lo, hh, 0, 1, 2, 3, 4, 5, 6, 7); o[1] = MFMA32(vf, pw, o[1]); }
}
DI void mask_block(f32x16& s, unsigned w  ) {
#pragma unroll
    for (int r = 0; r < 16; ++r) { const int sh = (r & 3) + 8 * (r >> 2); if (!((w >> sh) & 1u)) s[r] = -INFINITY; }
}
DI float block_max(const f32x16& s) { float m = s[0];
#pragma unroll
    for (int r = 1; r < 16; ++r) m = fmaxf(m, s[r]);
    return m; }
template <int KOFF, int VOFF>
DI void attn_tile(const bf16x8 (&qr)[4], LAS const unsigned char* lds, f32x16 (&o)[2], float& m_run, float& l_run, u64 vb, const LaneAddr& la, int hi) {
    __builtin_amdgcn_sched_barrier(0);
    f32x16 p0 = qk_block(lds, KOFF, qr, la), p1 = qk_block(lds, KOFF + 32 * KT_STRIDE, qr, la);
    __builtin_amdgcn_sched_barrier(0);
    mask_block(p0, (unsigned)vb >> (4 * hi)); mask_block(p1, (unsigned)(vb >> 32) >> (4 * hi));
    float mx = fmaxf(block_max(p0), block_max(p1));
    mx = fmaxf(mx, __shfl_xor(mx, 32));
    const float m_new = fmaxf(m_run, mx);
    const float alpha = fast_exp2(m_run - m_new);
    m_run = m_new;
    float rs = 0.f;
#pragma unroll
    for (int r = 0; r < 16; ++r) { p0[r] = fast_exp2(p0[r] - m_new); p1[r] = fast_exp2(p1[r] - m_new); rs += p0[r] + p1[r]; }
    l_run = l_run * alpha + rs;
#pragma unroll
    for (int r = 0; r < 16; ++r) { o[0][r] *= alpha; o[1][r] *= alpha; }
    __builtin_amdgcn_sched_barrier(0);
    pv_step(o, lds, VOFF + 0 * 128, pack8(p0, 0), la); __builtin_amdgcn_sched_barrier(0);
    pv_step(o, lds, VOFF + 16 * 128, pack8(p0, 8), la); __builtin_amdgcn_sched_barrier(0);
    pv_step(o, lds, VOFF + 32 * 128, pack8(p1, 0), la); __builtin_amdgcn_sched_barrier(0);
    pv_step(o, lds, VOFF + 48 * 128, pack8(p1, 8), la); __builtin_amdgcn_sched_barrier(0);
}
DI u64 causal_bits(int ql) { return ql >= 63 ? ~0ull : ((1ull << (ql + 1)) - 1ull); }

DI void compress_item(Frame& F, int item) {
    const int kv = item & 1, half = (item >> 1) & 1, g = (item >> 2) & 1, b = item >> 3;
    const int lane = launder(F.lane), r32 = lane & 31, hi = lane >> 5, wid = F.wave;
    const bf16* Pb = WSP(bf16, WS_P) + (size_t)b * T * PP + ((kv ? HB_VC : HB_KC) + g) * 64;
    const bf16* W1 = kv ? WSP(bf16, WS_W1V) : WSP(bf16, WS_W1K); const bf16* W2 = kv ? WSP(bf16, WS_W2V) : WSP(bf16, WS_W2K);
    const float* bias = WSP(float, WS_BIASC) + kv * 128;
    bf16* OUT = (kv ? WSP(bf16, WS_VCMP) : WSP(bf16, WS_KCMP)) + (size_t)((b * 2 + g) * 128) * 64;
    LAS unsigned char* H1 = F.lds;
    {
        const int mh = wid & 1, nq = wid >> 1;
        const int n = 64 * half + 32 * mh + r32, nc = n < 126 ? n : 126;
        const bf16* arow = Pb + (size_t)(16 * nc) * PP + hi * 8;
        const bf16* brow = W1 + (size_t)(32 * nq + r32) * 2048 + hi * 8;
        f32x16 acc;
#pragma unroll
        for (int i = 0; i < 16; ++i) acc[i] = 0.f;
#pragma unroll 2
        for (int l = 0; l < 32; ++l) {
#pragma unroll
            for (int ss = 0; ss < 4; ++ss) {
                const bf16x8 a = *(const bf16x8*)(arow + (size_t)l * PP + ss * 16);
                const bf16x8 bb = *(const bf16x8*)(brow + (4 * l + ss) * 16);
                acc = MFMA32(a, bb, acc);
            }
        }
        const float bj = bias[32 * nq + r32];
#pragma unroll
        for (int r = 0; r < 16; ++r) {
            const float h = gelu_tanh(acc[r] + bj);
            *(LAS unsigned short*)(H1 + (32 * mh + crow(r, hi)) * 272 + (32 * nq + r32) * 2) = (unsigned short)(pk2(h, 0.f) & 0xffffu);
        }
    }
    __syncthreads();
    if (wid < 4) {
        const int mh = wid & 1, dh = wid >> 1;
        f32x16 acc;
#pragma unroll
        for (int i = 0; i < 16; ++i) acc[i] = 0.f;
        LAS const unsigned char* ar = H1 + (32 * mh + r32) * 272 + hi * 16;
        const bf16* br = W2 + (size_t)(32 * dh + r32) * 128 + hi * 8;
#pragma unroll
        for (int st = 0; st < 8; ++st) {
            const bf16x8 a = *(LAS const bf16x8*)(ar + st * 32);
            const bf16x8 bb = *(const bf16x8*)(br + st * 16);
            acc = MFMA32(a, bb, acc);
        }
#pragma unroll
        for (int r = 0; r < 16; ++r) OUT[(size_t)(64 * half + 32 * mh + crow(r, hi)) * 64 + 32 * dh + r32] = (bf16)(pk2(acc[r], 0.f) & 0xffffu);
    }
    __syncthreads();
}

DI void score_unit(Frame& F, int b, int qb) {
    const int lane = launder(F.lane), r32 = lane & 31, hi = lane >> 5, wid = F.wave;
    const int qh = wid & 1, kvh = (wid >> 1) & 1, kpar = wid >> 2;
    const size_t rowq = (size_t)b * T + 64 * qb + 32 * qh + r32;
    bf16x8 qf[4][4];
#pragma unroll
    for (int h = 0; h < 4; ++h)
#pragma unroll
        for (int st = 0; st < 4; ++st) qf[h][st] = *(const bf16x8*)(WSP(bf16, WS_P) + rowq * PP + (HB_QI + h) * 64 + 16 * st + 8 * hi);
    const float idx_scale = 0.5f * 0.125f;
    const f32x4 wv = *(const f32x4*)(WSP(float, WS_MISC) + rowq * 32 + 24);
    const float w0 = wv[0] * idx_scale, w1 = wv[1] * idx_scale, w2 = wv[2] * idx_scale, w3 = wv[3] * idx_scale;
    float* tbase = WSP(float, WS_SC) + ((size_t)b * SC_TILES_PER_B + (size_t)(qb * (qb + 1) / 2)) * 4096 + (32 * qh + r32) * 64 + 32 * kvh + 4 * hi;
    for (int kb = kpar; kb <= qb; kb += 2) {
        const size_t rowk = (size_t)b * T + 64 * kb + 32 * kvh + r32;
        bf16x8 kf[4];
#pragma unroll
        for (int st = 0; st < 4; ++st) kf[st] = *(const bf16x8*)(WSP(bf16, WS_P) + rowk * PP + HB_KI * 64 + 16 * st + 8 * hi);
        f32x16 sc;
#pragma unroll
        for (int h = 0; h < 4; ++h) {
            f32x16 acc;
#pragma unroll
            for (int i = 0; i < 16; ++i) acc[i] = 0.f;
#pragma unroll
            for (int st = 0; st < 4; ++st) acc = MFMA32(kf[st], qf[h][st], acc);
            const float wh = h == 0 ? w0 : (h == 1 ? w1 : (h == 2 ? w2 : w3));
#pragma unroll
            for (int i = 0; i < 16; ++i) { const float rl = fmaxf(acc[i], 0.f); sc[i] = h == 0 ? wh * rl : fmaf(wh, rl, sc[i]); }
        }
        float* tp = tbase + (size_t)kb * 4096;
#pragma unroll
        for (int u = 0; u < 4; ++u) { f32x4 v = {sc[4 * u], sc[4 * u + 1], sc[4 * u + 2], sc[4 * u + 3]}; *(f32x4*)(tp + 8 * u) = v; }
    }
}
DI void phase_a1(Frame& F) {
    unsigned* ctr = WSP(unsigned, WS_CTL) + 64;
    for (;;) {
        const int it = q_next(F, ctr);
        if (it >= 256 + 1024) break;
        if (it < 256) compress_item(F, it);
        else { const int u = it - 256; score_unit(F, u & 31, 31 - (u >> 5)); }
    }
}

template <class MaskF>
DI void run_tiles(Frame& F, unsigned tmask, const bf16* Kg0, const bf16* Vg0,
                  const bf16x8 (&qr)[4], f32x16 (&o)[2], float& m_run, float& l_run, const MaskF mf, const LaneAddr& la, const int tid) {
    LAS unsigned char* KT = F.lds; LAS unsigned char* VT = F.lds + KT_BYTES;
    if (tmask == 0u) return;
    int j = __builtin_ctz(tmask); tmask &= tmask - 1u;
    KVRegs rg; kv_load(rg, Kg0 + (size_t)(64 * j) * PP, Vg0 + (size_t)(64 * j) * PP, tid);
    for (;;) {
        __syncthreads();
        kv_store(KT, VT, rg, tid);
        __syncthreads();
        int jn = -1;
        if (tmask) { jn = __builtin_ctz(tmask); tmask &= tmask - 1u; kv_load(rg, Kg0 + (size_t)(64 * jn) * PP, Vg0 + (size_t)(64 * jn) * PP, tid); }
        attn_tile<0, KT_BYTES>(qr, F.lds, o, m_run, l_run, mf(j), la, (tid >> 5) & 1);
        if (jn < 0) break;
        j = jn;
    }
}
struct SlcMask { unsigned sel; int tb, ql; DI u64 operator()(int j) const { return ((sel >> j) & 1u) ? (j == tb ? causal_bits(ql) : ~0ull) : 0ull; } };
struct WinMask { int tb, ql; DI u64 operator()(int j) const { return j == tb ? causal_bits(ql) : (j == tb - 8 ? ~causal_bits(ql) : ~0ull); } };
struct DsaMask { LAS const u64* row; DI u64 operator()(int j) const { return row[j]; } };

constexpr int NSA_KT = 0, NSA_VT = KT_BYTES, NSA_KC = NSA_VT + VT_BYTES, NSA_VC = NSA_KC + 128 * KT_STRIDE, NSA_IMP = NSA_VC + 128 * 128,
              NSA_SELM = NSA_IMP + 4 * 64 * 33 * 4, NSA_UM = NSA_SELM + 256, NSA_END = NSA_UM + 16;
static_assert(NSA_END <= RING_BYTES, "NSA LDS map");

DI void nsa_unit(Frame& F, int b, int g, int tb) {
    const int tid = launder(F.tid), lane = tid & 63, r32 = lane & 31, hi = lane >> 5, wid = F.wave;
    const int r = wid & 3, th = wid >> 2, hq = 4 * g + r, ql = 32 * th + r32, t = 64 * tb + ql;
    const size_t rowg = (size_t)b * T + t;
    LAS unsigned char* KC = F.lds + NSA_KC; LAS unsigned char* VC = F.lds + NSA_VC;
    const LaneAddr la = lane_addr(lane);
    LAS float* IMP = (LAS float*)(F.lds + NSA_IMP); LAS unsigned* SELM = (LAS unsigned*)(F.lds + NSA_SELM); LAS unsigned* UM = (LAS unsigned*)(F.lds + NSA_UM);
    bf16x8 qr[4];
#pragma unroll
    for (int st = 0; st < 4; ++st) qr[st] = *(const bf16x8*)(WSP(bf16, WS_P) + rowg * PP + hq * 64 + 16 * st + 8 * hi);
    float gate[3];
#pragma unroll
    for (int br = 0; br < 3; ++br) { const float xg = WSP(float, WS_MISC)[rowg * 32 + hq * 3 + br]; gate[br] = 1.0f / (1.0f + __expf(-xg)); }
    f32x16 ot[2];
#pragma unroll
    for (int i = 0; i < 16; ++i) { ot[0][i] = 0.f; ot[1][i] = 0.f; }
    {
        const bf16* kc = WSP(bf16, WS_KCMP) + (size_t)((b * 2 + g) * 128) * 64; const bf16* vc = WSP(bf16, WS_VCMP) + (size_t)((b * 2 + g) * 128) * 64;
#pragma unroll
        for (int ps = 0; ps < 2; ++ps) { const int row = (tid >> 3) + 64 * ps, ch = tid & 7;
            const u32x4 kk = *(const u32x4*)(kc + row * 64 + ch * 8), vv = *(const u32x4*)(vc + row * 64 + ch * 8);
            *(LAS u32x4*)(KC + row * KT_STRIDE + ch * 16) = kk; *(LAS u32x4*)(VC + vt_off(row, ch * 16)) = vv; }
        if (tid == 0) UM[0] = 0u;
    }
    __syncthreads();
    {
        const int nq = (t - 31) >> 4;
        float mx = -INFINITY;
#pragma unroll 1
        for (int c = 0; c < 4; ++c) {
            const f32x16 s = qk_block(F.lds, NSA_KC + c * 32 * KT_STRIDE, qr, la);
#pragma unroll
            for (int rg = 0; rg < 16; ++rg) if (32 * c + crow(rg, hi) <= nq) mx = fmaxf(mx, s[rg]);
        }
        mx = fmaxf(mx, __shfl_xor(mx, 32));
        const float ms = fmaxf(mx, -1e30f);
        float l = 0.f, carry = 0.f;
        LAS float* irow = IMP + (r * 64 + ql) * 33;
        f32x16 oc[2];
#pragma unroll
        for (int i = 0; i < 16; ++i) { oc[0][i] = 0.f; oc[1][i] = 0.f; }
#pragma unroll 1
        for (int c = 0; c < 4; ++c) {
            f32x16 p = qk_block(F.lds, NSA_KC + c * 32 * KT_STRIDE, qr, la);
#pragma unroll
            for (int rg = 0; rg < 16; ++rg) { p[rg] = (32 * c + crow(rg, hi) <= nq) ? fast_exp2(p[rg] - ms) : 0.f; l += p[rg]; }
            float sw[4];
#pragma unroll
            for (int u = 0; u < 4; ++u) sw[u] = __shfl_xor(p[4 * u + 3], 32);
#pragma unroll
            for (int u = 0; u < 4; ++u) {
                const float quad = (p[4 * u] + p[4 * u + 1]) + (p[4 * u + 2] + p[4 * u + 3]);
                const float prevlo = u > 0 ? sw[u > 0 ? u - 1 : 0] : carry;
                irow[8 * c + 2 * u + hi] = quad + (hi ? sw[u] : prevlo);
            }
            carry = sw[3];
            pv_step(oc, F.lds, NSA_VC + (32 * c) * 128, pack8(p, 0), la); pv_step(oc, F.lds, NSA_VC + (32 * c + 16) * 128, pack8(p, 8), la);
        }
        l += __shfl_xor(l, 32);
        const float inv = l > 0.f ? 1.0f / l : 0.f;
#pragma unroll
        for (int i = 0; i < 16; ++i) irow[2 * i + hi] *= inv;
        const float gs = gate[0] * inv;
#pragma unroll
        for (int i = 0; i < 16; ++i) { ot[0][i] = gs * oc[0][i]; ot[1][i] = gs * oc[1][i]; }
    }
    __syncthreads();
    if (tb < 16) {
        if (tid < 64) SELM[tid] = (2u << tb) - 1u;
        if (tid == 0) UM[0] = (2u << tb) - 1u;
    } else {
        const int j = lane & 31;
        unsigned um = 0u;
#pragma unroll 1
        for (int ps = 0; ps < 4; ++ps) {
            const int tq = wid * 8 + ps * 2 + hi;
            float v = ((IMP[(0 * 64 + tq) * 33 + j] + IMP[(1 * 64 + tq) * 33 + j]) + IMP[(2 * 64 + tq) * 33 + j]) + IMP[(3 * 64 + tq) * 33 + j];
            if (j > tb) v = -INFINITY; else if (j == 0 || j == tb || j == tb - 1) v = INFINITY;
            int rank = 0;
#pragma unroll 1
            for (int sft = 1; sft < 32; ++sft) {
                const int oj = (j + sft) & 31;
                const float ov = __shfl(v, (lane & 32) | oj);
                rank += (ov > v || (ov == v && oj < j)) ? 1 : 0;
            }
            const u64 bm = __ballot(rank < 16 && j <= tb);
            if (j == 0) SELM[tq] = hi ? (unsigned)(bm >> 32) : (unsigned)bm;
            um |= (unsigned)bm | (unsigned)(bm >> 32);
        }
        if (lane == 0) __hip_atomic_fetch_or(UM, um, __ATOMIC_RELAXED, __HIP_MEMORY_SCOPE_WORKGROUP);
    }
    __syncthreads();
    const unsigned umask = UM[0];
    const unsigned sel = SELM[ql];
    const bf16* Pb = WSP(bf16, WS_P) + (size_t)b * T * PP;
    {
        f32x16 o[2];
#pragma unroll
        for (int i = 0; i < 16; ++i) { o[0][i] = 0.f; o[1][i] = 0.f; }
        float m_run = -1e30f, l_run = 0.f;
        SlcMask mf{sel, tb, ql};
        run_tiles(F, umask, Pb + (HB_KSL + g) * 64, Pb + (HB_VSL + g) * 64, qr, o, m_run, l_run, mf, la, tid);
        float l = l_run + __shfl_xor(l_run, 32);
        const float sc = l > 0.f ? gate[1] / l : 0.f;
#pragma unroll
        for (int i = 0; i < 16; ++i) { ot[0][i] += sc * o[0][i]; ot[1][i] += sc * o[1][i]; }
    }
    {
        f32x16 o[2];
#pragma unroll
        for (int i = 0; i < 16; ++i) { o[0][i] = 0.f; o[1][i] = 0.f; }
        float m_run = -1e30f, l_run = 0.f;
        const int jlo = tb >= 8 ? tb - 8 : 0;
        const unsigned wmask = (tb == 31 ? ~0u : ((2u << tb) - 1u)) & ~((1u << jlo) - 1u);
        WinMask mf{tb, ql};
        run_tiles(F, wmask, Pb + (HB_KW + g) * 64, Pb + (HB_VW + g) * 64, qr, o, m_run, l_run, mf, la, tid);
        float l = l_run + __shfl_xor(l_run, 32);
        const float sc = l > 0.f ? gate[2] / l : 0.f;
#pragma unroll
        for (int i = 0; i < 16; ++i) { ot[0][i] += sc * o[0][i]; ot[1][i] += sc * o[1][i]; }
    }
    bf16* orow = WSP(bf16, WS_XN) + rowg * D + hq * 64 + 4 * hi;
#pragma unroll
    for (int db = 0; db < 2; ++db)
#pragma unroll
        for (int u = 0; u < 4; ++u) { u32x2 w; w.x = pk2(ot[db][4 * u], ot[db][4 * u + 1]); w.y = pk2(ot[db][4 * u + 2], ot[db][4 * u + 3]); *(u32x2*)(orow + 32 * db + 8 * u) = w; }
}

DI void dsa_select(const float* SCb, int t, int KB, LAS unsigned* hist, LAS unsigned* keys, LAS u64* mrow, int lane) {
    const int qb = t >> 6, ql = t & 63;
    if (t + 1 <= 256) {
        for (int i = 0; i < KB; ++i) { const u64 bm = __ballot(64 * i + lane <= t); if (lane == 0) mrow[i] = bm; }
        return;
    }
    const float* base = SCb + (size_t)(qb * (qb + 1) / 2) * 4096 + ql * 64 + lane;
#pragma unroll 4
    for (int i = 0; i < KB; ++i) {
        unsigned k = 0u;
        if (64 * i + lane <= t) { const float v = base[(size_t)i * 4096] + 0.0f; const unsigned u = __float_as_uint(v); k = (u & 0x80000000u) ? ~u : (u | 0x80000000u); }
        keys[i * 64 + lane] = k;
    }
    unsigned prefix = 0u; int rem = 256;
#pragma unroll 1
    for (int pass = 0; pass < 4; ++pass) {
        const int shift = 24 - 8 * pass;
        { u32x4 z = {0u, 0u, 0u, 0u}; *(LAS u32x4*)(hist + 4 * lane) = z; }
        LDS_WAIT();
        for (int i = 0; i < KB; ++i) {
            const unsigned k = keys[i * 64 + lane];
            const bool match = k != 0u && ((k >> 1) >> (shift + 7)) == prefix;
            if (match) __hip_atomic_fetch_add(hist + ((k >> shift) & 255u), 1u, __ATOMIC_RELAXED, __HIP_MEMORY_SCOPE_WORKGROUP);
        }
        LDS_WAIT();
        const u32x4 cc = *(LAS u32x4*)(hist + 4 * lane);
        LDS_WAIT();
        const int tot = (int)(cc.x + cc.y + cc.z + cc.w);
        int suf = tot;
#pragma unroll
        for (int off = 1; off < 64; off <<= 1) { const int y = __shfl_down(suf, off); if (lane + off < 64) suf += y; }
        const u64 bal = __ballot(suf >= rem);
        const int L = __popcll(bal) - 1;
        int cum = suf - tot, dsel;
        if (cum + (int)cc.w >= rem) dsel = 3;
        else { cum += (int)cc.w;
            if (cum + (int)cc.z >= rem) dsel = 2;
            else { cum += (int)cc.z;
                if (cum + (int)cc.y >= rem) dsel = 1;
                else { cum += (int)cc.y; dsel = 0; } } }
        const int dig = __shfl(4 * lane + dsel, L);
        rem -= __shfl(cum, L);
        prefix = (prefix << 8) | (unsigned)dig;
    }
    int running = 0;
    for (int i = 0; i < KB; ++i) {
        const unsigned k = keys[i * 64 + lane];
        const bool gt = k > prefix, eq = k == prefix;
        const u64 beq = __ballot(eq);
        const int mypos = running + __popcll(beq & ((1ull << lane) - 1ull));
        const bool sl = gt || (eq && mypos < rem);
        running += __popcll(beq);
        const u64 bm = __ballot(sl);
        if (lane == 0) mrow[i] = bm;
    }
}
constexpr int DSA_MB = KT_BYTES + VT_BYTES, DSA_HIST = DSA_MB + 32 * 33 * 8, DSA_KEYS = DSA_HIST + 8 * 1024, DSA_END = DSA_KEYS + 8 * 8192;
static_assert(DSA_END <= RING_BYTES, "DSA LDS map");
DI void dsa_unit(Frame& F, int b, int qb32) {
    const int tid = launder(F.tid), lane = tid & 63, r32 = lane & 31, hi = lane >> 5, wid = F.wave;
    const int t0 = 32 * qb32, KB = (qb32 >> 1) + 1;
    const LaneAddr la = lane_addr(lane);
    LAS u64* MB = (LAS u64*)(F.lds + DSA_MB); LAS unsigned* HIST = (LAS unsigned*)(F.lds + DSA_HIST) + wid * 256; LAS unsigned* KEYS = (LAS unsigned*)(F.lds + DSA_KEYS) + wid * 2048;
    const float* SCb = WSP(float, WS_SC) + (size_t)b * SC_TILES_PER_B * 4096;
    for (int qq = 0; qq < 4; ++qq) { const int qi = wid * 4 + qq; dsa_select(SCb, t0 + qi, KB, HIST, KEYS, MB + qi * 33, lane); }
    __syncthreads();
    const size_t rowg = (size_t)b * T + t0 + r32;
    bf16x8 qr[4];
#pragma unroll
    for (int st = 0; st < 4; ++st) qr[st] = *(const bf16x8*)(WSP(bf16, WS_P) + rowg * PP + (HB_QD + wid) * 64 + 16 * st + 8 * hi);
    f32x16 o[2];
#pragma unroll
    for (int i = 0; i < 16; ++i) { o[0][i] = 0.f; o[1][i] = 0.f; }
    float m_run = -1e30f, l_run = 0.f;
    const bf16* Pb = WSP(bf16, WS_P) + (size_t)b * T * PP;
    const unsigned tmask = KB >= 32 ? ~0u : ((1u << KB) - 1u);
    DsaMask mf{MB + r32 * 33};
    run_tiles(F, tmask, Pb + HB_KD * 64, Pb + HB_VD * 64, qr, o, m_run, l_run, mf, la, tid);
    const float l = l_run + __shfl_xor(l_run, 32);
    const float sc = l > 0.f ? 1.0f / l : 0.f;
    bf16* orow = WSP(bf16, WS_XN) + rowg * D + 512 + wid * 64 + 4 * hi;
#pragma unroll
    for (int db = 0; db < 2; ++db)
#pragma unroll
        for (int u = 0; u < 4; ++u) { u32x2 w; w.x = pk2(o[db][4 * u] * sc, o[db][4 * u + 1] * sc); w.y = pk2(o[db][4 * u + 2] * sc, o[db][4 * u + 3] * sc); *(u32x2*)(orow + 32 * db + 8 * u) = w; }
}
DI void phase_a2(Frame& F) {
    unsigned* ctr = WSP(unsigned, WS_CTL) + 128;
    for (;;) {
        const int it = q_next(F, ctr);
        if (it >= 4096) break;
        const int L = it >> 7, k = it & 127;
#ifndef NO_NSA
        if (k < 64) nsa_unit(F, k >> 1, k & 1, 31 - L);
#endif
#ifndef NO_DSA
        if (k >= 64) { const int kk = k - 64; dsa_unit(F, kk >> 1, 63 - 2 * L - (kk & 1)); }
#endif
    }
}

constexpr int N_PHASES = 10;
#ifndef PHASE_MASK
#define PHASE_MASK 0x3FF
#endif
#ifndef MK_COOP
#define MK_COOP 0
#endif

__global__ void __launch_bounds__(NTHR, 2) mega_fwd(Args args) {
    extern __shared__ __attribute__((aligned(16))) unsigned char lds_raw[];
    Frame F;
    F.lds = (LAS unsigned char*)lds_raw;
    F.MISC = (volatile LAS unsigned*)(F.lds + MISC_OFF);
    F.tid = threadIdx.x; F.lane = F.tid & 63; F.wave = __builtin_amdgcn_readfirstlane(F.tid >> 6);
    F.G = gridDim.x; F.bid = blockIdx.x;
    F.ws = args.ws;
    const Args& A = args;
    bf16* OPROJ = WSP(bf16, WS_P); bf16* Y = WSP(bf16, WS_P);

    const int lo = args.ph_lo, hi = args.ph_hi;
#define IN(k) (lo <= (k) && (k) < hi)
#define SEAM(k) do { if (IN(k) && IN((k) + 1)) { if (args.coop) cg::this_grid().sync(); } } while (0)

    if (((PHASE_MASK >> 0) & 1) && IN(0)) { phase_p0(F, A); }
    SEAM(0);
    if (((PHASE_MASK >> 1) & 1) && IN(1)) { phase_e0(F, A); }
    SEAM(1);
    if (((PHASE_MASK >> 2) & 1) && IN(2)) {
        pg8::Gemm g{WSP(bf16, WS_XN), WSP(bf16, WS_WIN), M, NPROJ, D}; pg8::StaticOrder S; S.init(M, NPROJ, F.G, F.bid);
        pg8::EpiProj E{WSP(bf16, WS_P), WSP(float, WS_MISC), WSP(float, WS_CS)};
        pg8::gemm_phase<pg8::EpiProj, pg8::StaticOrder, true, true>(F.lds, g, S, E);
    }
    SEAM(2);
    if (((PHASE_MASK >> 3) & 1) && IN(3)) { phase_a1(F); }
    SEAM(3);
    if (((PHASE_MASK >> 4) & 1) && IN(4)) { phase_a2(F); }
    SEAM(4);
    if (((PHASE_MASK >> 5) & 1) && IN(5)) {
        pg8::Gemm g{WSP(bf16, WS_XN), WSP(bf16, WS_WOUT), M, D, D}; pg8::StaticOrder S; S.init(M, D, F.G, F.bid);
        pg8::EpiStore<0> E{OPROJ, D};
        pg8::gemm_phase<pg8::EpiStore<0>, pg8::StaticOrder, true, true>(F.lds, g, S, E);
    }
    SEAM(5);
    if (((PHASE_MASK >> 6) & 1) && IN(6)) { phase_e1(F, A, OPROJ); }
    SEAM(6);
    if (((PHASE_MASK >> 7) & 1) && IN(7)) {
        pg8::Gemm g{WSP(bf16, WS_XN), WSP(bf16, WS_WUP), M, FF, D}; pg8::StaticOrder S; S.init(M, FF, F.G, F.bid);
        pg8::EpiStore<1> E{WSP(bf16, WS_SC), FF};
        pg8::gemm_phase<pg8::EpiStore<1>, pg8::StaticOrder, true, true>(F.lds, g, S, E);
    }
    SEAM(7);
    if (((PHASE_MASK >> 8) & 1) && IN(8)) {
        pg8::Gemm g{WSP(bf16, WS_SC), WSP(bf16, WS_WDOWN), M, D, FF}; pg8::StaticOrder S; S.init(M, D, F.G, F.bid);
        pg8::EpiStore<0> E{Y, D};
        pg8::gemm_phase<pg8::EpiStore<0>, pg8::StaticOrder, true, true>(F.lds, g, S, E);
    }
    SEAM(8);
    if (((PHASE_MASK >> 9) & 1) && IN(9)) { phase_e2(F, A, Y); }
#undef IN
#undef SEAM
}

extern "C" void kernel_launch(void* const* d_in, const int* in_sizes, int n_in, void* d_out, int out_size, void* d_ws, size_t ws_size, hipStream_t stream) {
    static int grid = 0;
    if (grid == 0) {
        if (n_in != 19 || in_sizes[0] != M * D || out_size != M * D || ws_size < WS_END) {
            fprintf(stderr, "kernel_launch: unexpected shapes: n_in %d in0 %d out %d ws %zu (need %zu)\n", n_in, n_in > 0 ? in_sizes[0] : -1, out_size, ws_size, (size_t)WS_END); grid = -1; return; }
        int dev = 0, cus = 0, per_cu = 0;
        if (hipGetDevice(&dev) != hipSuccess || hipDeviceGetAttribute(&cus, hipDeviceAttributeMultiprocessorCount, dev) != hipSuccess) { fprintf(stderr, "kernel_launch: device query failed\n"); grid = -1; return; }
        if (hipFuncSetAttribute((const void*)mega_fwd, hipFuncAttributeMaxDynamicSharedMemorySize, LDS_BYTES) != hipSuccess) { fprintf(stderr, "kernel_launch: hipFuncSetAttribute failed\n"); grid = -1; return; }
        if (hipOccupancyMaxActiveBlocksPerMultiprocessor(&per_cu, (const void*)mega_fwd, NTHR, LDS_BYTES) != hipSuccess || per_cu < 1) { fprintf(stderr, "kernel_launch: occupancy query says %d\n", per_cu); per_cu = 1; }
        (void)hipGetLastError();
        grid = cus;
        fprintf(stderr, "kernel_launch: cus %d per_cu %d grid %d\n", cus, per_cu, grid);
    }
    if (grid < 0) return;
    if (hipMemsetAsync((char*)d_ws + WS_CTL, 0, CTL_ZERO_BYTES, stream) != hipSuccess) { fprintf(stderr, "kernel_launch: memset failed\n"); return; }
    Args a{};
    for (int i = 0; i < 19; ++i) a.in[i] = d_in[i];
    a.out = (float*)d_out; a.ws = (unsigned char*)d_ws;
#if MK_COOP
    a.ph_lo = 0; a.ph_hi = N_PHASES; a.coop = 1;
    void* kargs[] = {&a};
    hipError_t e = hipLaunchCooperativeKernel((const void*)mega_fwd, dim3(grid), dim3(NTHR), kargs, LDS_BYTES, stream);
    if (e != hipSuccess) fprintf(stderr, "kernel_launch: cooperative launch failed: %s (grid %d)\n", hipGetErrorString(e), grid);
#else
    for (int ph = 0; ph < N_PHASES; ++ph) {
        a.ph_lo = ph; a.ph_hi = ph + 1; a.coop = 0;
        hipLaunchKernelGGL(mega_fwd, dim3(grid), dim3(NTHR), LDS_BYTES, stream, a);
        const hipError_t le = hipPeekAtLastError();
        if (le != hipSuccess) { fprintf(stderr, "kernel_launch: launch %d failed: %s\n", ph, hipGetErrorName(le)); break; }
    }
#endif
}
```

```cpp
#include <hip/hip_runtime.h>
#include <hip/hip_cooperative_groups.h>
#include <cstdio>
#include <cstdint>
namespace cg = cooperative_groups;
#define DI __device__ __forceinline__
namespace pg8 {
#define PG8_LAS __attribute__((address_space(3)))
typedef unsigned short bf16_t;
typedef short bf16x8 __attribute__((ext_vector_type(8)));
typedef float f32x4 __attribute__((ext_vector_type(4)));
typedef unsigned u32x4 __attribute__((ext_vector_type(4)));
constexpr int BM = 256, BK = 64, HALF = 128, HTB = HALF * BK * 2  , STAGE_BYTES = 8 * HTB, NXCD = 8, WGM = 8;

__host__ __device__ __forceinline__ int lds_byte(int r, int c) { const int st = (r >> 4) * 2 + (c >> 5), rr = r & 15, cc = c & 31, ob = rr * 64 + cc * 2; return st * 1024 + (ob ^ (((ob >> 9) & 1) << 5)); }
__host__ __device__ __forceinline__ void stage_rc(int b, int& R, int& C) { const int st = b / 1024, sb = b % 1024, swz = sb ^ (((sb >> 9) & 1) << 5); R = (st >> 1) * 16 + swz / 64; C = (st & 1) * 32 + (swz % 64) / 2; }
__host__ __device__ __forceinline__ int perm32(int rho) { const int n = rho >> 4, i = rho & 15; return 8 * (i >> 2) + 4 * n + (i & 3); }

struct Unit { int pm, pn; };
struct Gemm { const bf16_t* A; const bf16_t* Bt; int M, N, K; };

struct StaticOrder {
    int nM, nN, nwg, G, c;
    __host__ __device__ void init(int M, int N, int G_, int c_) { nM = M / BM; nN = N / BM; nwg = nM * nN; G = G_; c = c_; }
    __host__ __device__ bool next(int i, Unit& u) const {
        const long L = (long)i * G + c; if (L >= nwg) return false;
        int wgid = (int)L; { const int q = nwg / NXCD, r = nwg % NXCD, xcd = wgid % NXCD, off = wgid / NXCD; wgid = (xcd < r ? xcd * (q + 1) : r * (q + 1) + (xcd - r) * q) + off; }
        const int nig = WGM * nN, gid = wgid / nig, fm = gid * WGM, gsz = (nM - fm) < WGM ? (nM - fm) : WGM;
        u.pm = fm + ((wgid % nig) % gsz); u.pn = (wgid % nig) / gsz; return true;
    }
    __device__ __forceinline__ void a_ready(const Unit&) const {}
    __device__ __forceinline__ void done(const Unit&) const {}
};


typedef float f32x2 __attribute__((ext_vector_type(2)));
typedef unsigned u32x2 __attribute__((ext_vector_type(2)));
typedef __bf16 bf16x2_t __attribute__((ext_vector_type(2)));
__device__ __forceinline__ unsigned cvt_pk_bf16(float lo, float hi) { f32x2 v = {lo, hi}; bf16x2_t b = __builtin_convertvector(v, bf16x2_t); return __builtin_bit_cast(unsigned, b); }

template <int ACT  > struct EpiStore {
    static constexpr bool PERM = true, AFTER_DRAIN = false;
    bf16_t* O; int ldc;
    __device__ __forceinline__ void operator()(const f32x4 (&acc)[2][2][4][2], const Unit& u, int wr, int wc, int fr, int fq) const {
        const int row0 = u.pm * BM + wr * 64 + fr; const int col0 = u.pn * BM + wc * 32 + 8 * fq;
#pragma unroll
        for (int ai = 0; ai < 2; ++ai)
#pragma unroll
            for (int m = 0; m < 4; ++m) { bf16_t* rowp = O + (size_t)(row0 + ai * HALF + m * 16) * ldc + col0;
#pragma unroll
                for (int bj = 0; bj < 2; ++bj) { f32x4 v0 = acc[ai][bj][m][0], v1 = acc[ai][bj][m][1];
                    if (ACT == 1) {
#pragma unroll
                        for (int i = 0; i < 4; ++i) { const float a = v0[i] > 0.f ? v0[i] : 0.f, b = v1[i] > 0.f ? v1[i] : 0.f; v0[i] = a * a; v1[i] = b * b; } }
                    u32x4 w; w.x = cvt_pk_bf16(v0[0], v0[1]); w.y = cvt_pk_bf16(v0[2], v0[3]); w.z = cvt_pk_bf16(v1[0], v1[1]); w.w = cvt_pk_bf16(v1[2], v1[3]);
                    *(u32x4*)(rowp + bj * HALF) = w; } }
    }
};

struct EpiProj {
    static constexpr bool PERM = true, AFTER_DRAIN = false;
    bf16_t* P; float* MISC; const float* CS;
    __device__ __forceinline__ void operator()(const f32x4 (&acc)[2][2][4][2], const Unit& u, int wr, int wc, int fr, int fq) const {
        const int row0 = u.pm * BM + wr * 64 + fr; const int qd = 4 * (wc & 1) + fq;
        constexpr unsigned long long ROPE_MASK = 0x00000007DFF333FFull;
        constexpr float QSCALE = 0.125f * 1.4426950408889634f;
#pragma unroll
        for (int ai = 0; ai < 2; ++ai)
#pragma unroll
            for (int m = 0; m < 4; ++m) {
                const int row = row0 + ai * HALF + m * 16;
                const f32x4 c01 = *(const f32x4*)(CS + (size_t)row * 64 + 8 * qd), c23 = *(const f32x4*)(CS + (size_t)row * 64 + 8 * qd + 4);
                const float cs[4] = {c01[0], c01[2], c23[0], c23[2]}, sn[4] = {c01[1], c01[3], c23[1], c23[3]};
#pragma unroll
                for (int bj = 0; bj < 2; ++bj) {
                    const int hb = u.pn * 4 + bj * 2 + (wc >> 1);
                    const f32x4 v0 = acc[ai][bj][m][0], v1 = acc[ai][bj][m][1];
                    if (hb == 35) {
                        if (qd < 4) { *(f32x4*)(MISC + (size_t)row * 32 + 8 * qd) = v0; *(f32x4*)(MISC + (size_t)row * 32 + 8 * qd + 4) = v1; }
                    } else if ((ROPE_MASK >> hb) & 1ull) {
                        const float sc = (hb < 8 || (hb >= 20 && hb < 28)) ? QSCALE : 1.0f;
                        float o1[4], o2[4];
#pragma unroll
                        for (int i = 0; i < 4; ++i) { o1[i] = (v0[i] * cs[i] - v1[i] * sn[i]) * sc; o2[i] = (v1[i] * cs[i] + v0[i] * sn[i]) * sc; }
                        bf16_t* rp = P + (size_t)row * 2304 + hb * 64 + 4 * qd;
                        u32x2 a, b; a.x = cvt_pk_bf16(o1[0], o1[1]); a.y = cvt_pk_bf16(o1[2], o1[3]); b.x = cvt_pk_bf16(o2[0], o2[1]); b.y = cvt_pk_bf16(o2[2], o2[3]);
                        *(u32x2*)rp = a; *(u32x2*)(rp + 32) = b;
                    } else {
                        u32x4 w; w.x = cvt_pk_bf16(v0[0], v0[1]); w.y = cvt_pk_bf16(v0[2], v0[3]); w.z = cvt_pk_bf16(v1[0], v1[1]); w.w = cvt_pk_bf16(v1[2], v1[3]);
                        *(u32x4*)(P + (size_t)row * 2304 + hb * 64 + 8 * qd) = w;
                    }
                }
            }
    }
};
template <class Epi, class Sched, bool ALIGN_EPI = false, bool SP2 = false>
__device__ __forceinline__ void gemm_phase(PG8_LAS unsigned char* lds, const Gemm g, const Sched& S, const Epi& E) {
    const int tid = threadIdx.x, wid = __builtin_amdgcn_readfirstlane(tid >> 6), lane = tid & 63, wr = wid >> 2, wc = wid & 3, fr = lane & 15, fq = lane >> 4;
    const int K = g.K, nt = K / BK;
    unsigned voffA[2], voffB[2];
#pragma unroll
    for (int i = 0; i < 2; ++i) { int R, C; stage_rc(tid * 16 + i * 8192, R, C); const int Rb = Epi::PERM ? ((R & ~31) + perm32(R & 31)) : R;
        voffA[i] = (unsigned)(R * K + C) * 2u; voffB[i] = (unsigned)(Rb * K + C) * 2u; }
    const size_t kstep = (size_t)(BK * 2);
    const size_t hstep = (size_t)HALF * K * 2;
    const size_t tstep = 2 * hstep;
    const unsigned ldsw = (unsigned)wid * 1024u;
    const int aoff = lds_byte(wr * 64 + fr, fq * 8), boff = lds_byte(wc * 32 + fr, fq * 8);
#define PG8_SA(b, h) (((b) * 2 + (h)) * HTB)
#define PG8_SB(b, h) ((4 + (b) * 2 + (h)) * HTB)
#define PG8_STAGE(bufoff, gbase, voff) do { _Pragma("unroll") for (int _i = 0; _i < 2; ++_i) \
        __builtin_amdgcn_global_load_lds((const unsigned*)((const char*)(gbase) + (voff)[_i]), (PG8_LAS unsigned*)(lds + (bufoff) + ldsw + _i * 8192), 16, 0, 0); } while (0)
#define PG8_LDA(dst, b, h) do { _Pragma("unroll") for (int m = 0; m < 4; ++m) _Pragma("unroll") for (int k = 0; k < 2; ++k) dst[m][k] = *(const PG8_LAS bf16x8*)(lds + PG8_SA(b, h) + aoff + m * 2048 + k * 1024); } while (0)
#define PG8_LDB(dst, b, h) do { _Pragma("unroll") for (int n = 0; n < 2; ++n) _Pragma("unroll") for (int k = 0; k < 2; ++k) dst[n][k] = *(const PG8_LAS bf16x8*)(lds + PG8_SB(b, h) + boff + n * 2048 + k * 1024); } while (0)
#define PG8_MMA(ai, bj, At, Bt) do { __builtin_amdgcn_s_setprio(1); _Pragma("unroll") for (int m = 0; m < 4; ++m) _Pragma("unroll") for (int n = 0; n < 2; ++n) _Pragma("unroll") for (int k = 0; k < 2; ++k) \
        acc[ai][bj][m][n] = __builtin_amdgcn_mfma_f32_16x16x32_bf16(Bt[n][k], At[m][k], acc[ai][bj][m][n], 0, 0, 0); __builtin_amdgcn_s_setprio(0); } while (0)
#define PG8_WAIT_V(n) asm volatile("s_waitcnt vmcnt(" #n ")" ::: "memory")
#define PG8_WAIT_L(n) asm volatile("s_waitcnt lgkmcnt(" #n ")" ::: "memory")
#define PG8_BAR __builtin_amdgcn_s_barrier()
#define PG8_SCHED __builtin_amdgcn_sched_barrier(0)
    Unit cur, nxt; int ui = 0;
    if (!S.next(0, cur)) return;
    f32x4 acc[2][2][4][2];
#pragma unroll
    for (int a = 0; a < 2; ++a)
#pragma unroll
        for (int b = 0; b < 2; ++b)
#pragma unroll
            for (int m = 0; m < 4; ++m)
#pragma unroll
                for (int n = 0; n < 2; ++n) acc[a][b][m][n] = (f32x4){0.f, 0.f, 0.f, 0.f};
    bf16x8 At[4][2], B0[2][2], B1[2][2];
    const char* cA = (const char*)g.A + (size_t)cur.pm * tstep; const char* cB = (const char*)g.Bt + (size_t)cur.pn * tstep;
    S.a_ready(cur);
    if constexpr (SP2) {
        PG8_STAGE(PG8_SB(0, 0), cB, voffB); PG8_STAGE(PG8_SB(0, 1), cB + hstep, voffB); PG8_STAGE(PG8_SA(0, 0), cA, voffA); PG8_STAGE(PG8_SA(0, 1), cA + hstep, voffA);
        if (wr == 1) PG8_BAR;
        PG8_WAIT_V(2); PG8_BAR;
        PG8_STAGE(PG8_SB(1, 0), cB + kstep, voffB); PG8_STAGE(PG8_SA(1, 0), cA + kstep, voffA); PG8_STAGE(PG8_SB(1, 1), cB + hstep + kstep, voffB);
        PG8_WAIT_V(6); PG8_BAR;
    } else {
        PG8_STAGE(PG8_SB(0, 0), cB, voffB); PG8_STAGE(PG8_SA(0, 0), cA, voffA); PG8_STAGE(PG8_SB(0, 1), cB + hstep, voffB); PG8_STAGE(PG8_SA(0, 1), cA + hstep, voffA);
        if (wr == 1) PG8_BAR;
        PG8_WAIT_V(4); PG8_BAR;
        PG8_STAGE(PG8_SB(1, 0), cB + kstep, voffB); PG8_STAGE(PG8_SA(1, 0), cA + kstep, voffA); PG8_STAGE(PG8_SB(1, 1), cB + hstep + kstep, voffB);
        PG8_WAIT_V(6); PG8_BAR;
    }
    for (;;) {
        const bool has_next = S.next(ui + 1, nxt);
        const char* nA = has_next ? (const char*)g.A + (size_t)nxt.pm * tstep : cA; const char* nB = has_next ? (const char*)g.Bt + (size_t)nxt.pn * tstep : cB;
        for (int t = 0; t < nt; t += 2) {
            const bool last = (t == nt - 2);
            const char* a1 = cA + (size_t)(t + 1) * kstep;
            const char* a2 = last ? nA : cA + (size_t)(t + 2) * kstep; const char* b2 = last ? nB : cB + (size_t)(t + 2) * kstep;
            const char* a3 = a2 + kstep; const char* b3 = b2 + kstep;
            if (last && has_next) S.a_ready(nxt);
            if constexpr (SP2) {
            PG8_LDB(B0, 0, 0); PG8_LDB(B1, 0, 1); PG8_SCHED; PG8_LDA(At, 0, 0); PG8_STAGE(PG8_SA(1, 1), a1 + hstep, voffA);
            PG8_WAIT_V(8); PG8_WAIT_L(0); PG8_BAR; PG8_MMA(0, 0, At, B0); PG8_MMA(0, 1, At, B1); PG8_BAR; PG8_SCHED;
            PG8_LDA(At, 0, 1); PG8_STAGE(PG8_SB(0, 0), b2, voffB); PG8_STAGE(PG8_SB(0, 1), b2 + hstep, voffB); PG8_STAGE(PG8_SA(0, 0), a2, voffA);
            PG8_WAIT_V(8); PG8_WAIT_L(0); PG8_BAR; PG8_MMA(1, 0, At, B0); PG8_MMA(1, 1, At, B1); PG8_BAR; PG8_SCHED;
            PG8_LDB(B0, 1, 0); PG8_LDB(B1, 1, 1); PG8_SCHED; PG8_LDA(At, 1, 0); PG8_STAGE(PG8_SA(0, 1), a2 + hstep, voffA);
            PG8_WAIT_V(8); PG8_WAIT_L(0); PG8_BAR; PG8_MMA(0, 0, At, B0); PG8_MMA(0, 1, At, B1); PG8_BAR; PG8_SCHED;
            PG8_LDA(At, 1, 1); PG8_STAGE(PG8_SB(1, 0), b3, voffB); PG8_STAGE(PG8_SB(1, 1), b3 + hstep, voffB); PG8_STAGE(PG8_SA(1, 0), a3, voffA);
            PG8_WAIT_V(8); PG8_WAIT_L(0); PG8_BAR; PG8_MMA(1, 0, At, B0); PG8_MMA(1, 1, At, B1); PG8_BAR; PG8_SCHED;
            } else {
            PG8_LDB(B0, 0, 0); PG8_SCHED; PG8_LDA(At, 0, 0); PG8_STAGE(PG8_SA(1, 1), a1 + hstep, voffA);
            PG8_WAIT_L(8); PG8_BAR; PG8_WAIT_L(0); PG8_MMA(0, 0, At, B0); PG8_BAR; PG8_SCHED;
            PG8_LDB(B1, 0, 1); PG8_STAGE(PG8_SB(0, 0), b2, voffB);
            PG8_BAR; PG8_WAIT_L(0); PG8_MMA(0, 1, At, B1); PG8_BAR;
            PG8_LDA(At, 0, 1); PG8_STAGE(PG8_SA(0, 0), a2, voffA);
            PG8_BAR; PG8_WAIT_L(0); PG8_MMA(1, 0, At, B0); PG8_BAR; PG8_SCHED;
            PG8_STAGE(PG8_SB(0, 1), b2 + hstep, voffB);
            PG8_WAIT_V(6); PG8_BAR; PG8_MMA(1, 1, At, B1); PG8_BAR;
            PG8_LDB(B0, 1, 0); PG8_SCHED; PG8_LDA(At, 1, 0); PG8_STAGE(PG8_SA(0, 1), a2 + hstep, voffA);
            PG8_WAIT_L(8); PG8_BAR; PG8_WAIT_L(0); PG8_MMA(0, 0, At, B0); PG8_BAR; PG8_SCHED;
            PG8_LDB(B1, 1, 1); PG8_STAGE(PG8_SB(1, 0), b3, voffB);
            PG8_BAR; PG8_WAIT_L(0); PG8_MMA(0, 1, At, B1); PG8_BAR;
            PG8_LDA(At, 1, 1); PG8_STAGE(PG8_SA(1, 0), a3, voffA);
            PG8_BAR; PG8_WAIT_L(0); PG8_MMA(1, 0, At, B0); PG8_BAR; PG8_SCHED;
            PG8_STAGE(PG8_SB(1, 1), b3 + hstep, voffB);
            PG8_WAIT_V(6); PG8_BAR; PG8_MMA(1, 1, At, B1); PG8_BAR;
            }
        }
        if constexpr (ALIGN_EPI) { if (wr == 0) PG8_BAR; }
        if constexpr (!Epi::AFTER_DRAIN) { E(acc, cur, wr, wc, fr, fq); S.done(cur); }
        if (!has_next) break;
#pragma unroll
        for (int a = 0; a < 2; ++a)
#pragma unroll
            for (int b = 0; b < 2; ++b)
#pragma unroll
                for (int m = 0; m < 4; ++m)
#pragma unroll
                    for (int n = 0; n < 2; ++n) acc[a][b][m][n] = (f32x4){0.f, 0.f, 0.f, 0.f};
        cur = nxt; cA = nA; cB = nB; ++ui;
        if constexpr (ALIGN_EPI) { if (wr == 1) PG8_BAR; }
    }
    PG8_WAIT_V(0);
    if constexpr (!ALIGN_EPI) { if (wr == 0) PG8_BAR; }
    PG8_BAR;
    if constexpr (Epi::AFTER_DRAIN) { E.fused(acc, cur, wr, wc, fr, fq, lds, wid, lane); S.done(cur); }
#undef PG8_SA
#undef PG8_SB
#undef PG8_STAGE
#undef PG8_LDA
#undef PG8_LDB
#undef PG8_MMA
#undef PG8_WAIT_V
#undef PG8_WAIT_L
#undef PG8_BAR
#undef PG8_SCHED
}
}

constexpr int NB = 32, T = 2048, D = 1024, M = NB * T, FF = 4096, NPROJ = 2304, PP = NPROJ;
constexpr int HB_QN = 0, HB_KC = 8, HB_VC = 10, HB_KSL = 12, HB_VSL = 14, HB_KW = 16, HB_VW = 18, HB_QD = 20, HB_KD = 28, HB_VD = 29, HB_QI = 30, HB_KI = 34, HB_MISC = 35;
constexpr int NWAVES = 8, NTHR = 512;
constexpr float RMS_EPS = 1e-6f;

constexpr size_t MiB = 1u << 20;
constexpr size_t WS_CTL = 0, CTL_ZERO_BYTES = 64 * 1024;
constexpr size_t WS_MOD = 1 * MiB;
constexpr size_t WS_BIASC = 1 * MiB + 800 * 1024;
constexpr size_t WS_CS = 2 * MiB;
constexpr size_t WS_WIN = 18 * MiB;
constexpr size_t WS_WOUT = 23 * MiB;
constexpr size_t WS_WUP = 25 * MiB;
constexpr size_t WS_WDOWN = 33 * MiB;
constexpr size_t WS_W1K = 41 * MiB, WS_W1V = 41 * MiB + 512 * 1024;
constexpr size_t WS_W2K = 42 * MiB, WS_W2V = 42 * MiB + 64 * 1024;
constexpr size_t WS_KCMP = 43 * MiB, WS_VCMP = 44 * MiB;
constexpr size_t WS_MISC = 45 * MiB;
constexpr size_t WS_XN = 64 * MiB;
constexpr size_t WS_P = 192 * MiB;
constexpr size_t WS_SC = 480 * MiB;
constexpr size_t WS_END = 992 * MiB;
constexpr int SC_TILES_PER_B = 528;

constexpr int RING_BYTES = 131072;
constexpr int MISC_OFF = RING_BYTES + 320;
constexpr int LDS_BYTES = 147456;

#define LAS __attribute__((address_space(3)))
typedef unsigned short bf16;
typedef short bf16x8 __attribute__((ext_vector_type(8)));
typedef short s16x4 __attribute__((ext_vector_type(4)));
typedef float f32x4 __attribute__((ext_vector_type(4)));
typedef float f32x16 __attribute__((ext_vector_type(16)));
typedef unsigned u32x4 __attribute__((ext_vector_type(4)));
typedef unsigned u32x2 __attribute__((ext_vector_type(2)));
typedef unsigned long long u64;
#define MFMA32(a, b, c) __builtin_amdgcn_mfma_f32_32x32x16_bf16((a), (b), (c), 0, 0, 0)
#define LDS_WAIT() asm volatile("s_waitcnt lgkmcnt(0)" ::: "memory")

DI unsigned pk2(float lo, float hi) { return pg8::cvt_pk_bf16(lo, hi); }
DI float bf2f(unsigned short v) { return __uint_as_float((unsigned)v << 16); }
DI int crow(int r, int hi) { return (r & 3) + 8 * (r >> 2) + 4 * hi; }
DI float wave_sum(float v) {
#pragma unroll
    for (int o = 1; o < 64; o <<= 1) v += __shfl_xor(v, o);
    return v;
}
DI int launder(int x) { asm volatile("" : "+v"(x)); return x; }
DI float fast_exp2(float x) { return __builtin_amdgcn_exp2f(x); }
DI float gelu_tanh(float x) {
    const float u = 0.7978845608028654f * (x + 0.044715f * x * x * x);
    const float e = __expf(2.0f * u);
    const float th = 1.0f - 2.0f / (e + 1.0f);
    return 0.5f * x * (1.0f + th);
}

struct Frame {
    LAS unsigned char* lds;
    volatile LAS unsigned* MISC;
    unsigned char* ws;
    int tid, lane, wave, G, bid;
};
struct Args { const void* in[19]; float* out; unsigned char* ws; int ph_lo, ph_hi, coop, pad; };
#define WSP(type, off) ((type*)(F.ws + (off)))
#define INP(type, i) ((const type*)A.in[i])

DI int q_next(Frame& F, unsigned* ctr) {
    __syncthreads();
    if (F.tid == 0) F.MISC[0] = __hip_atomic_fetch_add(ctr, 1u, __ATOMIC_RELAXED, __HIP_MEMORY_SCOPE_AGENT);
    __syncthreads();
    return (int)F.MISC[0];
}

DI int proj_src_col(int n) {
    const int hb = n >> 6, p = n & 63;
    if (hb == 35) return p < 24 ? 1280 + p : (p < 28 ? 2264 + (p - 24) : -1);
    const int base = hb < 20 ? 64 * hb : 1304 + 64 * (hb - 20);
    constexpr u64 ROPE_MASK = 0x00000007DFF333FFull;
    int d = p;
    if ((ROPE_MASK >> hb) & 1ull) { const int q = p >> 3, i = p & 7; d = i < 4 ? 4 * q + i : 32 + 4 * q + (i - 4); }
    return base + d;
}
template <bool PERMUTE> DI void transpose_item(const float* W, int ldw, int K, int N, bf16* WT, LAS float* scr, int item, int lane) {
    const int nblk = N / 32, kb = item / nblk, nb = item % nblk, k0 = 64 * kb, n0 = 32 * nb;
    const int ncol = n0 + (lane & 31); const int src = PERMUTE ? proj_src_col(ncol) : ncol;
#pragma unroll 8
    for (int i = 0; i < 32; ++i) { const int kk = 2 * i + (lane >> 5); scr[kk * 33 + (lane & 31)] = src >= 0 ? W[(size_t)(k0 + kk) * ldw + src] : 0.f; }
    LDS_WAIT();
    const int cch = lane & 7;
#pragma unroll
    for (int j = 0; j < 4; ++j) { const int n = (lane >> 3) + 8 * j; const LAS float* s = scr + (8 * cch) * 33 + n;
        u32x4 o; o.x = pk2(s[0 * 33], s[1 * 33]); o.y = pk2(s[2 * 33], s[3 * 33]); o.z = pk2(s[4 * 33], s[5 * 33]); o.w = pk2(s[6 * 33], s[7 * 33]);
        *(u32x4*)(WT + (size_t)(n0 + n) * K + k0 + 8 * cch) = o; }
    LDS_WAIT();
}
DI void phase_p0(Frame& F, const Args& A) {
    LAS float* scr = (LAS float*)(F.lds + F.wave * 16384);
    const int gw = F.bid * NWAVES + F.wave, NGW = F.G * NWAVES;
    constexpr int I_IN = (D / 64) * (NPROJ / 32), I_OUT = (D / 64) * (D / 32), I_UP = (D / 64) * (FF / 32), I_DN = (FF / 64) * (D / 32), I_W1 = (2048 / 64) * (128 / 32), I_W2 = (128 / 64) * (64 / 32);
    constexpr int NITEMS = I_IN + I_OUT + I_UP + I_DN + 2 * I_W1 + 2 * I_W2;
    for (int it = gw; it < NITEMS; it += NGW) {
        int r = it;
        if (r < I_IN) { transpose_item<true>(INP(float, 9), 2268, D, NPROJ, WSP(bf16, WS_WIN), scr, r, F.lane); continue; } r -= I_IN;
        if (r < I_OUT) { transpose_item<false>(INP(float, 16), D, D, D, WSP(bf16, WS_WOUT), scr, r, F.lane); continue; } r -= I_OUT;
        if (r < I_UP) { transpose_item<false>(INP(float, 17), FF, D, FF, WSP(bf16, WS_WUP), scr, r, F.lane); continue; } r -= I_UP;
        if (r < I_DN) { transpose_item<false>(INP(float, 18), D, FF, D, WSP(bf16, WS_WDOWN), scr, r, F.lane); continue; } r -= I_DN;
        if (r < I_W1) { transpose_item<false>(INP(float, 12), 128, 2048, 128, WSP(bf16, WS_W1K), scr, r, F.lane); continue; } r -= I_W1;
        if (r < I_W1) { transpose_item<false>(INP(float, 14), 128, 2048, 128, WSP(bf16, WS_W1V), scr, r, F.lane); continue; } r -= I_W1;
        if (r < I_W2) { transpose_item<false>(INP(float, 13), 64, 128, 64, WSP(bf16, WS_W2K), scr, r, F.lane); continue; } r -= I_W2;
        transpose_item<false>(INP(float, 15), 64, 128, 64, WSP(bf16, WS_W2V), scr, r, F.lane);
    }
    const int gt = F.bid * NTHR + F.tid, NGT = F.G * NTHR;
    for (int idx = gt; idx < NB * 6 * D; idx += NGT) {
        const int b = idx / (6 * D), j = idx % (6 * D);
        const float* cb = INP(float, 1) + b * D; const float* wp = INP(float, 3) + j;
        float a0 = 0.f, a1 = 0.f, a2 = 0.f, a3 = 0.f;
#pragma unroll 4
        for (int k = 0; k < D; k += 4) {
            a0 = fmaf(cb[k], wp[(size_t)k * (6 * D)], a0); a1 = fmaf(cb[k + 1], wp[(size_t)(k + 1) * (6 * D)], a1);
            a2 = fmaf(cb[k + 2], wp[(size_t)(k + 2) * (6 * D)], a2); a3 = fmaf(cb[k + 3], wp[(size_t)(k + 3) * (6 * D)], a3);
        }
        WSP(float, WS_MOD)[idx] = INP(float, 4)[j] + ((a0 + a1) + (a2 + a3));
    }
    for (int idx = gt; idx < M * 32; idx += NGT) {
        const int m = idx >> 5, d = idx & 31;
        const float inv = powf(10000.0f, -(float)d / 32.0f);
        const float ang = (float)INP(int, 2)[m] * inv;
        WSP(float, WS_CS)[2 * (size_t)idx] = cosf(ang); WSP(float, WS_CS)[2 * (size_t)idx + 1] = sinf(ang);
    }
    if (gw < 4) {
        const int kv = gw >> 1, j = (gw & 1) * 64 + F.lane;
        const float* pe = kv ? INP(float, 11) : INP(float, 10); const float* w1 = kv ? INP(float, 14) : INP(float, 12);
        float a0 = 0.f, a1 = 0.f;
#pragma unroll 4
        for (int k = 0; k < 2048; k += 2) { a0 = fmaf(pe[k], w1[(size_t)k * 128 + j], a0); a1 = fmaf(pe[k + 1], w1[(size_t)(k + 1) * 128 + j], a1); }
        WSP(float, WS_BIASC)[kv * 128 + j] = a0 + a1;
    }
}

DI void phase_e0(Frame& F, const Args& A) {
    const int gw = F.bid * NWAVES + F.wave, NGW = F.G * NWAVES;
    const int per = (M + NGW - 1) / NGW; const int r0 = gw * per, r1 = (r0 + per < M) ? r0 + per : M;
    for (int m = r0; m < r1; ++m) {
        const int b = m / T;
        const f32x4* xr = (const f32x4*)(INP(float, 0) + (size_t)m * D) + F.lane;
        const float* mod = WSP(float, WS_MOD) + (size_t)b * 6 * D;
        f32x4 v[4]; float s = 0.f;
#pragma unroll
        for (int j = 0; j < 4; ++j) { v[j] = xr[64 * j]; s += (v[j].x * v[j].x + v[j].y * v[j].y) + (v[j].z * v[j].z + v[j].w * v[j].w); }
        const float rstd = 1.0f / sqrtf(wave_sum(s) * (1.0f / D) + RMS_EPS);
        u64* o8 = (u64*)(WSP(bf16, WS_XN) + (size_t)m * D) + F.lane;
#pragma unroll
        for (int j = 0; j < 4; ++j) {
            const int col = 4 * F.lane + 256 * j;
            const f32x4 g = *(const f32x4*)(INP(float, 5) + col), sc = *(const f32x4*)(mod + D + col), sh = *(const f32x4*)(mod + col);
            const f32x4 h = v[j] * rstd * g * (sc + 1.0f) + sh;
            o8[64 * j] = (u64)pk2(h.x, h.y) | ((u64)pk2(h.z, h.w) << 32);
        }
    }
}

DI void phase_e1(Frame& F, const Args& A, const bf16* OPROJ) {
    const int gw = F.bid * NWAVES + F.wave, NGW = F.G * NWAVES;
    const int per = (M + NGW - 1) / NGW; const int r0 = gw * per, r1 = (r0 + per < M) ? r0 + per : M;
    for (int m = r0; m < r1; ++m) {
        const int b = m / T;
        const f32x4* xr = (const f32x4*)(INP(float, 0) + (size_t)m * D) + F.lane;
        const u64* orow = (const u64*)(OPROJ + (size_t)m * D) + F.lane;
        const float* mod = WSP(float, WS_MOD) + (size_t)b * 6 * D;
        f32x4 o[4]; float s = 0.f;
#pragma unroll
        for (int j = 0; j < 4; ++j) { const u64 w = orow[64 * j];
            o[j].x = bf2f((unsigned short)w); o[j].y = bf2f((unsigned short)(w >> 16)); o[j].z = bf2f((unsigned short)(w >> 32)); o[j].w = bf2f((unsigned short)(w >> 48));
            s += (o[j].x * o[j].x + o[j].y * o[j].y) + (o[j].z * o[j].z + o[j].w * o[j].w); }
        const float rstd = 1.0f / sqrtf(wave_sum(s) * (1.0f / D) + RMS_EPS);
        f32x4 x2[4]; float s2 = 0.f;
        f32x4* outr = (f32x4*)(A.out + (size_t)m * D) + F.lane;
#pragma unroll
        for (int j = 0; j < 4; ++j) {
            const int col = 4 * F.lane + 256 * j;
            const f32x4 g = *(const f32x4*)(INP(float, 6) + col), gt = *(const f32x4*)(mod + 2 * D + col);
            x2[j] = xr[64 * j] + gt * (o[j] * rstd * g);
            outr[64 * j] = x2[j];
            s2 += (x2[j].x * x2[j].x + x2[j].y * x2[j].y) + (x2[j].z * x2[j].z + x2[j].w * x2[j].w);
        }
        const float rstd2 = 1.0f / sqrtf(wave_sum(s2) * (1.0f / D) + RMS_EPS);
        u64* o8 = (u64*)(WSP(bf16, WS_XN) + (size_t)m * D) + F.lane;
#pragma unroll
        for (int j = 0; j < 4; ++j) {
            const int col = 4 * F.lane + 256 * j;
            const f32x4 g = *(const f32x4*)(INP(float, 7) + col), sc = *(const f32x4*)(mod + 4 * D + col), sh = *(const f32x4*)(mod + 3 * D + col);
            const f32x4 h = x2[j] * rstd2 * g * (sc + 1.0f) + sh;
            o8[64 * j] = (u64)pk2(h.x, h.y) | ((u64)pk2(h.z, h.w) << 32);
        }
    }
}
DI void phase_e2(Frame& F, const Args& A, const bf16* Y) {
    const int gw = F.bid * NWAVES + F.wave, NGW = F.G * NWAVES;
    const int per = (M + NGW - 1) / NGW; const int r0 = gw * per, r1 = (r0 + per < M) ? r0 + per : M;
    for (int m = r0; m < r1; ++m) {
        const int b = m / T;
        const u64* yrow = (const u64*)(Y + (size_t)m * D) + F.lane;
        const float* mod = WSP(float, WS_MOD) + (size_t)b * 6 * D;
        f32x4 y[4]; float s = 0.f;
#pragma unroll
        for (int j = 0; j < 4; ++j) { const u64 w = yrow[64 * j];
            y[j].x = bf2f((unsigned short)w); y[j].y = bf2f((unsigned short)(w >> 16)); y[j].z = bf2f((unsigned short)(w >> 32)); y[j].w = bf2f((unsigned short)(w >> 48));
            s += (y[j].x * y[j].x + y[j].y * y[j].y) + (y[j].z * y[j].z + y[j].w * y[j].w); }
        const float rstd = 1.0f / sqrtf(wave_sum(s) * (1.0f / D) + RMS_EPS);
        f32x4* outr = (f32x4*)(A.out + (size_t)m * D) + F.lane;
#pragma unroll
        for (int j = 0; j < 4; ++j) {
            const int col = 4 * F.lane + 256 * j;
            const f32x4 g = *(const f32x4*)(INP(float, 8) + col), gt = *(const f32x4*)(mod + 5 * D + col);
            outr[64 * j] = outr[64 * j] + gt * (y[j] * rstd * g);
        }
    }
}

constexpr int KT_STRIDE = 144, KT_BYTES = 64 * KT_STRIDE, VT_BYTES = 64 * 128;
DI int vt_off(int row, int colbyte) { return row * 128 + (colbyte ^ (((row >> 1) & 1) << 6)); }
struct KVRegs { u32x4 k, v; };
DI void kv_load(KVRegs& r, const bf16* Kg, const bf16* Vg, int tid) {
    const int row = tid >> 3, ch = tid & 7;
    r.k = *(const u32x4*)(Kg + (size_t)row * PP + ch * 8); r.v = *(const u32x4*)(Vg + (size_t)row * PP + ch * 8);
}
DI void kv_store(LAS unsigned char* Kl, LAS unsigned char* Vl, const KVRegs& r, int tid) {
    const int row = tid >> 3, ch = tid & 7;
    *(LAS u32x4*)(Kl + row * KT_STRIDE + ch * 16) = r.k; *(LAS u32x4*)(Vl + vt_off(row, ch * 16)) = r.v;
}
typedef short v4i16_t __attribute__((ext_vector_type(4)));
DI s16x4 vtr(LAS const unsigned char* p) { return __builtin_bit_cast(s16x4, __builtin_amdgcn_ds_read_tr16_b64_v4i16((LAS v4i16_t*)p)); }
DI bf16x8 pack8(const f32x16& p, const int base) {
    u32x4 w; w.x = pk2(p[base], p[base + 1]); w.y = pk2(p[base + 2], p[base + 3]); w.z = pk2(p[base + 4], p[base + 5]); w.w = pk2(p[base + 6], p[base + 7]);
    return __builtin_bit_cast(bf16x8, w);
}
struct LaneAddr { int kb, vb0, vb1; };
DI LaneAddr lane_addr(int lane) {
    const int r32 = lane & 31, hi = lane >> 5, a = lane & 15, g1 = (lane >> 4) & 1, swz = (a >> 3) & 1;
    const int common = (4 * hi + (a >> 2)) * 128 + 32 * g1 + 8 * (a & 3);
    LaneAddr la; la.kb = r32 * KT_STRIDE + hi * 16; la.vb0 = common + 64 * swz; la.vb1 = common + 64 * (1 - swz);
    return la;
}
DI f32x16 qk_block(LAS const unsigned char* lds, const int koff, const bf16x8 (&qr)[4], const LaneAddr& la) {
    f32x16 s;
#pragma unroll
    for (int i = 0; i < 16; ++i) s[i] = 0.f;
    LAS const unsigned char* kb = lds + la.kb;
#pragma unroll
    for (int st = 0; st < 4; ++st) { const bf16x8 a = *(LAS const bf16x8*)(kb + (koff + st * 32)); s = MFMA32(a, qr[st], s); }
    return s;
}
DI void pv_step(f32x16 (&o)[2], LAS const unsigned char* lds, const int voff, const bf16x8 pw, const LaneAddr& la) {
    { const s16x4 lo = vtr(lds + la.vb0 + voff), hh = vtr(lds + la.vb0 + (voff + 1024));
      const bf16x8 vf = __builtin_shufflevector(lo, hh, 0, 1, 2, 3, 4, 5, 6, 7); o[0] = MFMA32(vf, pw, o[0]); }
    { const s16x4 lo = vtr(lds + la.vb1 + voff), hh = vtr(lds + la.vb1 + (voff + 1024));
      const bf16x8 vf = __builtin_shufflevector(lo, hh, 0, 1, 2, 3, 4, 5, 6, 7); o[1] = MFMA32(vf, pw, o[1]); }
}
DI void mask_block(f32x16& s, unsigned w  ) {
#pragma unroll
    for (int r = 0; r < 16; ++r) { const int sh = (r & 3) + 8 * (r >> 2); if (!((w >> sh) & 1u)) s[r] = -INFINITY; }
}
DI float block_max(const f32x16& s) { float m = s[0];
#pragma unroll
    for (int r = 1; r < 16; ++r) m = fmaxf(m, s[r]);
    return m; }
template <int KOFF, int VOFF>
DI void attn_tile(const bf16x8 (&qr)[4], LAS const unsigned char* lds, f32x16 (&o)[2], float& m_run, float& l_run, u64 vb, const LaneAddr& la, int hi) {
    __builtin_amdgcn_sched_barrier(0);
    f32x16 p0 = qk_block(lds, KOFF, qr, la), p1 = qk_block(lds, KOFF + 32 * KT_STRIDE, qr, la);
    __builtin_amdgcn_sched_barrier(0);
    mask_block(p0, (unsigned)vb >> (4 * hi)); mask_block(p1, (unsigned)(vb >> 32) >> (4 * hi));
    float mx = fmaxf(block_max(p0), block_max(p1));
    mx = fmaxf(mx, __shfl_xor(mx, 32));
    const float m_new = fmaxf(m_run, mx);
    const float alpha = fast_exp2(m_run - m_new);
    m_run = m_new;
    float rs = 0.f;
#pragma unroll
    for (int r = 0; r < 16; ++r) { p0[r] = fast_exp2(p0[r] - m_new); p1[r] = fast_exp2(p1[r] - m_new); rs += p0[r] + p1[r]; }
    l_run = l_run * alpha + rs;
#pragma unroll
    for (int r = 0; r < 16; ++r) { o[0][r] *= alpha; o[1][r] *= alpha; }
    __builtin_amdgcn_sched_barrier(0);
    pv_step(o, lds, VOFF + 0 * 128, pack8(p0, 0), la); __builtin_amdgcn_sched_barrier(0);
    pv_step(o, lds, VOFF + 16 * 128, pack8(p0, 8), la); __builtin_amdgcn_sched_barrier(0);
    pv_step(o, lds, VOFF + 32 * 128, pack8(p1, 0), la); __builtin_amdgcn_sched_barrier(0);
    pv_step(o, lds, VOFF + 48 * 128, pack8(p1, 8), la); __builtin_amdgcn_sched_barrier(0);
}
DI u64 causal_bits(int ql) { return ql >= 63 ? ~0ull : ((1ull << (ql + 1)) - 1ull); }

DI void compress_item(Frame& F, int item) {
    const int kv = item & 1, half = (item >> 1) & 1, g = (item >> 2) & 1, b = item >> 3;
    const int lane = launder(F.lane), r32 = lane & 31, hi = lane >> 5, wid = F.wave;
    const bf16* Pb = WSP(bf16, WS_P) + (size_t)b * T * PP + ((kv ? HB_VC : HB_KC) + g) * 64;
    const bf16* W1 = kv ? WSP(bf16, WS_W1V) : WSP(bf16, WS_W1K); const bf16* W2 = kv ? WSP(bf16, WS_W2V) : WSP(bf16, WS_W2K);
    const float* bias = WSP(float, WS_BIASC) + kv * 128;
    bf16* OUT = (kv ? WSP(bf16, WS_VCMP) : WSP(bf16, WS_KCMP)) + (size_t)((b * 2 + g) * 128) * 64;
    LAS unsigned char* H1 = F.lds;
    {
        const int mh = wid & 1, nq = wid >> 1;
        const int n = 64 * half + 32 * mh + r32, nc = n < 126 ? n : 126;
        const bf16* arow = Pb + (size_t)(16 * nc) * PP + hi * 8;
        const bf16* brow = W1 + (size_t)(32 * nq + r32) * 2048 + hi * 8;
        f32x16 acc;
#pragma unroll
        for (int i = 0; i < 16; ++i) acc[i] = 0.f;
#pragma unroll 2
        for (int l = 0; l < 32; ++l) {
#pragma unroll
            for (int ss = 0; ss < 4; ++ss) {
                const bf16x8 a = *(const bf16x8*)(arow + (size_t)l * PP + ss * 16);
                const bf16x8 bb = *(const bf16x8*)(brow + (4 * l + ss) * 16);
                acc = MFMA32(a, bb, acc);
            }
        }
        const float bj = bias[32 * nq + r32];
#pragma unroll
        for (int r = 0; r < 16; ++r) {
            const float h = gelu_tanh(acc[r] + bj);
            *(LAS unsigned short*)(H1 + (32 * mh + crow(r, hi)) * 272 + (32 * nq + r32) * 2) = (unsigned short)(pk2(h, 0.f) & 0xffffu);
        }
    }
    __syncthreads();
    if (wid < 4) {
        const int mh = wid & 1, dh = wid >> 1;
        f32x16 acc;
#pragma unroll
        for (int i = 0; i < 16; ++i) acc[i] = 0.f;
        LAS const unsigned char* ar = H1 + (32 * mh + r32) * 272 + hi * 16;
        const bf16* br = W2 + (size_t)(32 * dh + r32) * 128 + hi * 8;
#pragma unroll
        for (int st = 0; st < 8; ++st) {
            const bf16x8 a = *(LAS const bf16x8*)(ar + st * 32);
            const bf16x8 bb = *(const bf16x8*)(br + st * 16);
            acc = MFMA32(a, bb, acc);
        }
#pragma unroll
        for (int r = 0; r < 16; ++r) OUT[(size_t)(64 * half + 32 * mh + crow(r, hi)) * 64 + 32 * dh + r32] = (bf16)(pk2(acc[r], 0.f) & 0xffffu);
    }
    __syncthreads();
}

DI void score_unit(Frame& F, int b, int qb) {
    const int lane = launder(F.lane), r32 = lane & 31, hi = lane >> 5, wid = F.wave;
    const int qh = wid & 1, kvh = (wid >> 1) & 1, kpar = wid >> 2;
    const size_t rowq = (size_t)b * T + 64 * qb + 32 * qh + r32;
    bf16x8 qf[4][4];
#pragma unroll
    for (int h = 0; h < 4; ++h)
#pragma unroll
        for (int st = 0; st < 4; ++st) qf[h][st] = *(const bf16x8*)(WSP(bf16, WS_P) + rowq * PP + (HB_QI + h) * 64 + 16 * st + 8 * hi);
    const float idx_scale = 0.5f * 0.125f;
    const f32x4 wv = *(const f32x4*)(WSP(float, WS_MISC) + rowq * 32 + 24);
    const float w0 = wv[0] * idx_scale, w1 = wv[1] * idx_scale, w2 = wv[2] * idx_scale, w3 = wv[3] * idx_scale;
    float* tbase = WSP(float, WS_SC) + ((size_t)b * SC_TILES_PER_B + (size_t)(qb * (qb + 1) / 2)) * 4096 + (32 * qh + r32) * 64 + 32 * kvh + 4 * hi;
    for (int kb = kpar; kb <= qb; kb += 2) {
        const size_t rowk = (size_t)b * T + 64 * kb + 32 * kvh + r32;
        bf16x8 kf[4];
#pragma unroll
        for (int st = 0; st < 4; ++st) kf[st] = *(const bf16x8*)(WSP(bf16, WS_P) + rowk * PP + HB_KI * 64 + 16 * st + 8 * hi);
        f32x16 sc;
#pragma unroll
        for (int h = 0; h < 4; ++h) {
            f32x16 acc;
#pragma unroll
            for (int i = 0; i < 16; ++i) acc[i] = 0.f;
#pragma unroll
            for (int st = 0; st < 4; ++st) acc = MFMA32(kf[st], qf[h][st], acc);
            const float wh = h == 0 ? w0 : (h == 1 ? w1 : (h == 2 ? w2 : w3));
#pragma unroll
            for (int i = 0; i < 16; ++i) { const float rl = fmaxf(acc[i], 0.f); sc[i] = h == 0 ? wh * rl : fmaf(wh, rl, sc[i]); }
        }
        float* tp = tbase + (size_t)kb * 4096;
#pragma unroll
        for (int u = 0; u < 4; ++u) { f32x4 v = {sc[4 * u], sc[4 * u + 1], sc[4 * u + 2], sc[4 * u + 3]}; *(f32x4*)(tp + 8 * u) = v; }
    }
}
DI void phase_a1(Frame& F) {
    unsigned* ctr = WSP(unsigned, WS_CTL) + 64;
    for (;;) {
        const int it = q_next(F, ctr);
        if (it >= 256 + 1024) break;
        if (it < 256) compress_item(F, it);
        else { const int u = it - 256; score_unit(F, u & 31, 31 - (u >> 5)); }
    }
}

template <class MaskF>
DI void run_tiles(Frame& F, unsigned tmask, const bf16* Kg0, const bf16* Vg0,
                  const bf16x8 (&qr)[4], f32x16 (&o)[2], float& m_run, float& l_run, const MaskF mf, const LaneAddr& la, const int tid) {
    LAS unsigned char* KT = F.lds; LAS unsigned char* VT = F.lds + KT_BYTES;
    if (tmask == 0u) return;
    int j = __builtin_ctz(tmask); tmask &= tmask - 1u;
    KVRegs rg; kv_load(rg, Kg0 + (size_t)(64 * j) * PP, Vg0 + (size_t)(64 * j) * PP, tid);
    for (;;) {
        __syncthreads();
        kv_store(KT, VT, rg, tid);
        __syncthreads();
        int jn = -1;
        if (tmask) { jn = __builtin_ctz(tmask); tmask &= tmask - 1u; kv_load(rg, Kg0 + (size_t)(64 * jn) * PP, Vg0 + (size_t)(64 * jn) * PP, tid); }
        attn_tile<0, KT_BYTES>(qr, F.lds, o, m_run, l_run, mf(j), la, (tid >> 5) & 1);
        if (jn < 0) break;
        j = jn;
    }
}
struct SlcMask { unsigned sel; int tb, ql; DI u64 operator()(int j) const { return ((sel >> j) & 1u) ? (j == tb ? causal_bits(ql) : ~0ull) : 0ull; } };
struct WinMask { int tb, ql; DI u64 operator()(int j) const { return j == tb ? causal_bits(ql) : (j == tb - 8 ? ~causal_bits(ql) : ~0ull); } };
struct DsaMask { LAS const u64* row; DI u64 operator()(int j) const { return row[j]; } };

constexpr int NSA_KT = 0, NSA_VT = KT_BYTES, NSA_KC = NSA_VT + VT_BYTES, NSA_VC = NSA_KC + 128 * KT_STRIDE, NSA_IMP = NSA_VC + 128 * 128,
              NSA_SELM = NSA_IMP + 4 * 64 * 33 * 4, NSA_UM = NSA_SELM + 256, NSA_END = NSA_UM + 16;
static_assert(NSA_END <= RING_BYTES, "NSA LDS map");

DI void nsa_unit(Frame& F, int b, int g, int tb) {
    const int tid = launder(F.tid), lane = tid & 63, r32 = lane & 31, hi = lane >> 5, wid = F.wave;
    const int r = wid & 3, th = wid >> 2, hq = 4 * g + r, ql = 32 * th + r32, t = 64 * tb + ql;
    const size_t rowg = (size_t)b * T + t;
    LAS unsigned char* KC = F.lds + NSA_KC; LAS unsigned char* VC = F.lds + NSA_VC;
    const LaneAddr la = lane_addr(lane);
    LAS float* IMP = (LAS float*)(F.lds + NSA_IMP); LAS unsigned* SELM = (LAS unsigned*)(F.lds + NSA_SELM); LAS unsigned* UM = (LAS unsigned*)(F.lds + NSA_UM);
    bf16x8 qr[4];
#pragma unroll
    for (int st = 0; st < 4; ++st) qr[st] = *(const bf16x8*)(WSP(bf16, WS_P) + rowg * PP + hq * 64 + 16 * st + 8 * hi);
    float gate[3];
#pragma unroll
    for (int br = 0; br < 3; ++br) { const float xg = WSP(float, WS_MISC)[rowg * 32 + hq * 3 + br]; gate[br] = 1.0f / (1.0f + __expf(-xg)); }
    f32x16 ot[2];
#pragma unroll
    for (int i = 0; i < 16; ++i) { ot[0][i] = 0.f; ot[1][i] = 0.f; }
    {
        const bf16* kc = WSP(bf16, WS_KCMP) + (size_t)((b * 2 + g) * 128) * 64; const bf16* vc = WSP(bf16, WS_VCMP) + (size_t)((b * 2 + g) * 128) * 64;
#pragma unroll
        for (int ps = 0; ps < 2; ++ps) { const int row = (tid >> 3) + 64 * ps, ch = tid & 7;
            const u32x4 kk = *(const u32x4*)(kc + row * 64 + ch * 8), vv = *(const u32x4*)(vc + row * 64 + ch * 8);
            *(LAS u32x4*)(KC + row * KT_STRIDE + ch * 16) = kk; *(LAS u32x4*)(VC + vt_off(row, ch * 16)) = vv; }
        if (tid == 0) UM[0] = 0u;
    }
    __syncthreads();
    {
        const int nq = (t - 31) >> 4;
        float mx = -INFINITY;
#pragma unroll 1
        for (int c = 0; c < 4; ++c) {
            const f32x16 s = qk_block(F.lds, NSA_KC + c * 32 * KT_STRIDE, qr, la);
#pragma unroll
            for (int rg = 0; rg < 16; ++rg) if (32 * c + crow(rg, hi) <= nq) mx = fmaxf(mx, s[rg]);
        }
        mx = fmaxf(mx, __shfl_xor(mx, 32));
        const float ms = fmaxf(mx, -1e30f);
        float l = 0.f, carry = 0.f;
        LAS float* irow = IMP + (r * 64 + ql) * 33;
        f32x16 oc[2];
#pragma unroll
        for (int i = 0; i < 16; ++i) { oc[0][i] = 0.f; oc[1][i] = 0.f; }
#pragma unroll 1
        for (int c = 0; c < 4; ++c) {
            f32x16 p = qk_block(F.lds, NSA_KC + c * 32 * KT_STRIDE, qr, la);
#pragma unroll
            for (int rg = 0; rg < 16; ++rg) { p[rg] = (32 * c + crow(rg, hi) <= nq) ? fast_exp2(p[rg] - ms) : 0.f; l += p[rg]; }
            float sw[4];
#pragma unroll
            for (int u = 0; u < 4; ++u) sw[u] = __shfl_xor(p[4 * u + 3], 32);
#pragma unroll
            for (int u = 0; u < 4; ++u) {
                const float quad = (p[4 * u] + p[4 * u + 1]) + (p[4 * u + 2] + p[4 * u + 3]);
                const float prevlo = u > 0 ? sw[u > 0 ? u - 1 : 0] : carry;
                irow[8 * c + 2 * u + hi] = quad + (hi ? sw[u] : prevlo);
            }
            carry = sw[3];
            pv_step(oc, F.lds, NSA_VC + (32 * c) * 128, pack8(p, 0), la); pv_step(oc, F.lds, NSA_VC + (32 * c + 16) * 128, pack8(p, 8), la);
        }
        l += __shfl_xor(l, 32);
        const float inv = l > 0.f ? 1.0f / l : 0.f;
#pragma unroll
        for (int i = 0; i < 16; ++i) irow[2 * i + hi] *= inv;
        const float gs = gate[0] * inv;
#pragma unroll
        for (int i = 0; i < 16; ++i) { ot[0][i] = gs * oc[0][i]; ot[1][i] = gs * oc[1][i]; }
    }
    __syncthreads();
    if (tb < 16) {
        if (tid < 64) SELM[tid] = (2u << tb) - 1u;
        if (tid == 0) UM[0] = (2u << tb) - 1u;
    } else {
        const int j = lane & 31;
        unsigned um = 0u;
#pragma unroll 1
        for (int ps = 0; ps < 4; ++ps) {
            const int tq = wid * 8 + ps * 2 + hi;
            float v = ((IMP[(0 * 64 + tq) * 33 + j] + IMP[(1 * 64 + tq) * 33 + j]) + IMP[(2 * 64 + tq) * 33 + j]) + IMP[(3 * 64 + tq) * 33 + j];
            if (j > tb) v = -INFINITY; else if (j == 0 || j == tb || j == tb - 1) v = INFINITY;
            int rank = 0;
#pragma unroll 1
            for (int sft = 1; sft < 32; ++sft) {
                const int oj = (j + sft) & 31;
                const float ov = __shfl(v, (lane & 32) | oj);
                rank += (ov > v || (ov == v && oj < j)) ? 1 : 0;
            }
            const u64 bm = __ballot(rank < 16 && j <= tb);
            if (j == 0) SELM[tq] = hi ? (unsigned)(bm >> 32) : (unsigned)bm;
            um |= (unsigned)bm | (unsigned)(bm >> 32);
        }
        if (lane == 0) __hip_atomic_fetch_or(UM, um, __ATOMIC_RELAXED, __HIP_MEMORY_SCOPE_WORKGROUP);
    }
    __syncthreads();
    const unsigned umask = UM[0];
    const unsigned sel = SELM[ql];
    const bf16* Pb = WSP(bf16, WS_P) + (size_t)b * T * PP;
    {
        f32x16 o[2];
#pragma unroll
        for (int i = 0; i < 16; ++i) { o[0][i] = 0.f; o[1][i] = 0.f; }
        float m_run = -1e30f, l_run = 0.f;
        SlcMask mf{sel, tb, ql};
        run_tiles(F, umask, Pb + (HB_KSL + g) * 64, Pb + (HB_VSL + g) * 64, qr, o, m_run, l_run, mf, la, tid);
        float l = l_run + __shfl_xor(l_run, 32);
        const float sc = l > 0.f ? gate[1] / l : 0.f;
#pragma unroll
        for (int i = 0; i < 16; ++i) { ot[0][i] += sc * o[0][i]; ot[1][i] += sc * o[1][i]; }
    }
    {
        f32x16 o[2];
#pragma unroll
        for (int i = 0; i < 16; ++i) { o[0][i] = 0.f; o[1][i] = 0.f; }
        float m_run = -1e30f, l_run = 0.f;
        const int jlo = tb >= 8 ? tb - 8 : 0;
        const unsigned wmask = (tb == 31 ? ~0u : ((2u << tb) - 1u)) & ~((1u << jlo) - 1u);
        WinMask mf{tb, ql};
        run_tiles(F, wmask, Pb + (HB_KW + g) * 64, Pb + (HB_VW + g) * 64, qr, o, m_run, l_run, mf, la, tid);
        float l = l_run + __shfl_xor(l_run, 32);
        const float sc = l > 0.f ? gate[2] / l : 0.f;
#pragma unroll
        for (int i = 0; i < 16; ++i) { ot[0][i] += sc * o[0][i]; ot[1][i] += sc * o[1][i]; }
    }
    bf16* orow = WSP(bf16, WS_XN) + rowg * D + hq * 64 + 4 * hi;
#pragma unroll
    for (int db = 0; db < 2; ++db)
#pragma unroll
        for (int u = 0; u < 4; ++u) { u32x2 w; w.x = pk2(ot[db][4 * u], ot[db][4 * u + 1]); w.y = pk2(ot[db][4 * u + 2], ot[db][4 * u + 3]); *(u32x2*)(orow + 32 * db + 8 * u) = w; }
}

DI void dsa_select(const float* SCb, int t, int KB, LAS unsigned* hist, LAS unsigned* keys, LAS u64* mrow, int lane) {
    const int qb = t >> 6, ql = t & 63;
    if (t + 1 <= 256) {
        for (int i = 0; i < KB; ++i) { const u64 bm = __ballot(64 * i + lane <= t); if (lane == 0) mrow[i] = bm; }
        return;
    }
    const float* base = SCb + (size_t)(qb * (qb + 1) / 2) * 4096 + ql * 64 + lane;
#pragma unroll 4
    for (int i = 0; i < KB; ++i) {
        unsigned k = 0u;
        if (64 * i + lane <= t) { const float v = base[(size_t)i * 4096] + 0.0f; const unsigned u = __float_as_uint(v); k = (u & 0x80000000u) ? ~u : (u | 0x80000000u); }
        keys[i * 64 + lane] = k;
    }
    unsigned prefix = 0u; int rem = 256;
#pragma unroll 1
    for (int pass = 0; pass < 4; ++pass) {
        const int shift = 24 - 8 * pass;
        { u32x4 z = {0u, 0u, 0u, 0u}; *(LAS u32x4*)(hist + 4 * lane) = z; }
        LDS_WAIT();
        for (int i = 0; i < KB; ++i) {
            const unsigned k = keys[i * 64 + lane];
            const bool match = k != 0u && ((k >> 1) >> (shift + 7)) == prefix;
            if (match) __hip_atomic_fetch_add(hist + ((k >> shift) & 255u), 1u, __ATOMIC_RELAXED, __HIP_MEMORY_SCOPE_WORKGROUP);
        }
        LDS_WAIT();
        const u32x4 cc = *(LAS u32x4*)(hist + 4 * lane);
        LDS_WAIT();
        const int tot = (int)(cc.x + cc.y + cc.z + cc.w);
        int suf = tot;
#pragma unroll
        for (int off = 1; off < 64; off <<= 1) { const int y = __shfl_down(suf, off); if (lane + off < 64) suf += y; }
        const u64 bal = __ballot(suf >= rem);
        const int L = __popcll(bal) - 1;
        int cum = suf - tot, dsel;
        if (cum + (int)cc.w >= rem) dsel = 3;
        else { cum += (int)cc.w;
            if (cum + (int)cc.z >= rem) dsel = 2;
            else { cum += (int)cc.z;
                if (cum + (int)cc.y >= rem) dsel = 1;
                else { cum += (int)cc.y; dsel = 0; } } }
        const int dig = __shfl(4 * lane + dsel, L);
        rem -= __shfl(cum, L);
        prefix = (prefix << 8) | (unsigned)dig;
    }
    int running = 0;
    for (int i = 0; i < KB; ++i) {
        const unsigned k = keys[i * 64 + lane];
        const bool gt = k > prefix, eq = k == prefix;
        const u64 beq = __ballot(eq);
        const int mypos = running + __popcll(beq & ((1ull << lane) - 1ull));
        const bool sl = gt || (eq && mypos < rem);
        running += __popcll(beq);
        const u64 bm = __ballot(sl);
        if (lane == 0) mrow[i] = bm;
    }
}
constexpr int DSA_MB = KT_BYTES + VT_BYTES, DSA_HIST = DSA_MB + 32 * 33 * 8, DSA_KEYS = DSA_HIST + 8 * 1024, DSA_END = DSA_KEYS + 8 * 8192;
static_assert(DSA_END <= RING_BYTES, "DSA LDS map");
DI void dsa_unit(Frame& F, int b, int qb32) {
    const int tid = launder(F.tid), lane = tid & 63, r32 = lane & 31, hi = lane >> 5, wid = F.wave;
    const int t0 = 32 * qb32, KB = (qb32 >> 1) + 1;
    const LaneAddr la = lane_addr(lane);
    LAS u64* MB = (LAS u64*)(F.lds + DSA_MB); LAS unsigned* HIST = (LAS unsigned*)(F.lds + DSA_HIST) + wid * 256; LAS unsigned* KEYS = (LAS unsigned*)(F.lds + DSA_KEYS) + wid * 2048;
    const float* SCb = WSP(float, WS_SC) + (size_t)b * SC_TILES_PER_B * 4096;
    for (int qq = 0; qq < 4; ++qq) { const int qi = wid * 4 + qq; dsa_select(SCb, t0 + qi, KB, HIST, KEYS, MB + qi * 33, lane); }
    __syncthreads();
    const size_t rowg = (size_t)b * T + t0 + r32;
    bf16x8 qr[4];
#pragma unroll
    for (int st = 0; st < 4; ++st) qr[st] = *(const bf16x8*)(WSP(bf16, WS_P) + rowg * PP + (HB_QD + wid) * 64 + 16 * st + 8 * hi);
    f32x16 o[2];
#pragma unroll
    for (int i = 0; i < 16; ++i) { o[0][i] = 0.f; o[1][i] = 0.f; }
    float m_run = -1e30f, l_run = 0.f;
    const bf16* Pb = WSP(bf16, WS_P) + (size_t)b * T * PP;
    const unsigned tmask = KB >= 32 ? ~0u : ((1u << KB) - 1u);
    DsaMask mf{MB + r32 * 33};
    run_tiles(F, tmask, Pb + HB_KD * 64, Pb + HB_VD * 64, qr, o, m_run, l_run, mf, la, tid);
    const float l = l_run + __shfl_xor(l_run, 32);
    const float sc = l > 0.f ? 1.0f / l : 0.f;
    bf16* orow = WSP(bf16, WS_XN) + rowg * D + 512 + wid * 64 + 4 * hi;
#pragma unroll
    for (int db = 0; db < 2; ++db)
#pragma unroll
        for (int u = 0; u < 4; ++u) { u32x2 w; w.x = pk2(o[db][4 * u] * sc, o[db][4 * u + 1] * sc); w.y = pk2(o[db][4 * u + 2] * sc, o[db][4 * u + 3] * sc); *(u32x2*)(orow + 32 * db + 8 * u) = w; }
}
DI void phase_a2(Frame& F) {
    unsigned* ctr = WSP(unsigned, WS_CTL) + 128;
    for (;;) {
        const int it = q_next(F, ctr);
        if (it >= 4096) break;
        const int L = it >> 7, k = it & 127;
#ifndef NO_NSA
        if (k < 64) nsa_unit(F, k >> 1, k & 1, 31 - L);
#endif
#ifndef NO_DSA
        if (k >= 64) { const int kk = k - 64; dsa_unit(F, kk >> 1, 63 - 2 * L - (kk & 1)); }
#endif
    }
}

constexpr int N_PHASES = 10;
#ifndef PHASE_MASK
#define PHASE_MASK 0x3FF
#endif
#ifndef MK_COOP
#define MK_COOP 1
#endif

__global__ void __launch_bounds__(NTHR, 2) mega_fwd(Args args) {
    extern __shared__ __attribute__((aligned(16))) unsigned char lds_raw[];
    Frame F;
    F.lds = (LAS unsigned char*)lds_raw;
    F.MISC = (volatile LAS unsigned*)(F.lds + MISC_OFF);
    F.tid = threadIdx.x; F.lane = F.tid & 63; F.wave = __builtin_amdgcn_readfirstlane(F.tid >> 6);
    F.G = gridDim.x; F.bid = blockIdx.x;
    F.ws = args.ws;
    const Args& A = args;
    bf16* OPROJ = WSP(bf16, WS_P); bf16* Y = WSP(bf16, WS_P);

    const int lo = args.ph_lo, hi = args.ph_hi;
#define IN(k) (lo <= (k) && (k) < hi)
#define SEAM(k) do { if (IN(k) && IN((k) + 1)) { if (args.coop) cg::this_grid().sync(); } } while (0)

    if (((PHASE_MASK >> 0) & 1) && IN(0)) { phase_p0(F, A); }
    SEAM(0);
    if (((PHASE_MASK >> 1) & 1) && IN(1)) { phase_e0(F, A); }
    SEAM(1);
    if (((PHASE_MASK >> 2) & 1) && IN(2)) {
        pg8::Gemm g{WSP(bf16, WS_XN), WSP(bf16, WS_WIN), M, NPROJ, D}; pg8::StaticOrder S; S.init(M, NPROJ, F.G, F.bid);
        pg8::EpiProj E{WSP(bf16, WS_P), WSP(float, WS_MISC), WSP(float, WS_CS)};
        pg8::gemm_phase<pg8::EpiProj, pg8::StaticOrder, true, true>(F.lds, g, S, E);
    }
    SEAM(2);
    if (((PHASE_MASK >> 3) & 1) && IN(3)) { phase_a1(F); }
    SEAM(3);
    if (((PHASE_MASK >> 4) & 1) && IN(4)) { phase_a2(F); }
    SEAM(4);
    if (((PHASE_MASK >> 5) & 1) && IN(5)) {
        pg8::Gemm g{WSP(bf16, WS_XN), WSP(bf16, WS_WOUT), M, D, D}; pg8::StaticOrder S; S.init(M, D, F.G, F.bid);
        pg8::EpiStore<0> E{OPROJ, D};
        pg8::gemm_phase<pg8::EpiStore<0>, pg8::StaticOrder, true, true>(F.lds, g, S, E);
    }
    SEAM(5);
    if (((PHASE_MASK >> 6) & 1) && IN(6)) { phase_e1(F, A, OPROJ); }
    SEAM(6);
    if (((PHASE_MASK >> 7) & 1) && IN(7)) {
        pg8::Gemm g{WSP(bf16, WS_XN), WSP(bf16, WS_WUP), M, FF, D}; pg8::StaticOrder S; S.init(M, FF, F.G, F.bid);
        pg8::EpiStore<1> E{WSP(bf16, WS_SC), FF};
        pg8::gemm_phase<pg8::EpiStore<1>, pg8::StaticOrder, true, true>(F.lds, g, S, E);
    }
    SEAM(7);
    if (((PHASE_MASK >> 8) & 1) && IN(8)) {
        pg8::Gemm g{WSP(bf16, WS_SC), WSP(bf16, WS_WDOWN), M, D, FF}; pg8::StaticOrder S; S.init(M, D, F.G, F.bid);
        pg8::EpiStore<0> E{Y, D};
        pg8::gemm_phase<pg8::EpiStore<0>, pg8::StaticOrder, true, true>(F.lds, g, S, E);
    }
    SEAM(8);
    if (((PHASE_MASK >> 9) & 1) && IN(9)) { phase_e2(F, A, Y); }
#undef IN
#undef SEAM
}

extern "C" void kernel_launch(void* const* d_in, const int* in_sizes, int n_in, void* d_out, int out_size, void* d_ws, size_t ws_size, hipStream_t stream) {
    static int grid = 0;
    if (grid == 0) {
        if (n_in != 19 || in_sizes[0] != M * D || out_size != M * D || ws_size < WS_END) {
            fprintf(stderr, "kernel_launch: unexpected shapes: n_in %d in0 %d out %d ws %zu (need %zu)\n", n_in, n_in > 0 ? in_sizes[0] : -1, out_size, ws_size, (size_t)WS_END); grid = -1; return; }
        int dev = 0, cus = 0, per_cu = 0;
        if (hipGetDevice(&dev) != hipSuccess || hipDeviceGetAttribute(&cus, hipDeviceAttributeMultiprocessorCount, dev) != hipSuccess) { fprintf(stderr, "kernel_launch: device query failed\n"); grid = -1; return; }
        if (hipFuncSetAttribute((const void*)mega_fwd, hipFuncAttributeMaxDynamicSharedMemorySize, LDS_BYTES) != hipSuccess) { fprintf(stderr, "kernel_launch: hipFuncSetAttribute failed\n"); grid = -1; return; }
        if (hipOccupancyMaxActiveBlocksPerMultiprocessor(&per_cu, (const void*)mega_fwd, NTHR, LDS_BYTES) != hipSuccess || per_cu < 1) { fprintf(stderr, "kernel_launch: occupancy query says %d\n", per_cu); per_cu = 1; }
        (void)hipGetLastError();
        grid = cus;
        fprintf(stderr, "kernel_launch: cus %d per_cu %d grid %d\n", cus, per_cu, grid);
    }
    if (grid < 0) return;
    if (hipMemsetAsync((char*)d_ws + WS_CTL, 0, CTL_ZERO_BYTES, stream) != hipSuccess) { fprintf(stderr, "kernel_launch: memset failed\n"); return; }
    Args a{};
    for (int i = 0; i < 19; ++i) a.in[i] = d_in[i];
    a.out = (float*)d_out; a.ws = (unsigned char*)d_ws;
#if MK_COOP
    a.ph_lo = 0; a.ph_hi = N_PHASES; a.coop = 1;
    void* kargs[] = {&a};
    hipError_t e = hipLaunchCooperativeKernel((const void*)mega_fwd, dim3(grid), dim3(NTHR), kargs, LDS_BYTES, stream);
    if (e != hipSuccess) fprintf(stderr, "kernel_launch: cooperative launch failed: %s (grid %d)\n", hipGetErrorString(e), grid);
#else
    for (int ph = 0; ph < N_PHASES; ++ph) {
        a.ph_lo = ph; a.ph_hi = ph + 1; a.coop = 0;
        hipLaunchKernelGGL(mega_fwd, dim3(grid), dim3(NTHR), LDS_BYTES, stream, a);
        const hipError_t le = hipPeekAtLastError();
        if (le != hipSuccess) { fprintf(stderr, "kernel_launch: launch %d failed: %s\n", ph, hipGetErrorName(le)); break; }
    }
#endif
}
```

```cpp
#include <hip/hip_runtime.h>
#include <hip/hip_cooperative_groups.h>
#include <cstdio>
#include <cstdint>
namespace cg = cooperative_groups;
#define DI __device__ __forceinline__
namespace pg8 {
#define PG8_LAS __attribute__((address_space(3)))
typedef unsigned short bf16_t;
typedef short bf16x8 __attribute__((ext_vector_type(8)));
typedef float f32x4 __attribute__((ext_vector_type(4)));
typedef unsigned u32x4 __attribute__((ext_vector_type(4)));
constexpr int BM = 256, BK = 64, HALF = 128, HTB = HALF * BK * 2  , STAGE_BYTES = 8 * HTB, NXCD = 8, WGM = 8;

__host__ __device__ __forceinline__ int lds_byte(int r, int c) { const int st = (r >> 4) * 2 + (c >> 5), rr = r & 15, cc = c & 31, ob = rr * 64 + cc * 2; return st * 1024 + (ob ^ (((ob >> 9) & 1) << 5)); }
__host__ __device__ __forceinline__ void stage_rc(int b, int& R, int& C) { const int st = b / 1024, sb = b % 1024, swz = sb ^ (((sb >> 9) & 1) << 5); R = (st >> 1) * 16 + swz / 64; C = (st & 1) * 32 + (swz % 64) / 2; }
__host__ __device__ __forceinline__ int perm32(int rho) { const int n = rho >> 4, i = rho & 15; return 8 * (i >> 2) + 4 * n + (i & 3); }

struct Unit { int pm, pn; };
struct Gemm { const bf16_t* A; const bf16_t* Bt; int M, N, K; };

struct StaticOrder {
    int nM, nN, nwg, G, c;
    __host__ __device__ void init(int M, int N, int G_, int c_) { nM = M / BM; nN = N / BM; nwg = nM * nN; G = G_; c = c_; }
    __host__ __device__ bool next(int i, Unit& u) const {
        const long L = (long)i * G + c; if (L >= nwg) return false;
        int wgid = (int)L; { const int q = nwg / NXCD, r = nwg % NXCD, xcd = wgid % NXCD, off = wgid / NXCD; wgid = (xcd < r ? xcd * (q + 1) : r * (q + 1) + (xcd - r) * q) + off; }
        const int nig = WGM * nN, gid = wgid / nig, fm = gid * WGM, gsz = (nM - fm) < WGM ? (nM - fm) : WGM;
        u.pm = fm + ((wgid % nig) % gsz); u.pn = (wgid % nig) / gsz; return true;
    }
    __device__ __forceinline__ void a_ready(const Unit&) const {}
    __device__ __forceinline__ void done(const Unit&) const {}
};


typedef float f32x2 __attribute__((ext_vector_type(2)));
typedef unsigned u32x2 __attribute__((ext_vector_type(2)));
typedef __bf16 bf16x2_t __attribute__((ext_vector_type(2)));
__device__ __forceinline__ unsigned cvt_pk_bf16(float lo, float hi) { f32x2 v = {lo, hi}; bf16x2_t b = __builtin_convertvector(v, bf16x2_t); return __builtin_bit_cast(unsigned, b); }

template <int ACT  > struct EpiStore {
    static constexpr bool PERM = true, AFTER_DRAIN = false;
    bf16_t* O; int ldc;
    __device__ __forceinline__ void operator()(const f32x4 (&acc)[2][2][4][2], const Unit& u, int wr, int wc, int fr, int fq) const {
        const int row0 = u.pm * BM + wr * 64 + fr; const int col0 = u.pn * BM + wc * 32 + 8 * fq;
#pragma unroll
        for (int ai = 0; ai < 2; ++ai)
#pragma unroll
            for (int m = 0; m < 4; ++m) { bf16_t* rowp = O + (size_t)(row0 + ai * HALF + m * 16) * ldc + col0;
#pragma unroll
                for (int bj = 0; bj < 2; ++bj) { f32x4 v0 = acc[ai][bj][m][0], v1 = acc[ai][bj][m][1];
                    if (ACT == 1) {
#pragma unroll
                        for (int i = 0; i < 4; ++i) { const float a = v0[i] > 0.f ? v0[i] : 0.f, b = v1[i] > 0.f ? v1[i] : 0.f; v0[i] = a * a; v1[i] = b * b; } }
                    u32x4 w; w.x = cvt_pk_bf16(v0[0], v0[1]); w.y = cvt_pk_bf16(v0[2], v0[3]); w.z = cvt_pk_bf16(v1[0], v1[1]); w.w = cvt_pk_bf16(v1[2], v1[3]);
                    *(u32x4*)(rowp + bj * HALF) = w; } }
    }
};

struct EpiProj {
    static constexpr bool PERM = true, AFTER_DRAIN = false;
    bf16_t* P; float* MISC; const float* CS;
    __device__ __forceinline__ void operator()(const f32x4 (&acc)[2][2][4][2], const Unit& u, int wr, int wc, int fr, int fq) const {
        const int row0 = u.pm * BM + wr * 64 + fr; const int qd = 4 * (wc & 1) + fq;
        constexpr unsigned long long ROPE_MASK = 0x00000007DFF333FFull;
        constexpr float QSCALE = 0.125f * 1.4426950408889634f;
#pragma unroll
        for (int ai = 0; ai < 2; ++ai)
#pragma unroll
            for (int m = 0; m < 4; ++m) {
                const int row = row0 + ai * HALF + m * 16;
                const f32x4 c01 = *(const f32x4*)(CS + (size_t)row * 64 + 8 * qd), c23 = *(const f32x4*)(CS + (size_t)row * 64 + 8 * qd + 4);
                const float cs[4] = {c01[0], c01[2], c23[0], c23[2]}, sn[4] = {c01[1], c01[3], c23[1], c23[3]};
#pragma unroll
                for (int bj = 0; bj < 2; ++bj) {
                    const int hb = u.pn * 4 + bj * 2 + (wc >> 1);
                    const f32x4 v0 = acc[ai][bj][m][0], v1 = acc[ai][bj][m][1];
                    if (hb == 35) {
                        if (qd < 4) { *(f32x4*)(MISC + (size_t)row * 32 + 8 * qd) = v0; *(f32x4*)(MISC + (size_t)row * 32 + 8 * qd + 4) = v1; }
                    } else if ((ROPE_MASK >> hb) & 1ull) {
                        const float sc = (hb < 8 || (hb >= 20 && hb < 28)) ? QSCALE : 1.0f;
                        float o1[4], o2[4];
#pragma unroll
                        for (int i = 0; i < 4; ++i) { o1[i] = (v0[i] * cs[i] - v1[i] * sn[i]) * sc; o2[i] = (v1[i] * cs[i] + v0[i] * sn[i]) * sc; }
                        bf16_t* rp = P + (size_t)row * 2304 + hb * 64 + 4 * qd;
                        u32x2 a, b; a.x = cvt_pk_bf16(o1[0], o1[1]); a.y = cvt_pk_bf16(o1[2], o1[3]); b.x = cvt_pk_bf16(o2[0], o2[1]); b.y = cvt_pk_bf16(o2[2], o2[3]);
                        *(u32x2*)rp = a; *(u32x2*)(rp + 32) = b;
                    } else {
                        u32x4 w; w.x = cvt_pk_bf16(v0[0], v0[1]); w.y = cvt_pk_bf16(v0[2], v0[3]); w.z = cvt_pk_bf16(v1[0], v1[1]); w.w = cvt_pk_bf16(v1[2], v1[3]);
                        *(u32x4*)(P + (size_t)row * 2304 + hb * 64 + 8 * qd) = w;
                    }
                }
            }
    }
};
template <class Epi, class Sched, bool ALIGN_EPI = false, bool SP2 = false>
__device__ __forceinline__ void gemm_phase(PG8_LAS unsigned char* lds, const Gemm g, const Sched& S, const Epi& E) {
    const int tid = threadIdx.x, wid = __builtin_amdgcn_readfirstlane(tid >> 6), lane = tid & 63, wr = wid >> 2, wc = wid & 3, fr = lane & 15, fq = lane >> 4;
    const int K = g.K, nt = K / BK;
    unsigned voffA[2], voffB[2];
#pragma unroll
    for (int i = 0; i < 2; ++i) { int R, C; stage_rc(tid * 16 + i * 8192, R, C); const int Rb = Epi::PERM ? ((R & ~31) + perm32(R & 31)) : R;
        voffA[i] = (unsigned)(R * K + C) * 2u; voffB[i] = (unsigned)(Rb * K + C) * 2u; }
    const size_t kstep = (size_t)(BK * 2);
    const size_t hstep = (size_t)HALF * K * 2;
    const size_t tstep = 2 * hstep;
    const unsigned ldsw = (unsigned)wid * 1024u;
    const int aoff = lds_byte(wr * 64 + fr, fq * 8), boff = lds_byte(wc * 32 + fr, fq * 8);
#define PG8_SA(b, h) (((b) * 2 + (h)) * HTB)
#define PG8_SB(b, h) ((4 + (b) * 2 + (h)) * HTB)
#define PG8_STAGE(bufoff, gbase, voff) do { _Pragma("unroll") for (int _i = 0; _i < 2; ++_i) \
        __builtin_amdgcn_global_load_lds((const unsigned*)((const char*)(gbase) + (voff)[_i]), (PG8_LAS unsigned*)(lds + (bufoff) + ldsw + _i * 8192), 16, 0, 0); } while (0)
#define PG8_LDA(dst, b, h) do { _Pragma("unroll") for (int m = 0; m < 4; ++m) _Pragma("unroll") for (int k = 0; k < 2; ++k) dst[m][k] = *(const PG8_LAS bf16x8*)(lds + PG8_SA(b, h) + aoff + m * 2048 + k * 1024); } while (0)
#define PG8_LDB(dst, b, h) do { _Pragma("unroll") for (int n = 0; n < 2; ++n) _Pragma("unroll") for (int k = 0; k < 2; ++k) dst[n][k] = *(const PG8_LAS bf16x8*)(lds + PG8_SB(b, h) + boff + n * 2048 + k * 1024); } while (0)
#define PG8_MMA(ai, bj, At, Bt) do { __builtin_amdgcn_s_setprio(1); _Pragma("unroll") for (int m = 0; m < 4; ++m) _Pragma("unroll") for (int n = 0; n < 2; ++n) _Pragma("unroll") for (int k = 0; k < 2; ++k) \
        acc[ai][bj][m][n] = __builtin_amdgcn_mfma_f32_16x16x32_bf16(Bt[n][k], At[m][k], acc[ai][bj][m][n], 0, 0, 0); __builtin_amdgcn_s_setprio(0); } while (0)
#define PG8_WAIT_V(n) asm volatile("s_waitcnt vmcnt(" #n ")" ::: "memory")
#define PG8_WAIT_L(n) asm volatile("s_waitcnt lgkmcnt(" #n ")" ::: "memory")
#define PG8_BAR __builtin_amdgcn_s_barrier()
#define PG8_SCHED __builtin_amdgcn_sched_barrier(0)
    Unit cur, nxt; int ui = 0;
    if (!S.next(0, cur)) return;
    f32x4 acc[2][2][4][2];
#pragma unroll
    for (int a = 0; a < 2; ++a)
#pragma unroll
        for (int b = 0; b < 2; ++b)
#pragma unroll
            for (int m = 0; m < 4; ++m)
#pragma unroll
                for (int n = 0; n < 2; ++n) acc[a][b][m][n] = (f32x4){0.f, 0.f, 0.f, 0.f};
    bf16x8 At[4][2], B0[2][2], B1[2][2];
    const char* cA = (const char*)g.A + (size_t)cur.pm * tstep; const char* cB = (const char*)g.Bt + (size_t)cur.pn * tstep;
    S.a_ready(cur);
    if constexpr (SP2) {
        PG8_STAGE(PG8_SB(0, 0), cB, voffB); PG8_STAGE(PG8_SB(0, 1), cB + hstep, voffB); PG8_STAGE(PG8_SA(0, 0), cA, voffA); PG8_STAGE(PG8_SA(0, 1), cA + hstep, voffA);
        if (wr == 1) PG8_BAR;
        PG8_WAIT_V(2); PG8_BAR;
        PG8_STAGE(PG8_SB(1, 0), cB + kstep, voffB); PG8_STAGE(PG8_SA(1, 0), cA + kstep, voffA); PG8_STAGE(PG8_SB(1, 1), cB + hstep + kstep, voffB);
        PG8_WAIT_V(6); PG8_BAR;
    } else {
        PG8_STAGE(PG8_SB(0, 0), cB, voffB); PG8_STAGE(PG8_SA(0, 0), cA, voffA); PG8_STAGE(PG8_SB(0, 1), cB + hstep, voffB); PG8_STAGE(PG8_SA(0, 1), cA + hstep, voffA);
        if (wr == 1) PG8_BAR;
        PG8_WAIT_V(4); PG8_BAR;
        PG8_STAGE(PG8_SB(1, 0), cB + kstep, voffB); PG8_STAGE(PG8_SA(1, 0), cA + kstep, voffA); PG8_STAGE(PG8_SB(1, 1), cB + hstep + kstep, voffB);
        PG8_WAIT_V(6); PG8_BAR;
    }
    for (;;) {
        const bool has_next = S.next(ui + 1, nxt);
        const char* nA = has_next ? (const char*)g.A + (size_t)nxt.pm * tstep : cA; const char* nB = has_next ? (const char*)g.Bt + (size_t)nxt.pn * tstep : cB;
        for (int t = 0; t < nt; t += 2) {
            const bool last = (t == nt - 2);
            const char* a1 = cA + (size_t)(t + 1) * kstep;
            const char* a2 = last ? nA : cA + (size_t)(t + 2) * kstep; const char* b2 = last ? nB : cB + (size_t)(t + 2) * kstep;
            const char* a3 = a2 + kstep; const char* b3 = b2 + kstep;
            if (last && has_next) S.a_ready(nxt);
            if constexpr (SP2) {
            PG8_LDB(B0, 0, 0); PG8_LDB(B1, 0, 1); PG8_SCHED; PG8_LDA(At, 0, 0); PG8_STAGE(PG8_SA(1, 1), a1 + hstep, voffA);
            PG8_WAIT_V(8); PG8_WAIT_L(0); PG8_BAR; PG8_MMA(0, 0, At, B0); PG8_MMA(0, 1, At, B1); PG8_BAR; PG8_SCHED;
            PG8_LDA(At, 0, 1); PG8_STAGE(PG8_SB(0, 0), b2, voffB); PG8_STAGE(PG8_SB(0, 1), b2 + hstep, voffB); PG8_STAGE(PG8_SA(0, 0), a2, voffA);
            PG8_WAIT_V(8); PG8_WAIT_L(0); PG8_BAR; PG8_MMA(1, 0, At, B0); PG8_MMA(1, 1, At, B1); PG8_BAR; PG8_SCHED;
            PG8_LDB(B0, 1, 0); PG8_LDB(B1, 1, 1); PG8_SCHED; PG8_LDA(At, 1, 0); PG8_STAGE(PG8_SA(0, 1), a2 + hstep, voffA);
            PG8_WAIT_V(8); PG8_WAIT_L(0); PG8_BAR; PG8_MMA(0, 0, At, B0); PG8_MMA(0, 1, At, B1); PG8_BAR; PG8_SCHED;
            PG8_LDA(At, 1, 1); PG8_STAGE(PG8_SB(1, 0), b3, voffB); PG8_STAGE(PG8_SB(1, 1), b3 + hstep, voffB); PG8_STAGE(PG8_SA(1, 0), a3, voffA);
            PG8_WAIT_V(8); PG8_WAIT_L(0); PG8_BAR; PG8_MMA(1, 0, At, B0); PG8_MMA(1, 1, At, B1); PG8_BAR; PG8_SCHED;
            } else {
            PG8_LDB(B0, 0, 0); PG8_SCHED; PG8_LDA(At, 0, 0); PG8_STAGE(PG8_SA(1, 1), a1 + hstep, voffA);
            PG8_WAIT_L(8); PG8_BAR; PG8_WAIT_L(0); PG8_MMA(0, 0, At, B0); PG8_BAR; PG8_SCHED;
            PG8_LDB(B1, 0, 1); PG8_STAGE(PG8_SB(0, 0), b2, voffB);
            PG8_BAR; PG8_WAIT_L(0); PG8_MMA(0, 1, At, B1); PG8_BAR;
            PG8_LDA(At, 0, 1); PG8_STAGE(PG8_SA(0, 0), a2, voffA);
            PG8_BAR; PG8_WAIT_L(0); PG8_MMA(1, 0, At, B0); PG8_BAR; PG8_SCHED;
            PG8_STAGE(PG8_SB(0, 1), b2 + hstep, voffB);
            PG8_WAIT_V(6); PG8_BAR; PG8_MMA(1, 1, At, B1); PG8_BAR;
            PG8_LDB(B0, 1, 0); PG8_SCHED; PG8_LDA(At, 1, 0); PG8_STAGE(PG8_SA(0, 1), a2 + hstep, voffA);
            PG8_WAIT_L(8); PG8_BAR; PG8_WAIT_L(0); PG8_MMA(0, 0, At, B0); PG8_BAR; PG8_SCHED;
            PG8_LDB(B1, 1, 1); PG8_STAGE(PG8_SB(1, 0), b3, voffB);
            PG8_BAR; PG8_WAIT_L(0); PG8_MMA(0, 1, At, B1); PG8_BAR;
            PG8_LDA(At, 1, 1); PG8_STAGE(PG8_SA(1, 0), a3, voffA);
            PG8_BAR; PG8_WAIT_L(0); PG8_MMA(1, 0, At, B0); PG8_BAR; PG8_SCHED;
            PG8_STAGE(PG8_SB(1, 1), b3 + hstep, voffB);
            PG8_WAIT_V(6); PG8_BAR; PG8_MMA(1, 1, At, B1); PG8_BAR;
            }
        }
        if constexpr (ALIGN_EPI) { if (wr == 0) PG8_BAR; }
        if constexpr (!Epi::AFTER_DRAIN) { E(acc, cur, wr, wc, fr, fq); S.done(cur); }
        if (!has_next) break;
#pragma unroll
        for (int a = 0; a < 2; ++a)
#pragma unroll
            for (int b = 0; b < 2; ++b)
#pragma unroll
                for (int m = 0; m < 4; ++m)
#pragma unroll
                    for (int n = 0; n < 2; ++n) acc[a][b][m][n] = (f32x4){0.f, 0.f, 0.f, 0.f};
        cur = nxt; cA = nA; cB = nB; ++ui;
        if constexpr (ALIGN_EPI) { if (wr == 1) PG8_BAR; }
    }
    PG8_WAIT_V(0);
    if constexpr (!ALIGN_EPI) { if (wr == 0) PG8_BAR; }
    PG8_BAR;
    if constexpr (Epi::AFTER_DRAIN) { E.fused(acc, cur, wr, wc, fr, fq, lds, wid, lane); S.done(cur); }
#undef PG8_SA
#undef PG8_SB
#undef PG8_STAGE
#undef PG8_LDA
#undef PG8_LDB
#undef PG8_MMA
#undef PG8_WAIT_V
#undef PG8_WAIT_L
#undef PG8_BAR
#undef PG8_SCHED
}
}

constexpr int NB = 32, T = 2048, D = 1024, M = NB * T, FF = 4096, NPROJ = 2304, PP = NPROJ;
constexpr int HB_QN = 0, HB_KC = 8, HB_VC = 10, HB_KSL = 12, HB_VSL = 14, HB_KW = 16, HB_VW = 18, HB_QD = 20, HB_KD = 28, HB_VD = 29, HB_QI = 30, HB_KI = 34, HB_MISC = 35;
constexpr int NWAVES = 8, NTHR = 512;
constexpr float RMS_EPS = 1e-6f;

constexpr size_t MiB = 1u << 20;
constexpr size_t WS_CTL = 0, CTL_ZERO_BYTES = 64 * 1024;
constexpr size_t WS_MOD = 1 * MiB;
constexpr size_t WS_BIASC = 1 * MiB + 800 * 1024;
constexpr size_t WS_CS = 2 * MiB;
constexpr size_t WS_WIN = 18 * MiB;
constexpr size_t WS_WOUT = 23 * MiB;
constexpr size_t WS_WUP = 25 * MiB;
constexpr size_t WS_WDOWN = 33 * MiB;
constexpr size_t WS_W1K = 41 * MiB, WS_W1V = 41 * MiB + 512 * 1024;
constexpr size_t WS_W2K = 42 * MiB, WS_W2V = 42 * MiB + 64 * 1024;
constexpr size_t WS_KCMP = 43 * MiB, WS_VCMP = 44 * MiB;
constexpr size_t WS_MISC = 45 * MiB;
constexpr size_t WS_XN = 64 * MiB;
constexpr size_t WS_P = 192 * MiB;
constexpr size_t WS_SC = 480 * MiB;
constexpr size_t WS_END = 992 * MiB;
constexpr int SC_TILES_PER_B = 528;

constexpr int RING_BYTES = 131072;
constexpr int MISC_OFF = RING_BYTES + 320;
constexpr int LDS_BYTES = 147456;

#define LAS __attribute__((address_space(3)))
typedef unsigned short bf16;
typedef short bf16x8 __attribute__((ext_vector_type(8)));
typedef short s16x4 __attribute__((ext_vector_type(4)));
typedef float f32x4 __attribute__((ext_vector_type(4)));
typedef float f32x16 __attribute__((ext_vector_type(16)));
typedef unsigned u32x4 __attribute__((ext_vector_type(4)));
typedef unsigned u32x2 __attribute__((ext_vector_type(2)));
typedef unsigned long long u64;
#define MFMA32(a, b, c) __builtin_amdgcn_mfma_f32_32x32x16_bf16((a), (b), (c), 0, 0, 0)
#define LDS_WAIT() asm volatile("s_waitcnt lgkmcnt(0)" ::: "memory")

DI unsigned pk2(float lo, float hi) { return pg8::cvt_pk_bf16(lo, hi); }
DI float bf2f(unsigned short v) { return __uint_as_float((unsigned)v << 16); }
DI int crow(int r, int hi) { return (r & 3) + 8 * (r >> 2) + 4 * hi; }
DI float wave_sum(float v) {
#pragma unroll
    for (int o = 1; o < 64; o <<= 1) v += __shfl_xor(v, o);
    return v;
}
DI int launder(int x) { asm volatile("" : "+v"(x)); return x; }
DI float fast_exp2(float x) { return __builtin_amdgcn_exp2f(x); }
DI float gelu_tanh(float x) {
    const float u = 0.7978845608028654f * (x + 0.044715f * x * x * x);
    const float e = __expf(2.0f * u);
    const float th = 1.0f - 2.0f / (e + 1.0f);
    return 0.5f * x * (1.0f + th);
}

struct Frame {
    LAS unsigned char* lds;
    volatile LAS unsigned* MISC;
    unsigned char* ws;
    int tid, lane, wave, G, bid;
    unsigned long long pacc;
};
#ifndef PROBE_SEC
#define PROBE_SEC 0
#endif
#define SEC_BEGIN(k) unsigned long long _ps##k = 0; if (PROBE_SEC == (k)) _ps##k = __builtin_amdgcn_s_memrealtime()
#define SEC_END(k) do { if (PROBE_SEC == (k)) F.pacc += __builtin_amdgcn_s_memrealtime() - _ps##k; } while (0)
struct Args { const void* in[19]; float* out; unsigned char* ws; int ph_lo, ph_hi, coop, pad; };
#define WSP(type, off) ((type*)(F.ws + (off)))
#define INP(type, i) ((const type*)A.in[i])

DI int q_next(Frame& F, unsigned* ctr) {
    __syncthreads();
    if (F.tid == 0) F.MISC[0] = __hip_atomic_fetch_add(ctr, 1u, __ATOMIC_RELAXED, __HIP_MEMORY_SCOPE_AGENT);
    __syncthreads();
    return (int)F.MISC[0];
}

DI int proj_src_col(int n) {
    const int hb = n >> 6, p = n & 63;
    if (hb == 35) return p < 24 ? 1280 + p : (p < 28 ? 2264 + (p - 24) : -1);
    const int base = hb < 20 ? 64 * hb : 1304 + 64 * (hb - 20);
    constexpr u64 ROPE_MASK = 0x00000007DFF333FFull;
    int d = p;
    if ((ROPE_MASK >> hb) & 1ull) { const int q = p >> 3, i = p & 7; d = i < 4 ? 4 * q + i : 32 + 4 * q + (i - 4); }
    return base + d;
}
template <bool PERMUTE> DI void transpose_item(const float* W, int ldw, int K, int N, bf16* WT, LAS float* scr, int item, int lane) {
    const int nblk = N / 32, kb = item / nblk, nb = item % nblk, k0 = 64 * kb, n0 = 32 * nb;
    const int ncol = n0 + (lane & 31); const int src = PERMUTE ? proj_src_col(ncol) : ncol;
#pragma unroll 8
    for (int i = 0; i < 32; ++i) { const int kk = 2 * i + (lane >> 5); scr[kk * 33 + (lane & 31)] = src >= 0 ? W[(size_t)(k0 + kk) * ldw + src] : 0.f; }
    LDS_WAIT();
    const int cch = lane & 7;
#pragma unroll
    for (int j = 0; j < 4; ++j) { const int n = (lane >> 3) + 8 * j; const LAS float* s = scr + (8 * cch) * 33 + n;
        u32x4 o; o.x = pk2(s[0 * 33], s[1 * 33]); o.y = pk2(s[2 * 33], s[3 * 33]); o.z = pk2(s[4 * 33], s[5 * 33]); o.w = pk2(s[6 * 33], s[7 * 33]);
        *(u32x4*)(WT + (size_t)(n0 + n) * K + k0 + 8 * cch) = o; }
    LDS_WAIT();
}
DI void phase_p0(Frame& F, const Args& A) {
    LAS float* scr = (LAS float*)(F.lds + F.wave * 16384);
    const int gw = F.bid * NWAVES + F.wave, NGW = F.G * NWAVES;
    constexpr int I_IN = (D / 64) * (NPROJ / 32), I_OUT = (D / 64) * (D / 32), I_UP = (D / 64) * (FF / 32), I_DN = (FF / 64) * (D / 32), I_W1 = (2048 / 64) * (128 / 32), I_W2 = (128 / 64) * (64 / 32);
    constexpr int NITEMS = I_IN + I_OUT + I_UP + I_DN + 2 * I_W1 + 2 * I_W2;
    for (int it = gw; it < NITEMS; it += NGW) {
        int r = it;
        if (r < I_IN) { transpose_item<true>(INP(float, 9), 2268, D, NPROJ, WSP(bf16, WS_WIN), scr, r, F.lane); continue; } r -= I_IN;
        if (r < I_OUT) { transpose_item<false>(INP(float, 16), D, D, D, WSP(bf16, WS_WOUT), scr, r, F.lane); continue; } r -= I_OUT;
        if (r < I_UP) { transpose_item<false>(INP(float, 17), FF, D, FF, WSP(bf16, WS_WUP), scr, r, F.lane); continue; } r -= I_UP;
        if (r < I_DN) { transpose_item<false>(INP(float, 18), D, FF, D, WSP(bf16, WS_WDOWN), scr, r, F.lane); continue; } r -= I_DN;
        if (r < I_W1) { transpose_item<false>(INP(float, 12), 128, 2048, 128, WSP(bf16, WS_W1K), scr, r, F.lane); continue; } r -= I_W1;
        if (r < I_W1) { transpose_item<false>(INP(float, 14), 128, 2048, 128, WSP(bf16, WS_W1V), scr, r, F.lane); continue; } r -= I_W1;
        if (r < I_W2) { transpose_item<false>(INP(float, 13), 64, 128, 64, WSP(bf16, WS_W2K), scr, r, F.lane); continue; } r -= I_W2;
        transpose_item<false>(INP(float, 15), 64, 128, 64, WSP(bf16, WS_W2V), scr, r, F.lane);
    }
    const int gt = F.bid * NTHR + F.tid, NGT = F.G * NTHR;
    for (int it = F.bid; it < (6 * D) / 32; it += F.G) {
        LAS float* cl = (LAS float*)(F.lds + F.wave * 16384);
        const int k0 = 128 * F.wave;
        for (int e = F.lane; e < 128 * 32; e += 64) { const int kk = e >> 5, bb = e & 31; cl[kk * 32 + bb] = INP(float, 1)[bb * D + k0 + kk]; }
        LDS_WAIT();
        const int n = F.lane & 31, bh = F.lane >> 5;
        const float* wp = INP(float, 3) + (size_t)k0 * (6 * D) + it * 32 + n;
        float acc[16];
#pragma unroll
        for (int i = 0; i < 16; ++i) acc[i] = 0.f;
#pragma unroll 4
        for (int kk = 0; kk < 128; ++kk) {
            const float w = wp[(size_t)kk * (6 * D)];
            const LAS f32x4* cr = (const LAS f32x4*)(cl + kk * 32 + 16 * bh);
            const f32x4 c0 = cr[0], c1 = cr[1], c2 = cr[2], c3 = cr[3];
#pragma unroll
            for (int i = 0; i < 4; ++i) { acc[i] = fmaf(c0[i], w, acc[i]); acc[4 + i] = fmaf(c1[i], w, acc[4 + i]); acc[8 + i] = fmaf(c2[i], w, acc[8 + i]); acc[12 + i] = fmaf(c3[i], w, acc[12 + i]); }
        }
        __syncthreads();
        LAS float* pr = (LAS float*)F.lds + F.wave * 1024;
#pragma unroll
        for (int i = 0; i < 16; ++i) pr[(16 * bh + i) * 32 + n] = acc[i];
        __syncthreads();
        for (int e = F.tid; e < 1024; e += NTHR) {
            const LAS float* q = (const LAS float*)F.lds + e;
            const float sum = ((q[0] + q[1024]) + (q[2048] + q[3072])) + ((q[4096] + q[5120]) + (q[6144] + q[7168]));
            const int bb = e >> 5, nn = e & 31;
            WSP(float, WS_MOD)[(size_t)bb * (6 * D) + it * 32 + nn] = INP(float, 4)[it * 32 + nn] + sum;
        }
        __syncthreads();
    }
    for (int idx = gt; idx < M * 32; idx += NGT) {
        const int m = idx >> 5, d = idx & 31;
        const float inv = powf(10000.0f, -(float)d / 32.0f);
        const float ang = (float)INP(int, 2)[m] * inv;
        WSP(float, WS_CS)[2 * (size_t)idx] = cosf(ang); WSP(float, WS_CS)[2 * (size_t)idx + 1] = sinf(ang);
    }
    if (gw < 4) {
        const int kv = gw >> 1, j = (gw & 1) * 64 + F.lane;
        const float* pe = kv ? INP(float, 11) : INP(float, 10); const float* w1 = kv ? INP(float, 14) : INP(float, 12);
        float a0 = 0.f, a1 = 0.f;
#pragma unroll 4
        for (int k = 0; k < 2048; k += 2) { a0 = fmaf(pe[k], w1[(size_t)k * 128 + j], a0); a1 = fmaf(pe[k + 1], w1[(size_t)(k + 1) * 128 + j], a1); }
        WSP(float, WS_BIASC)[kv * 128 + j] = a0 + a1;
    }
}

DI float sumsq4(const f32x4 (&v)[4]) { float s = 0.f;
#pragma unroll
    for (int j = 0; j < 4; ++j) s += (v[j].x * v[j].x + v[j].y * v[j].y) + (v[j].z * v[j].z + v[j].w * v[j].w);
    return s; }
DI void unpack_bf16x4(f32x4& o, u64 w) { o.x = bf2f((unsigned short)w); o.y = bf2f((unsigned short)(w >> 16)); o.z = bf2f((unsigned short)(w >> 32)); o.w = bf2f((unsigned short)(w >> 48)); }
DI void phase_e0(Frame& F, const Args& A) {
    const int gw = F.bid * NWAVES + F.wave, NGW = F.G * NWAVES;
    for (int r0 = gw * 32; r0 < M; r0 += NGW * 32) {
        const int b = r0 / T;
        const float* mod = WSP(float, WS_MOD) + (size_t)b * 6 * D;
        f32x4 ga[4], sh[4];
#pragma unroll
        for (int j = 0; j < 4; ++j) { const int col = 4 * F.lane + 256 * j;
            ga[j] = *(const f32x4*)(INP(float, 5) + col) * (*(const f32x4*)(mod + D + col) + 1.0f); sh[j] = *(const f32x4*)(mod + col); }
#pragma unroll 1
        for (int m = r0; m < r0 + 32; m += 2) {
            const f32x4* xa = (const f32x4*)(INP(float, 0) + (size_t)m * D) + F.lane; const f32x4* xb = xa + D / 4;
            f32x4 va[4], vb[4];
#pragma unroll
            for (int j = 0; j < 4; ++j) { va[j] = xa[64 * j]; vb[j] = xb[64 * j]; }
            const float ra = 1.0f / sqrtf(wave_sum(sumsq4(va)) * (1.0f / D) + RMS_EPS), rb = 1.0f / sqrtf(wave_sum(sumsq4(vb)) * (1.0f / D) + RMS_EPS);
            u64* oa = (u64*)(WSP(bf16, WS_XN) + (size_t)m * D) + F.lane; u64* ob = oa + D / 4;
#pragma unroll
            for (int j = 0; j < 4; ++j) {
                const f32x4 ha = va[j] * ra * ga[j] + sh[j], hb = vb[j] * rb * ga[j] + sh[j];
                oa[64 * j] = (u64)pk2(ha.x, ha.y) | ((u64)pk2(ha.z, ha.w) << 32); ob[64 * j] = (u64)pk2(hb.x, hb.y) | ((u64)pk2(hb.z, hb.w) << 32);
            }
        }
    }
}

DI void phase_e1(Frame& F, const Args& A, const bf16* OPROJ) {
    const int gw = F.bid * NWAVES + F.wave, NGW = F.G * NWAVES;
    for (int r0 = gw * 32; r0 < M; r0 += NGW * 32) {
        const int b = r0 / T;
        const float* mod = WSP(float, WS_MOD) + (size_t)b * 6 * D;
        f32x4 g1[4], g2[4], sh[4];
#pragma unroll
        for (int j = 0; j < 4; ++j) { const int col = 4 * F.lane + 256 * j;
            g1[j] = *(const f32x4*)(INP(float, 6) + col) * *(const f32x4*)(mod + 2 * D + col);
            g2[j] = *(const f32x4*)(INP(float, 7) + col) * (*(const f32x4*)(mod + 4 * D + col) + 1.0f); sh[j] = *(const f32x4*)(mod + 3 * D + col); }
#pragma unroll 1
        for (int m = r0; m < r0 + 32; m += 2) {
            const f32x4* xa = (const f32x4*)(INP(float, 0) + (size_t)m * D) + F.lane; const f32x4* xb = xa + D / 4;
            const u64* pa = (const u64*)(OPROJ + (size_t)m * D) + F.lane; const u64* pb = pa + D / 4;
            f32x4 xva[4], xvb[4], oa[4], ob[4];
#pragma unroll
            for (int j = 0; j < 4; ++j) { xva[j] = xa[64 * j]; xvb[j] = xb[64 * j]; unpack_bf16x4(oa[j], pa[64 * j]); unpack_bf16x4(ob[j], pb[64 * j]); }
            const float ra = 1.0f / sqrtf(wave_sum(sumsq4(oa)) * (1.0f / D) + RMS_EPS), rb = 1.0f / sqrtf(wave_sum(sumsq4(ob)) * (1.0f / D) + RMS_EPS);
            f32x4* outa = (f32x4*)(A.out + (size_t)m * D) + F.lane; f32x4* outb = outa + D / 4;
#pragma unroll
            for (int j = 0; j < 4; ++j) { xva[j] = xva[j] + g1[j] * (oa[j] * ra); xvb[j] = xvb[j] + g1[j] * (ob[j] * rb); outa[64 * j] = xva[j]; outb[64 * j] = xvb[j]; }
            const float sa = 1.0f / sqrtf(wave_sum(sumsq4(xva)) * (1.0f / D) + RMS_EPS), sb = 1.0f / sqrtf(wave_sum(sumsq4(xvb)) * (1.0f / D) + RMS_EPS);
            u64* ha8 = (u64*)(WSP(bf16, WS_XN) + (size_t)m * D) + F.lane; u64* hb8 = ha8 + D / 4;
#pragma unroll
            for (int j = 0; j < 4; ++j) {
                const f32x4 ha = xva[j] * sa * g2[j] + sh[j], hb = xvb[j] * sb * g2[j] + sh[j];
                ha8[64 * j] = (u64)pk2(ha.x, ha.y) | ((u64)pk2(ha.z, ha.w) << 32); hb8[64 * j] = (u64)pk2(hb.x, hb.y) | ((u64)pk2(hb.z, hb.w) << 32);
            }
        }
    }
}
DI void phase_e2(Frame& F, const Args& A, const bf16* Y) {
    const int gw = F.bid * NWAVES + F.wave, NGW = F.G * NWAVES;
    for (int r0 = gw * 32; r0 < M; r0 += NGW * 32) {
        const int b = r0 / T;
        const float* mod = WSP(float, WS_MOD) + (size_t)b * 6 * D;
        f32x4 g1[4];
#pragma unroll
        for (int j = 0; j < 4; ++j) { const int col = 4 * F.lane + 256 * j; g1[j] = *(const f32x4*)(INP(float, 8) + col) * *(const f32x4*)(mod + 5 * D + col); }
#pragma unroll 1
        for (int m = r0; m < r0 + 32; m += 2) {
            const u64* pa = (const u64*)(Y + (size_t)m * D) + F.lane; const u64* pb = pa + D / 4;
            f32x4* outa = (f32x4*)(A.out + (size_t)m * D) + F.lane; f32x4* outb = outa + D / 4;
            f32x4 ya[4], yb[4], xa[4], xb[4];
#pragma unroll
            for (int j = 0; j < 4; ++j) { unpack_bf16x4(ya[j], pa[64 * j]); unpack_bf16x4(yb[j], pb[64 * j]); xa[j] = outa[64 * j]; xb[j] = outb[64 * j]; }
            const float ra = 1.0f / sqrtf(wave_sum(sumsq4(ya)) * (1.0f / D) + RMS_EPS), rb = 1.0f / sqrtf(wave_sum(sumsq4(yb)) * (1.0f / D) + RMS_EPS);
#pragma unroll
            for (int j = 0; j < 4; ++j) { outa[64 * j] = xa[j] + g1[j] * (ya[j] * ra); outb[64 * j] = xb[j] + g1[j] * (yb[j] * rb); }
        }
    }
}

constexpr int KT_STRIDE = 144, KT_BYTES = 64 * KT_STRIDE, VT_BYTES = 64 * 128;
DI int vt_off(int row, int colbyte) { return row * 128 + (colbyte ^ (((row >> 1) & 1) << 6)); }
struct KVRegs { u32x4 k, v; };
DI void kv_load(KVRegs& r, const bf16* Kg, const bf16* Vg, int tid) {
    const int row = tid >> 3, ch = tid & 7;
    r.k = *(const u32x4*)(Kg + (size_t)row * PP + ch * 8); r.v = *(const u32x4*)(Vg + (size_t)row * PP + ch * 8);
}
DI void kv_store(LAS unsigned char* Kl, LAS unsigned char* Vl, const KVRegs& r, int tid) {
    const int row = tid >> 3, ch = tid & 7;
    *(LAS u32x4*)(Kl + row * KT_STRIDE + ch * 16) = r.k; *(LAS u32x4*)(Vl + vt_off(row, ch * 16)) = r.v;
}
typedef short v4i16_t __attribute__((ext_vector_type(4)));
DI s16x4 vtr(LAS const unsigned char* p) { return __builtin_bit_cast(s16x4, __builtin_amdgcn_ds_read_tr16_b64_v4i16((LAS v4i16_t*)p)); }
DI bf16x8 pack8(const f32x16& p, const int base) {
    u32x4 w; w.x = pk2(p[base], p[base + 1]); w.y = pk2(p[base + 2], p[base + 3]); w.z = pk2(p[base + 4], p[base + 5]); w.w = pk2(p[base + 6], p[base + 7]);
    return __builtin_bit_cast(bf16x8, w);
}
struct LaneAddr { int kb, vb0, vb1; };
DI LaneAddr lane_addr(int lane) {
    const int r32 = lane & 31, hi = lane >> 5, a = lane & 15, g1 = (lane >> 4) & 1, swz = (a >> 3) & 1;
    const int common = (4 * hi + (a >> 2)) * 128 + 32 * g1 + 8 * (a & 3);
    LaneAddr la; la.kb = r32 * KT_STRIDE + hi * 16; la.vb0 = common + 64 * swz; la.vb1 = common + 64 * (1 - swz);
    return la;
}
DI f32x16 qk_block(LAS const unsigned char* lds, const int koff, const bf16x8 (&qr)[4], const LaneAddr& la) {
    f32x16 s;
#pragma unroll
    for (int i = 0; i < 16; ++i) s[i] = 0.f;
    LAS const unsigned char* kb = lds + la.kb;
#pragma unroll
    for (int st = 0; st < 4; ++st) { const bf16x8 a = *(LAS const bf16x8*)(kb + (koff + st * 32)); s = MFMA32(a, qr[st], s); }
    return s;
}
DI void pv_step(f32x16 (&o)[2], LAS const unsigned char* lds, const int voff, const bf16x8 pw, const LaneAddr& la) {
    { const s16x4 lo = vtr(lds + la.vb0 + voff), hh = vtr(lds + la.vb0 + (voff + 1024));
      const bf16x8 vf = __builtin_shufflevector(lo, hh, 0, 1, 2, 3, 4, 5, 6, 7); o[0] = MFMA32(vf, pw, o[0]); }
    { const s16x4 lo = vtr(lds + la.vb1 + voff), hh = vtr(lds + la.vb1 + (voff + 1024));
      const bf16x8 vf = __builtin_shufflevector(lo, hh, 0, 1, 2, 3, 4, 5, 6, 7); o[1] = MFMA32(vf, pw, o[1]); }
}
DI void mask_block(f32x16& s, unsigned w  ) {
#pragma unroll
    for (int r = 0; r < 16; ++r) { const int sh = (r & 3) + 8 * (r >> 2); if (!((w >> sh) & 1u)) s[r] = -INFINITY; }
}
DI float block_max(const f32x16& s) { float m = s[0];
#pragma unroll
    for (int r = 1; r < 16; ++r) m = fmaxf(m, s[r]);
    return m; }
DI float pl32_max(float m) { auto rr = __builtin_amdgcn_permlane32_swap(__float_as_uint(m), __float_as_uint(m), false, false); return fmaxf(__uint_as_float(rr[0]), __uint_as_float(rr[1])); }
DI float pl32_sum(float m) { auto rr = __builtin_amdgcn_permlane32_swap(__float_as_uint(m), __float_as_uint(m), false, false); return __uint_as_float(rr[0]) + __uint_as_float(rr[1]); }
constexpr float ATT_THR = 8.0f;
template <bool ROWLEVEL>
DI void attn_tile(const bf16x8 (&qr)[4], LAS const unsigned char* ldsb  , f32x16 (&o)[2], float& m_ref, float& l_run, u64 vb, const LaneAddr& la, int hi) {
    const float cinit = (ROWLEVEL && vb == 0ull) ? -INFINITY : -m_ref;
    f32x16 p0, p1;
#pragma unroll
    for (int i = 0; i < 16; ++i) { p0[i] = cinit; p1[i] = cinit; }
    {
        LAS const unsigned char* kb = ldsb + la.kb;
#pragma unroll
        for (int st = 0; st < 4; ++st) {
            const bf16x8 a0 = *(LAS const bf16x8*)(kb + st * 32), a1 = *(LAS const bf16x8*)(kb + (32 * KT_STRIDE + st * 32));
            p0 = MFMA32(a0, qr[st], p0); p1 = MFMA32(a1, qr[st], p1);
        }
    }
    float mx = fmaxf(block_max(p0), block_max(p1));
    mx = pl32_max(mx);
    if (__any(mx > ATT_THR)) {
        const float dl = fmaxf(mx, 0.f);
        m_ref += dl;
        const float f = fast_exp2(-dl);
        l_run *= f;
#pragma unroll
        for (int r = 0; r < 16; ++r) { p0[r] -= dl; p1[r] -= dl; o[0][r] *= f; o[1][r] *= f; }
    }
    float rs = 0.f;
    if (ROWLEVEL) {
#pragma unroll
        for (int r = 0; r < 16; ++r) { p0[r] = fast_exp2(p0[r]); p1[r] = fast_exp2(p1[r]); rs += p0[r] + p1[r]; }
    } else {
        const unsigned w0 = (unsigned)vb >> (4 * hi), w1 = (unsigned)(vb >> 32) >> (4 * hi);
#pragma unroll
        for (int r = 0; r < 16; ++r) {
            const int sh = (r & 3) + 8 * (r >> 2);
            const unsigned k0 = (unsigned)__builtin_amdgcn_sbfe(w0, sh, 1), k1 = (unsigned)__builtin_amdgcn_sbfe(w1, sh, 1);
            p0[r] = __uint_as_float(__float_as_uint(fast_exp2(p0[r])) & k0); p1[r] = __uint_as_float(__float_as_uint(fast_exp2(p1[r])) & k1);
            rs += p0[r] + p1[r];
        }
    }
    l_run += rs;
    LAS const unsigned char* vbp = ldsb + KT_BYTES;
    pv_step(o, vbp, 0 * 128, pack8(p0, 0), la);
    pv_step(o, vbp, 16 * 128, pack8(p0, 8), la);
    pv_step(o, vbp, 32 * 128, pack8(p1, 0), la);
    pv_step(o, vbp, 48 * 128, pack8(p1, 8), la);
}
DI u64 causal_bits(int ql) { return ql >= 63 ? ~0ull : ((1ull << (ql + 1)) - 1ull); }

DI void compress_item(Frame& F, int item) {
    const int kv = item & 1, half = (item >> 1) & 1, g = (item >> 2) & 1, b = item >> 3;
    const int lane = launder(F.lane), r32 = lane & 31, hi = lane >> 5, wid = F.wave;
    const bf16* Pb = WSP(bf16, WS_P) + (size_t)b * T * PP + ((kv ? HB_VC : HB_KC) + g) * 64;
    const bf16* W1 = kv ? WSP(bf16, WS_W1V) : WSP(bf16, WS_W1K); const bf16* W2 = kv ? WSP(bf16, WS_W2V) : WSP(bf16, WS_W2K);
    const float* bias = WSP(float, WS_BIASC) + kv * 128;
    bf16* OUT = (kv ? WSP(bf16, WS_VCMP) : WSP(bf16, WS_KCMP)) + (size_t)((b * 2 + g) * 128) * 64;
    LAS unsigned char* H1 = F.lds;
    {
        const int mh = wid & 1, nq = wid >> 1;
        const int n = 64 * half + 32 * mh + r32, nc = n < 126 ? n : 126;
        const bf16* arow = Pb + (size_t)(16 * nc) * PP + hi * 8;
        const bf16* brow = W1 + (size_t)(32 * nq + r32) * 2048 + hi * 8;
        f32x16 acc;
#pragma unroll
        for (int i = 0; i < 16; ++i) acc[i] = 0.f;
#pragma unroll 2
        for (int l = 0; l < 32; ++l) {
#pragma unroll
            for (int ss = 0; ss < 4; ++ss) {
                const bf16x8 a = *(const bf16x8*)(arow + (size_t)l * PP + ss * 16);
                const bf16x8 bb = *(const bf16x8*)(brow + (4 * l + ss) * 16);
                acc = MFMA32(a, bb, acc);
            }
        }
        const float bj = bias[32 * nq + r32];
#pragma unroll
        for (int r = 0; r < 16; ++r) {
            const float h = gelu_tanh(acc[r] + bj);
            *(LAS unsigned short*)(H1 + (32 * mh + crow(r, hi)) * 272 + (32 * nq + r32) * 2) = (unsigned short)(pk2(h, 0.f) & 0xffffu);
        }
    }
    __syncthreads();
    if (wid < 4) {
        const int mh = wid & 1, dh = wid >> 1;
        f32x16 acc;
#pragma unroll
        for (int i = 0; i < 16; ++i) acc[i] = 0.f;
        LAS const unsigned char* ar = H1 + (32 * mh + r32) * 272 + hi * 16;
        const bf16* br = W2 + (size_t)(32 * dh + r32) * 128 + hi * 8;
#pragma unroll
        for (int st = 0; st < 8; ++st) {
            const bf16x8 a = *(LAS const bf16x8*)(ar + st * 32);
            const bf16x8 bb = *(const bf16x8*)(br + st * 16);
            acc = MFMA32(a, bb, acc);
        }
#pragma unroll
        for (int r = 0; r < 16; ++r) OUT[(size_t)(64 * half + 32 * mh + crow(r, hi)) * 64 + 32 * dh + r32] = (bf16)(pk2(acc[r], 0.f) & 0xffffu);
    }
    __syncthreads();
}

DI void score_unit(Frame& F, int b, int qb) {
    const int lane = launder(F.lane), r32 = lane & 31, hi = lane >> 5, wid = F.wave;
    const int qh = wid & 1, kvh = (wid >> 1) & 1, kpar = wid >> 2;
    const size_t rowq = (size_t)b * T + 64 * qb + 32 * qh + r32;
    bf16x8 qf[4][4];
#pragma unroll
    for (int h = 0; h < 4; ++h)
#pragma unroll
        for (int st = 0; st < 4; ++st) qf[h][st] = *(const bf16x8*)(WSP(bf16, WS_P) + rowq * PP + (HB_QI + h) * 64 + 16 * st + 8 * hi);
    const float idx_scale = 0.5f * 0.125f;
    const f32x4 wv = *(const f32x4*)(WSP(float, WS_MISC) + rowq * 32 + 24);
    const float w0 = wv[0] * idx_scale, w1 = wv[1] * idx_scale, w2 = wv[2] * idx_scale, w3 = wv[3] * idx_scale;
    float* tbase = WSP(float, WS_SC) + ((size_t)b * SC_TILES_PER_B + (size_t)(qb * (qb + 1) / 2)) * 4096 + (32 * qh + r32) * 64 + 32 * kvh + 4 * hi;
    for (int kb = kpar; kb <= qb; kb += 2) {
        const size_t rowk = (size_t)b * T + 64 * kb + 32 * kvh + r32;
        bf16x8 kf[4];
#pragma unroll
        for (int st = 0; st < 4; ++st) kf[st] = *(const bf16x8*)(WSP(bf16, WS_P) + rowk * PP + HB_KI * 64 + 16 * st + 8 * hi);
        f32x16 sc;
#pragma unroll
        for (int h = 0; h < 4; ++h) {
            f32x16 acc;
#pragma unroll
            for (int i = 0; i < 16; ++i) acc[i] = 0.f;
#pragma unroll
            for (int st = 0; st < 4; ++st) acc = MFMA32(kf[st], qf[h][st], acc);
            const float wh = h == 0 ? w0 : (h == 1 ? w1 : (h == 2 ? w2 : w3));
#pragma unroll
            for (int i = 0; i < 16; ++i) { const float rl = fmaxf(acc[i], 0.f); sc[i] = h == 0 ? wh * rl : fmaf(wh, rl, sc[i]); }
        }
        float* tp = tbase + (size_t)kb * 4096;
#pragma unroll
        for (int u = 0; u < 4; ++u) { f32x4 v = {sc[4 * u], sc[4 * u + 1], sc[4 * u + 2], sc[4 * u + 3]}; *(f32x4*)(tp + 8 * u) = v; }
    }
}
DI void phase_a1(Frame& F) {
    unsigned* ctr = WSP(unsigned, WS_CTL) + 64;
    for (;;) {
        const int it = q_next(F, ctr);
        if (it >= 256 + 1024) break;
        if (it < 256) compress_item(F, it);
        else { const int u = it - 256; score_unit(F, u & 31, 31 - (u >> 5)); }
    }
}

constexpr int TILE_PAIR = KT_BYTES + VT_BYTES;
template <class MaskF>
DI void run_tiles(Frame& F, unsigned tmask, const bf16* Kg0, const bf16* Vg0,
                  const bf16x8 (&qr)[4], f32x16 (&o)[2], float& m_ref, float& l_run, const MaskF mf, const LaneAddr& la, const int tid) {
    if (tmask == 0u) return;
    const int hi = (tid >> 5) & 1;
    int j = __builtin_ctz(tmask); tmask &= tmask - 1u;
    KVRegs rg; kv_load(rg, Kg0 + (size_t)(64 * j) * PP, Vg0 + (size_t)(64 * j) * PP, tid);
    __syncthreads();
    kv_store(F.lds, F.lds + KT_BYTES, rg, tid);
    int jn = -1;
    if (tmask) { jn = __builtin_ctz(tmask); tmask &= tmask - 1u; kv_load(rg, Kg0 + (size_t)(64 * jn) * PP, Vg0 + (size_t)(64 * jn) * PP, tid); }
    __syncthreads();
    int par = 0;
    for (;;) {
        int jnn = -1;
        if (jn >= 0) {
            LAS unsigned char* nb = F.lds + (par ^ 1) * TILE_PAIR;
            kv_store(nb, nb + KT_BYTES, rg, tid);
            if (tmask) { jnn = __builtin_ctz(tmask); tmask &= tmask - 1u; kv_load(rg, Kg0 + (size_t)(64 * jnn) * PP, Vg0 + (size_t)(64 * jnn) * PP, tid); }
        }
        const u64 vb = mf(j);
        LAS const unsigned char* cb = F.lds + par * TILE_PAIR;
        if (__all(vb == 0ull || vb == ~0ull)) attn_tile<true>(qr, cb, o, m_ref, l_run, vb, la, hi);
        else attn_tile<false>(qr, cb, o, m_ref, l_run, vb, la, hi);
        if (jn < 0) break;
        __syncthreads();
        j = jn; jn = jnn; par ^= 1;
    }
}
struct SlcMask { unsigned sel; int tb, ql; DI u64 operator()(int j) const { return ((sel >> j) & 1u) ? (j == tb ? causal_bits(ql) : ~0ull) : 0ull; } };
struct WinMask { int tb, ql; DI u64 operator()(int j) const { return j == tb ? causal_bits(ql) : (j == tb - 8 ? ~causal_bits(ql) : ~0ull); } };
struct DsaMask { LAS const u64* row; DI u64 operator()(int j) const { return row[j]; } };

constexpr int NSA_KC = 2 * TILE_PAIR, NSA_VC = NSA_KC + 128 * KT_STRIDE, NSA_IMP = NSA_VC + 128 * 128,
              NSA_SELM = NSA_IMP + 4 * 64 * 33 * 4, NSA_UM = NSA_SELM + 256, NSA_END = NSA_UM + 16;
static_assert(NSA_END <= RING_BYTES, "NSA LDS map");

DI void nsa_unit(Frame& F, int b, int g, int tb) {
    const int tid = launder(F.tid), lane = tid & 63, r32 = lane & 31, hi = lane >> 5, wid = F.wave;
    const int r = wid & 3, th = wid >> 2, hq = 4 * g + r, ql = 32 * th + r32, t = 64 * tb + ql;
    const size_t rowg = (size_t)b * T + t;
    LAS unsigned char* KC = F.lds + NSA_KC; LAS unsigned char* VC = F.lds + NSA_VC;
    const LaneAddr la = lane_addr(lane);
    LAS float* IMP = (LAS float*)(F.lds + NSA_IMP); LAS unsigned* SELM = (LAS unsigned*)(F.lds + NSA_SELM); LAS unsigned* UM = (LAS unsigned*)(F.lds + NSA_UM);
    SEC_BEGIN(1);
    bf16x8 qr[4];
#pragma unroll
    for (int st = 0; st < 4; ++st) qr[st] = *(const bf16x8*)(WSP(bf16, WS_P) + rowg * PP + hq * 64 + 16 * st + 8 * hi);
    float gate[3];
#pragma unroll
    for (int br = 0; br < 3; ++br) { const float xg = WSP(float, WS_MISC)[rowg * 32 + hq * 3 + br]; gate[br] = 1.0f / (1.0f + __expf(-xg)); }
    f32x16 ot[2];
#pragma unroll
    for (int i = 0; i < 16; ++i) { ot[0][i] = 0.f; ot[1][i] = 0.f; }
    {
        const bf16* kc = WSP(bf16, WS_KCMP) + (size_t)((b * 2 + g) * 128) * 64; const bf16* vc = WSP(bf16, WS_VCMP) + (size_t)((b * 2 + g) * 128) * 64;
#pragma unroll
        for (int ps = 0; ps < 2; ++ps) { const int row = (tid >> 3) + 64 * ps, ch = tid & 7;
            const u32x4 kk = *(const u32x4*)(kc + row * 64 + ch * 8), vv = *(const u32x4*)(vc + row * 64 + ch * 8);
            *(LAS u32x4*)(KC + row * KT_STRIDE + ch * 16) = kk; *(LAS u32x4*)(VC + vt_off(row, ch * 16)) = vv; }
        if (tid == 0) UM[0] = 0u;
    }
    __syncthreads();
    {
        const int nq = (t - 31) >> 4;
        float mx = -INFINITY;
#pragma unroll 1
        for (int c = 0; c < 4; ++c) {
            const f32x16 s = qk_block(F.lds, NSA_KC + c * 32 * KT_STRIDE, qr, la);
#pragma unroll
            for (int rg = 0; rg < 16; ++rg) if (32 * c + crow(rg, hi) <= nq) mx = fmaxf(mx, s[rg]);
        }
        mx = fmaxf(mx, __shfl_xor(mx, 32));
        const float ms = fmaxf(mx, -1e30f);
        float l = 0.f, carry = 0.f;
        LAS float* irow = IMP + (r * 64 + ql) * 33;
        f32x16 oc[2];
#pragma unroll
        for (int i = 0; i < 16; ++i) { oc[0][i] = 0.f; oc[1][i] = 0.f; }
#pragma unroll 1
        for (int c = 0; c < 4; ++c) {
            f32x16 p = qk_block(F.lds, NSA_KC + c * 32 * KT_STRIDE, qr, la);
#pragma unroll
            for (int rg = 0; rg < 16; ++rg) { p[rg] = (32 * c + crow(rg, hi) <= nq) ? fast_exp2(p[rg] - ms) : 0.f; l += p[rg]; }
            float sw[4];
#pragma unroll
            for (int u = 0; u < 4; ++u) sw[u] = __shfl_xor(p[4 * u + 3], 32);
#pragma unroll
            for (int u = 0; u < 4; ++u) {
                const float quad = (p[4 * u] + p[4 * u + 1]) + (p[4 * u + 2] + p[4 * u + 3]);
                const float prevlo = u > 0 ? sw[u > 0 ? u - 1 : 0] : carry;
                irow[8 * c + 2 * u + hi] = quad + (hi ? sw[u] : prevlo);
            }
            carry = sw[3];
            pv_step(oc, F.lds, NSA_VC + (32 * c) * 128, pack8(p, 0), la); pv_step(oc, F.lds, NSA_VC + (32 * c + 16) * 128, pack8(p, 8), la);
        }
        l += __shfl_xor(l, 32);
        const float inv = l > 0.f ? 1.0f / l : 0.f;
#pragma unroll
        for (int i = 0; i < 16; ++i) irow[2 * i + hi] *= inv;
        const float gs = gate[0] * inv;
#pragma unroll
        for (int i = 0; i < 16; ++i) { ot[0][i] = gs * oc[0][i]; ot[1][i] = gs * oc[1][i]; }
    }
    __syncthreads();
    if (tb < 16) {
        if (tid < 64) SELM[tid] = (2u << tb) - 1u;
        if (tid == 0) UM[0] = (2u << tb) - 1u;
    } else {
        const int j = lane & 31;
        unsigned um = 0u;
#pragma unroll 1
        for (int ps = 0; ps < 4; ++ps) {
            const int tq = wid * 8 + ps * 2 + hi;
            float v = ((IMP[(0 * 64 + tq) * 33 + j] + IMP[(1 * 64 + tq) * 33 + j]) + IMP[(2 * 64 + tq) * 33 + j]) + IMP[(3 * 64 + tq) * 33 + j];
            if (j > tb) v = -INFINITY; else if (j == 0 || j == tb || j == tb - 1) v = INFINITY;
            int rank = 0;
#pragma unroll 8
            for (int sft = 1; sft < 32; ++sft) {
                const int oj = (j + sft) & 31;
                const float ov = __shfl(v, (lane & 32) | oj);
                rank += (ov > v || (ov == v && oj < j)) ? 1 : 0;
            }
            const u64 bm = __ballot(rank < 16 && j <= tb);
            if (j == 0) SELM[tq] = hi ? (unsigned)(bm >> 32) : (unsigned)bm;
            um |= (unsigned)bm | (unsigned)(bm >> 32);
        }
        if (lane == 0) __hip_atomic_fetch_or(UM, um, __ATOMIC_RELAXED, __HIP_MEMORY_SCOPE_WORKGROUP);
    }
    __syncthreads();
    const unsigned umask = UM[0];
    SEC_END(1);
    SEC_BEGIN(2);
    const unsigned sel = SELM[ql];
    const bf16* Pb = WSP(bf16, WS_P) + (size_t)b * T * PP;
    {
        f32x16 o[2];
#pragma unroll
        for (int i = 0; i < 16; ++i) { o[0][i] = 0.f; o[1][i] = 0.f; }
        float m_run = 0.f, l_run = 0.f;
        SlcMask mf{sel, tb, ql};
        run_tiles(F, umask, Pb + (HB_KSL + g) * 64, Pb + (HB_VSL + g) * 64, qr, o, m_run, l_run, mf, la, tid);
        float l = pl32_sum(l_run);
        const float sc = l > 0.f ? gate[1] / l : 0.f;
#pragma unroll
        for (int i = 0; i < 16; ++i) { ot[0][i] += sc * o[0][i]; ot[1][i] += sc * o[1][i]; }
    }
    SEC_END(2);
    SEC_BEGIN(3);
    {
        f32x16 o[2];
#pragma unroll
        for (int i = 0; i < 16; ++i) { o[0][i] = 0.f; o[1][i] = 0.f; }
        float m_run = 0.f, l_run = 0.f;
        const int jlo = tb >= 8 ? tb - 8 : 0;
        const unsigned wmask = (tb == 31 ? ~0u : ((2u << tb) - 1u)) & ~((1u << jlo) - 1u);
        WinMask mf{tb, ql};
        run_tiles(F, wmask, Pb + (HB_KW + g) * 64, Pb + (HB_VW + g) * 64, qr, o, m_run, l_run, mf, la, tid);
        float l = pl32_sum(l_run);
        const float sc = l > 0.f ? gate[2] / l : 0.f;
#pragma unroll
        for (int i = 0; i < 16; ++i) { ot[0][i] += sc * o[0][i]; ot[1][i] += sc * o[1][i]; }
    }
    SEC_END(3);
    bf16* orow = WSP(bf16, WS_XN) + rowg * D + hq * 64 + 4 * hi;
#pragma unroll
    for (int db = 0; db < 2; ++db)
#pragma unroll
        for (int u = 0; u < 4; ++u) { u32x2 w; w.x = pk2(ot[db][4 * u], ot[db][4 * u + 1]); w.y = pk2(ot[db][4 * u + 2], ot[db][4 * u + 3]); *(u32x2*)(orow + 32 * db + 8 * u) = w; }
}

DI void dsa_load_row(float (&v)[32], const float* SCb, int t, int KB, int lane) {
    const int qb = t >> 6, ql = t & 63;
    const float* base = SCb + (size_t)(qb * (qb + 1) / 2) * 4096 + ql * 64 + lane;
#pragma unroll
    for (int i = 0; i < 32; ++i) { if (i < KB) v[i] = base[(size_t)i * 4096]; else v[i] = 0.f; }
}
DI void dsa_store_keys(const float (&v)[32], int t, int G4, LAS u32x4* keys, int lane) {
    float mxa = 0.f;
#pragma unroll
    for (int g = 0; g < 8; ++g) if (g < G4) {
#pragma unroll
        for (int e = 0; e < 4; ++e) { const int i = 4 * g + e; if (64 * i + lane <= t) mxa = fmaxf(mxa, fabsf(v[i])); }
    }
#pragma unroll
    for (int o = 1; o < 64; o <<= 1) mxa = fmaxf(mxa, __shfl_xor(mxa, o));
    const float sc = mxa > 0.f ? 1.0e9f / mxa : 0.f;
#pragma unroll
    for (int g = 0; g < 8; ++g) if (g < G4) {
        u32x4 kk;
#pragma unroll
        for (int e = 0; e < 4; ++e) {
            const int i = 4 * g + e;
            const unsigned k = (unsigned)__float2int_rn(v[i] * sc) ^ 0x80000000u;
            kk[e] = (64 * i + lane <= t) ? k : 0u;
        }
        keys[g * 64 + lane] = kk;
    }
}
DI void dsa_select(int t, int KB, LAS unsigned* hist, LAS const u32x4* keys, LAS u64* mrow, int lane) {
    if (t + 1 <= 256) {
        for (int i = 0; i < KB; ++i) { const u64 bm = __ballot(64 * i + lane <= t); if (lane == 0) mrow[i] = bm; }
        return;
    }
    const int G4 = (KB + 3) >> 2;
    unsigned prefix = 0u; int rem = 256;
    LAS unsigned* dummy = hist + 256 + lane;
#pragma unroll 1
    for (int pass = 0; pass < 4; ++pass) {
        const int shift = 24 - 8 * pass;
        { u32x4 z = {0u, 0u, 0u, 0u}; *(LAS u32x4*)(hist + 4 * lane) = z; }
        LDS_WAIT();
#pragma unroll 2
        for (int g = 0; g < G4; ++g) {
            const u32x4 kk = keys[g * 64 + lane];
#pragma unroll
            for (int e = 0; e < 4; ++e) {
                const unsigned k = kk[e];
                const bool match = k != 0u && ((k >> 1) >> (shift + 7)) == prefix;
                LAS unsigned* dst = match ? hist + ((k >> shift) & 255u) : dummy;
                __hip_atomic_fetch_add(dst, 1u, __ATOMIC_RELAXED, __HIP_MEMORY_SCOPE_WORKGROUP);
            }
        }
        LDS_WAIT();
        const u32x4 cc = *(LAS u32x4*)(hist + 4 * lane);
        LDS_WAIT();
        const int tot = (int)(cc.x + cc.y + cc.z + cc.w);
        int suf = tot;
#pragma unroll
        for (int off = 1; off < 64; off <<= 1) { const int y = __shfl_down(suf, off); if (lane + off < 64) suf += y; }
        const u64 bal = __ballot(suf >= rem);
        const int L = __popcll(bal) - 1;
        int cum = suf - tot, dsel;
        if (cum + (int)cc.w >= rem) dsel = 3;
        else { cum += (int)cc.w;
            if (cum + (int)cc.z >= rem) dsel = 2;
            else { cum += (int)cc.z;
                if (cum + (int)cc.y >= rem) dsel = 1;
                else { cum += (int)cc.y; dsel = 0; } } }
        const int dig = __shfl(4 * lane + dsel, L);
        rem -= __shfl(cum, L);
        prefix = (prefix << 8) | (unsigned)dig;
    }
    int running = 0;
    const u64 below = (1ull << lane) - 1ull;
    for (int g = 0; g < G4; ++g) {
        const u32x4 kk = keys[g * 64 + lane];
#pragma unroll
        for (int e = 0; e < 4; ++e) {
            const unsigned k = kk[e];
            const bool eq = k == prefix;
            const u64 beq = __ballot(eq);
            const bool sl = k > prefix || (eq && running + __popcll(beq & below) < rem);
            running += __popcll(beq);
            const u64 bm = __ballot(sl);
            if (lane == 0 && 4 * g + e < KB) mrow[4 * g + e] = bm;
        }
    }
}
constexpr int DSA_MB = 2 * TILE_PAIR, DSA_HIST = DSA_MB + 32 * 33 * 8, DSA_KEYS = DSA_HIST + 8 * 1280, DSA_END = DSA_KEYS + 8 * 8192;
static_assert(DSA_END <= RING_BYTES, "DSA LDS map");
DI void dsa_unit(Frame& F, int b, int qb32) {
    const int tid = launder(F.tid), lane = tid & 63, r32 = lane & 31, hi = lane >> 5, wid = F.wave;
    const int t0 = 32 * qb32, KB = (qb32 >> 1) + 1;
    const LaneAddr la = lane_addr(lane);
    LAS u64* MB = (LAS u64*)(F.lds + DSA_MB); LAS unsigned* HIST = (LAS unsigned*)(F.lds + DSA_HIST) + wid * 320; LAS u32x4* KEYS = (LAS u32x4*)(F.lds + DSA_KEYS) + wid * 512;
    const float* SCb = WSP(float, WS_SC) + (size_t)b * SC_TILES_PER_B * 4096;
    SEC_BEGIN(4);
    if (t0 + 31 >= 256) {
        float v[32];
        dsa_load_row(v, SCb, t0 + wid * 4, KB, lane);
#pragma unroll 1
        for (int qq = 0; qq < 4; ++qq) {
            const int qi = wid * 4 + qq, t = t0 + qi;
            LDS_WAIT();
            { SEC_BEGIN(6); dsa_store_keys(v, t, (KB + 3) >> 2, KEYS, lane); LDS_WAIT(); SEC_END(6); }
            if (qq < 3) dsa_load_row(v, SCb, t + 1, KB, lane);
            { SEC_BEGIN(7); dsa_select(t, KB, HIST, KEYS, MB + qi * 33, lane); LDS_WAIT(); SEC_END(7); }
        }
    } else {
        for (int qq = 0; qq < 4; ++qq) { const int qi = wid * 4 + qq; dsa_select(t0 + qi, KB, HIST, KEYS, MB + qi * 33, lane); }
    }
    __syncthreads();
    SEC_END(4);
    SEC_BEGIN(5);
    const size_t rowg = (size_t)b * T + t0 + r32;
    bf16x8 qr[4];
#pragma unroll
    for (int st = 0; st < 4; ++st) qr[st] = *(const bf16x8*)(WSP(bf16, WS_P) + rowg * PP + (HB_QD + wid) * 64 + 16 * st + 8 * hi);
    f32x16 o[2];
#pragma unroll
    for (int i = 0; i < 16; ++i) { o[0][i] = 0.f; o[1][i] = 0.f; }
    float m_run = 0.f, l_run = 0.f;
    const bf16* Pb = WSP(bf16, WS_P) + (size_t)b * T * PP;
    const unsigned tmask = KB >= 32 ? ~0u : ((1u << KB) - 1u);
    DsaMask mf{MB + r32 * 33};
    run_tiles(F, tmask, Pb + HB_KD * 64, Pb + HB_VD * 64, qr, o, m_run, l_run, mf, la, tid);
    const float l = pl32_sum(l_run);
    const float sc = l > 0.f ? 1.0f / l : 0.f;
    bf16* orow = WSP(bf16, WS_XN) + rowg * D + 512 + wid * 64 + 4 * hi;
#pragma unroll
    for (int db = 0; db < 2; ++db)
#pragma unroll
        for (int u = 0; u < 4; ++u) { u32x2 w; w.x = pk2(o[db][4 * u] * sc, o[db][4 * u + 1] * sc); w.y = pk2(o[db][4 * u + 2] * sc, o[db][4 * u + 3] * sc); *(u32x2*)(orow + 32 * db + 8 * u) = w; }
    SEC_END(5);
}
DI void phase_a2(Frame& F) {
    unsigned* ctr = WSP(unsigned, WS_CTL) + 128;
    for (;;) {
        const int it = q_next(F, ctr);
        if (it >= 4096) break;
        const int L = it >> 7, k = it & 127;
#ifndef NO_NSA
        if (k < 64) nsa_unit(F, k >> 1, k & 1, 31 - L);
#endif
#ifndef NO_DSA
        if (k >= 64) { const int kk = k - 64; dsa_unit(F, kk >> 1, 63 - 2 * L - (kk & 1)); }
#endif
    }
}

#define XB_TMO      128
#define XB_XCNT(j)  (256  + 64 * (j))
#define XB_XSUB(j)  (1280 + 64 * (j))
#define XB_XGEN(j)  (2304 + 64 * (j))
#define XB_TOP      3328
#define XB_TOPGEN   3392
#define XCD_BAR_WORDS 3456
#define XB_SPIN_CAP (1u << 18)

__device__ __forceinline__ unsigned xb_ld(unsigned* p)              { return __hip_atomic_load(p, __ATOMIC_RELAXED, __HIP_MEMORY_SCOPE_AGENT); }
__device__ __forceinline__ unsigned xb_add(unsigned* p, unsigned v) { return __hip_atomic_fetch_add(p, v, __ATOMIC_RELAXED, __HIP_MEMORY_SCOPE_AGENT); }
__device__ __forceinline__ unsigned xb_xcc_id() { return (unsigned)__builtin_amdgcn_s_getreg((3 << 11) | 20) & 0xFu; }
#define XB_SPIN(cond, bar) do { unsigned _sp = 0; while (cond) { __builtin_amdgcn_s_sleep(1); \
    if ((++_sp & 255u) == 0u) { if (xb_ld(&(bar)[XB_TMO])) break; if (_sp > XB_SPIN_CAP) { atomicAdd(&(bar)[XB_TMO], 1u); break; } } } } while (0)

struct XcdBarrier {
    unsigned* bar; unsigned x;
    volatile LAS unsigned* st;
};

__device__ __forceinline__ XcdBarrier xcd_barrier_post(unsigned* bar, volatile LAS unsigned* st) {
    XcdBarrier b; b.bar = bar; b.x = xb_xcc_id(); b.st = st;
    if (threadIdx.x == 0) (void)xb_add(&bar[XB_XCNT(b.x)], 1u);
    return b;
}
__device__ __forceinline__ void xcd_barrier_complete(unsigned* bar, unsigned x, unsigned& nloc, unsigned& nx) {
    const unsigned G = gridDim.x * gridDim.y * gridDim.z;
    unsigned sum, cnt, mine, sp = 0u;
    for (;;) {
        sum = 0u; cnt = 0u; mine = 0u;
#pragma unroll
        for (unsigned j = 0; j < 16; ++j) { const unsigned c = xb_ld(&bar[XB_XCNT(j)]); sum += c; cnt += (c > 0u) ? 1u : 0u; mine = (j == x) ? c : mine; }
        if (sum == G) break;
        __builtin_amdgcn_s_sleep(1);
        if ((++sp & 255u) == 0u) { if (xb_ld(&bar[XB_TMO])) break; if (sp > XB_SPIN_CAP) { atomicAdd(&bar[XB_TMO], 1u); break; } }
    }
    nloc = mine > 0u ? mine : 1u; nx = cnt > 0u ? cnt : 1u;
}

__device__ __forceinline__ void xcd_barrier(const XcdBarrier& b) {
    asm volatile("s_waitcnt vmcnt(0)" ::: "memory");
    __syncthreads();
    if (threadIdx.x == 0) {
        unsigned* bar = b.bar;
        __builtin_amdgcn_s_waitcnt(0);
        unsigned nloc = b.st[0], nx = b.st[1];
        if (nloc == 0u) { xcd_barrier_complete(bar, b.x, nloc, nx); b.st[0] = nloc; b.st[1] = nx; }
        const unsigned old = xb_add(&bar[XB_XSUB(b.x)], 1u);
        const unsigned gen = old / nloc;
        if (old + 1u == (gen + 1u) * nloc) {
            __builtin_amdgcn_fence(__ATOMIC_RELEASE, "agent");
            asm volatile("s_waitcnt vmcnt(0)" ::: "memory");
            const unsigned og = xb_add(&bar[XB_TOP], 1u);
            const unsigned tg = og / nx;
            if (og + 1u == (tg + 1u) * nx) xb_add(&bar[XB_TOPGEN], 1u);
            else XB_SPIN(xb_ld(&bar[XB_TOPGEN]) == tg, bar);
            __builtin_amdgcn_fence(__ATOMIC_ACQUIRE, "agent");
            xb_add(&bar[XB_XGEN(b.x)], 1u);
            asm volatile("s_waitcnt vmcnt(0)" ::: "memory");
        } else {
            XB_SPIN(xb_ld(&bar[XB_XGEN(b.x)]) == gen, bar);
            __builtin_amdgcn_fence(__ATOMIC_ACQUIRE, "agent");
            asm volatile("s_waitcnt vmcnt(0)" ::: "memory");
        }
    }
    __syncthreads();
}


constexpr int CW_BAR = 4096;
constexpr int N_PHASES = 10;
#ifndef PHASE_MASK
#define PHASE_MASK 0x3FF
#endif
#ifndef PROBE_LO
#define PROBE_LO -1
#endif
#ifndef PROBE_HI
#define PROBE_HI -1
#endif
#ifndef MK_COOP
#define MK_COOP 1
#endif

__global__ void __launch_bounds__(NTHR, 2) mega_fwd(Args args) {
    extern __shared__ __attribute__((aligned(16))) unsigned char lds_raw[];
    Frame F;
    F.lds = (LAS unsigned char*)lds_raw;
    F.MISC = (volatile LAS unsigned*)(F.lds + MISC_OFF);
    F.tid = threadIdx.x; F.lane = F.tid & 63; F.wave = __builtin_amdgcn_readfirstlane(F.tid >> 6);
    F.G = gridDim.x; F.bid = blockIdx.x; F.pacc = 0ull;
    if (F.tid < 32) F.MISC[F.tid] = 0u;
    __syncthreads();
    F.ws = args.ws;
    const Args& A = args;
    bf16* OPROJ = WSP(bf16, WS_P); bf16* Y = WSP(bf16, WS_P);

    const int lo = args.ph_lo, hi = args.ph_hi;
    XcdBarrier xbar; xbar.bar = WSP(unsigned, WS_CTL) + CW_BAR; xbar.x = 0; xbar.st = nullptr;
    if (args.coop) xbar = xcd_barrier_post(WSP(unsigned, WS_CTL) + CW_BAR, F.MISC + 8);
#define IN(k) (lo <= (k) && (k) < hi)
    unsigned long long pr_a = 0ull, pr_b = 0ull;
#define SEAM(k) do { if (IN(k) && IN((k) + 1)) { if (args.coop) { if ((k) == 0) cg::this_grid().sync(); else xcd_barrier(xbar); } } \
        if (PROBE_LO == (k) + 1) pr_a = __builtin_amdgcn_s_memrealtime(); if (PROBE_HI == (k)) pr_b = __builtin_amdgcn_s_memrealtime(); } while (0)
    if (PROBE_LO == 0) pr_a = __builtin_amdgcn_s_memrealtime();

    if (((PHASE_MASK >> 0) & 1) && IN(0)) { phase_p0(F, A); }
    SEAM(0);
    if (((PHASE_MASK >> 1) & 1) && IN(1)) { phase_e0(F, A); }
    SEAM(1);
    if (((PHASE_MASK >> 2) & 1) && IN(2)) {
        pg8::Gemm g{WSP(bf16, WS_XN), WSP(bf16, WS_WIN), M, NPROJ, D}; pg8::StaticOrder S; S.init(M, NPROJ, F.G, F.bid);
        pg8::EpiProj E{WSP(bf16, WS_P), WSP(float, WS_MISC), WSP(float, WS_CS)};
        pg8::gemm_phase<pg8::EpiProj, pg8::StaticOrder, true, true>(F.lds, g, S, E);
    }
    SEAM(2);
    if (((PHASE_MASK >> 3) & 1) && IN(3)) { phase_a1(F); }
    SEAM(3);
    if (((PHASE_MASK >> 4) & 1) && IN(4)) { phase_a2(F); }
    SEAM(4);
    if (((PHASE_MASK >> 5) & 1) && IN(5)) {
        pg8::Gemm g{WSP(bf16, WS_XN), WSP(bf16, WS_WOUT), M, D, D}; pg8::StaticOrder S; S.init(M, D, F.G, F.bid);
        pg8::EpiStore<0> E{OPROJ, D};
        pg8::gemm_phase<pg8::EpiStore<0>, pg8::StaticOrder, true, true>(F.lds, g, S, E);
    }
    SEAM(5);
    if (((PHASE_MASK >> 6) & 1) && IN(6)) { phase_e1(F, A, OPROJ); }
    SEAM(6);
    if (((PHASE_MASK >> 7) & 1) && IN(7)) {
        pg8::Gemm g{WSP(bf16, WS_XN), WSP(bf16, WS_WUP), M, FF, D}; pg8::StaticOrder S; S.init(M, FF, F.G, F.bid);
        pg8::EpiStore<1> E{WSP(bf16, WS_SC), FF};
        pg8::gemm_phase<pg8::EpiStore<1>, pg8::StaticOrder, true, true>(F.lds, g, S, E);
    }
    SEAM(7);
    if (((PHASE_MASK >> 8) & 1) && IN(8)) {
        pg8::Gemm g{WSP(bf16, WS_SC), WSP(bf16, WS_WDOWN), M, D, FF}; pg8::StaticOrder S; S.init(M, D, F.G, F.bid);
        pg8::EpiStore<0> E{Y, D};
        pg8::gemm_phase<pg8::EpiStore<0>, pg8::StaticOrder, true, true>(F.lds, g, S, E);
    }
    SEAM(8);
    if (((PHASE_MASK >> 9) & 1) && IN(9)) { phase_e2(F, A, Y); }
    if (PROBE_HI == 9) { __syncthreads(); pr_b = __builtin_amdgcn_s_memrealtime(); }
    if ((PROBE_LO >= 0 || PROBE_SEC > 0) && F.bid == 0 && F.tid == 0) {
        const unsigned long long t0 = __builtin_amdgcn_s_memrealtime(), span = PROBE_SEC > 0 ? F.pacc : pr_b - pr_a;
        while (__builtin_amdgcn_s_memrealtime() - t0 < span) __builtin_amdgcn_s_sleep(32);
    }
#undef IN
#undef SEAM
}

extern "C" void kernel_launch(void* const* d_in, const int* in_sizes, int n_in, void* d_out, int out_size, void* d_ws, size_t ws_size, hipStream_t stream) {
    static int grid = 0;
    if (grid == 0) {
        if (n_in != 19 || in_sizes[0] != M * D || out_size != M * D || ws_size < WS_END) {
            fprintf(stderr, "kernel_launch: unexpected shapes: n_in %d in0 %d out %d ws %zu (need %zu)\n", n_in, n_in > 0 ? in_sizes[0] : -1, out_size, ws_size, (size_t)WS_END); grid = -1; return; }
        int dev = 0, cus = 0, per_cu = 0;
        if (hipGetDevice(&dev) != hipSuccess || hipDeviceGetAttribute(&cus, hipDeviceAttributeMultiprocessorCount, dev) != hipSuccess) { fprintf(stderr, "kernel_launch: device query failed\n"); grid = -1; return; }
        if (hipFuncSetAttribute((const void*)mega_fwd, hipFuncAttributeMaxDynamicSharedMemorySize, LDS_BYTES) != hipSuccess) { fprintf(stderr, "kernel_launch: hipFuncSetAttribute failed\n"); grid = -1; return; }
        if (hipOccupancyMaxActiveBlocksPerMultiprocessor(&per_cu, (const void*)mega_fwd, NTHR, LDS_BYTES) != hipSuccess || per_cu < 1) { fprintf(stderr, "kernel_launch: occupancy query says %d\n", per_cu); per_cu = 1; }
        (void)hipGetLastError();
        grid = cus;
        fprintf(stderr, "kernel_launch: cus %d per_cu %d grid %d\n", cus, per_cu, grid);
    }
    if (grid < 0) return;
    if (hipMemsetAsync((char*)d_ws + WS_CTL, 0, CTL_ZERO_BYTES, stream) != hipSuccess) { fprintf(stderr, "kernel_launch: memset failed\n"); return; }
    Args a{};
    for (int i = 0; i < 19; ++i) a.in[i] = d_in[i];
    a.out = (float*)d_out; a.ws = (unsigned char*)d_ws;
#if MK_COOP
    a.ph_lo = 0; a.ph_hi = N_PHASES; a.coop = 1;
    void* kargs[] = {&a};
    hipError_t e = hipLaunchCooperativeKernel((const void*)mega_fwd, dim3(grid), dim3(NTHR), kargs, LDS_BYTES, stream);
    if (e != hipSuccess) fprintf(stderr, "kernel_launch: cooperative launch failed: %s (grid %d)\n", hipGetErrorString(e), grid);
#else
    for (int ph = 0; ph < N_PHASES; ++ph) {
        a.ph_lo = ph; a.ph_hi = ph + 1; a.coop = 0;
        hipLaunchKernelGGL(mega_fwd, dim3(grid), dim3(NTHR), LDS_BYTES, stream, a);
        const hipError_t le = hipPeekAtLastError();
        if (le != hipSuccess) { fprintf(stderr, "kernel_launch: launch %d failed: %s\n", ph, hipGetErrorName(le)); break; }
    }
#endif
}
```

```cpp
#include <hip/hip_runtime.h>
#include <hip/hip_cooperative_groups.h>
#include <cstdio>
#include <cstdint>
namespace cg = cooperative_groups;
#define DI __device__ __forceinline__
namespace pg8 {
#define PG8_LAS __attribute__((address_space(3)))
typedef unsigned short bf16_t;
typedef short bf16x8 __attribute__((ext_vector_type(8)));
typedef float f32x4 __attribute__((ext_vector_type(4)));
typedef unsigned u32x4 __attribute__((ext_vector_type(4)));
constexpr int BM = 256, BK = 64, HALF = 128, HTB = HALF * BK * 2  , STAGE_BYTES = 8 * HTB, NXCD = 8, WGM = 8;

__host__ __device__ __forceinline__ int lds_byte(int r, int c) { const int st = (r >> 4) * 2 + (c >> 5), rr = r & 15, cc = c & 31, ob = rr * 64 + cc * 2; return st * 1024 + (ob ^ (((ob >> 9) & 1) << 5)); }
__host__ __device__ __forceinline__ void stage_rc(int b, int& R, int& C) { const int st = b / 1024, sb = b % 1024, swz = sb ^ (((sb >> 9) & 1) << 5); R = (st >> 1) * 16 + swz / 64; C = (st & 1) * 32 + (swz % 64) / 2; }
__host__ __device__ __forceinline__ int perm32(int rho) { const int n = rho >> 4, i = rho & 15; return 8 * (i >> 2) + 4 * n + (i & 3); }

struct Unit { int pm, pn; };
struct Gemm { const bf16_t* A; const bf16_t* Bt; int M, N, K; };

struct StaticOrder {
    int nM, nN, nwg, G, c;
    __host__ __device__ void init(int M, int N, int G_, int c_) { nM = M / BM; nN = N / BM; nwg = nM * nN; G = G_; c = c_; }
    __host__ __device__ bool next(int i, Unit& u) const {
        const long L = (long)i * G + c; if (L >= nwg) return false;
        int wgid = (int)L; { const int q = nwg / NXCD, r = nwg % NXCD, xcd = wgid % NXCD, off = wgid / NXCD; wgid = (xcd < r ? xcd * (q + 1) : r * (q + 1) + (xcd - r) * q) + off; }
        const int nig = WGM * nN, gid = wgid / nig, fm = gid * WGM, gsz = (nM - fm) < WGM ? (nM - fm) : WGM;
        u.pm = fm + ((wgid % nig) % gsz); u.pn = (wgid % nig) / gsz; return true;
    }
    __device__ __forceinline__ void a_ready(const Unit&) const {}
    __device__ __forceinline__ void done(const Unit&) const {}
};


typedef float f32x2 __attribute__((ext_vector_type(2)));
typedef unsigned u32x2 __attribute__((ext_vector_type(2)));
typedef __bf16 bf16x2_t __attribute__((ext_vector_type(2)));
__device__ __forceinline__ unsigned cvt_pk_bf16(float lo, float hi) { f32x2 v = {lo, hi}; bf16x2_t b = __builtin_convertvector(v, bf16x2_t); return __builtin_bit_cast(unsigned, b); }

template <int ACT  > struct EpiStore {
    static constexpr bool PERM = true, AFTER_DRAIN = false;
    bf16_t* O; int ldc;
    __device__ __forceinline__ void operator()(const f32x4 (&acc)[2][2][4][2], const Unit& u, int wr, int wc, int fr, int fq) const {
        const int row0 = u.pm * BM + wr * 64 + fr; const int col0 = u.pn * BM + wc * 32 + 8 * fq;
#pragma unroll
        for (int ai = 0; ai < 2; ++ai)
#pragma unroll
            for (int m = 0; m < 4; ++m) { bf16_t* rowp = O + (size_t)(row0 + ai * HALF + m * 16) * ldc + col0;
#pragma unroll
                for (int bj = 0; bj < 2; ++bj) { f32x4 v0 = acc[ai][bj][m][0], v1 = acc[ai][bj][m][1];
                    if (ACT == 1) {
#pragma unroll
                        for (int i = 0; i < 4; ++i) { const float a = v0[i] > 0.f ? v0[i] : 0.f, b = v1[i] > 0.f ? v1[i] : 0.f; v0[i] = a * a; v1[i] = b * b; } }
                    u32x4 w; w.x = cvt_pk_bf16(v0[0], v0[1]); w.y = cvt_pk_bf16(v0[2], v0[3]); w.z = cvt_pk_bf16(v1[0], v1[1]); w.w = cvt_pk_bf16(v1[2], v1[3]);
                    *(u32x4*)(rowp + bj * HALF) = w; } }
    }
};

struct EpiProj {
    static constexpr bool PERM = true, AFTER_DRAIN = false;
    bf16_t* P; float* MISC; const float* CS;
    __device__ __forceinline__ void operator()(const f32x4 (&acc)[2][2][4][2], const Unit& u, int wr, int wc, int fr, int fq) const {
        const int row0 = u.pm * BM + wr * 64 + fr; const int qd = 4 * (wc & 1) + fq;
        constexpr unsigned long long ROPE_MASK = 0x00000007DFF333FFull;
        constexpr float QSCALE = 0.125f * 1.4426950408889634f;
#pragma unroll
        for (int ai = 0; ai < 2; ++ai)
#pragma unroll
            for (int m = 0; m < 4; ++m) {
                const int row = row0 + ai * HALF + m * 16;
                const f32x4 c01 = *(const f32x4*)(CS + (size_t)row * 64 + 8 * qd), c23 = *(const f32x4*)(CS + (size_t)row * 64 + 8 * qd + 4);
                const float cs[4] = {c01[0], c01[2], c23[0], c23[2]}, sn[4] = {c01[1], c01[3], c23[1], c23[3]};
#pragma unroll
                for (int bj = 0; bj < 2; ++bj) {
                    const int hb = u.pn * 4 + bj * 2 + (wc >> 1);
                    const f32x4 v0 = acc[ai][bj][m][0], v1 = acc[ai][bj][m][1];
                    if (hb == 35) {
                        if (qd < 4) { *(f32x4*)(MISC + (size_t)row * 32 + 8 * qd) = v0; *(f32x4*)(MISC + (size_t)row * 32 + 8 * qd + 4) = v1; }
                    } else if ((ROPE_MASK >> hb) & 1ull) {
                        const float sc = (hb < 8 || (hb >= 20 && hb < 28)) ? QSCALE : 1.0f;
                        float o1[4], o2[4];
#pragma unroll
                        for (int i = 0; i < 4; ++i) { o1[i] = (v0[i] * cs[i] - v1[i] * sn[i]) * sc; o2[i] = (v1[i] * cs[i] + v0[i] * sn[i]) * sc; }
                        bf16_t* rp = P + (size_t)row * 2304 + hb * 64 + 4 * qd;
                        u32x2 a, b; a.x = cvt_pk_bf16(o1[0], o1[1]); a.y = cvt_pk_bf16(o1[2], o1[3]); b.x = cvt_pk_bf16(o2[0], o2[1]); b.y = cvt_pk_bf16(o2[2], o2[3]);
                        *(u32x2*)rp = a; *(u32x2*)(rp + 32) = b;
                    } else {
                        u32x4 w; w.x = cvt_pk_bf16(v0[0], v0[1]); w.y = cvt_pk_bf16(v0[2], v0[3]); w.z = cvt_pk_bf16(v1[0], v1[1]); w.w = cvt_pk_bf16(v1[2], v1[3]);
                        *(u32x4*)(P + (size_t)row * 2304 + hb * 64 + 8 * qd) = w;
                    }
                }
            }
    }
};
template <class Epi, class Sched, bool ALIGN_EPI = false, bool SP2 = false>
__device__ __forceinline__ void gemm_phase(PG8_LAS unsigned char* lds, const Gemm g, const Sched& S, const Epi& E) {
    const int tid = threadIdx.x, wid = __builtin_amdgcn_readfirstlane(tid >> 6), lane = tid & 63, wr = wid >> 2, wc = wid & 3, fr = lane & 15, fq = lane >> 4;
    const int K = g.K, nt = K / BK;
    unsigned voffA[2], voffB[2];
#pragma unroll
    for (int i = 0; i < 2; ++i) { int R, C; stage_rc(tid * 16 + i * 8192, R, C); const int Rb = Epi::PERM ? ((R & ~31) + perm32(R & 31)) : R;
        voffA[i] = (unsigned)(R * K + C) * 2u; voffB[i] = (unsigned)(Rb * K + C) * 2u; }
    const size_t kstep = (size_t)(BK * 2);
    const size_t hstep = (size_t)HALF * K * 2;
    const size_t tstep = 2 * hstep;
    const unsigned ldsw = (unsigned)wid * 1024u;
    const int aoff = lds_byte(wr * 64 + fr, fq * 8), boff = lds_byte(wc * 32 + fr, fq * 8);
#define PG8_SA(b, h) (((b) * 2 + (h)) * HTB)
#define PG8_SB(b, h) ((4 + (b) * 2 + (h)) * HTB)
#define PG8_STAGE(bufoff, gbase, voff) do { _Pragma("unroll") for (int _i = 0; _i < 2; ++_i) \
        __builtin_amdgcn_global_load_lds((const unsigned*)((const char*)(gbase) + (voff)[_i]), (PG8_LAS unsigned*)(lds + (bufoff) + ldsw + _i * 8192), 16, 0, 0); } while (0)
#define PG8_LDA(dst, b, h) do { _Pragma("unroll") for (int m = 0; m < 4; ++m) _Pragma("unroll") for (int k = 0; k < 2; ++k) dst[m][k] = *(const PG8_LAS bf16x8*)(lds + PG8_SA(b, h) + aoff + m * 2048 + k * 1024); } while (0)
#define PG8_LDB(dst, b, h) do { _Pragma("unroll") for (int n = 0; n < 2; ++n) _Pragma("unroll") for (int k = 0; k < 2; ++k) dst[n][k] = *(const PG8_LAS bf16x8*)(lds + PG8_SB(b, h) + boff + n * 2048 + k * 1024); } while (0)
#define PG8_MMA(ai, bj, At, Bt) do { __builtin_amdgcn_s_setprio(1); _Pragma("unroll") for (int m = 0; m < 4; ++m) _Pragma("unroll") for (int n = 0; n < 2; ++n) _Pragma("unroll") for (int k = 0; k < 2; ++k) \
        acc[ai][bj][m][n] = __builtin_amdgcn_mfma_f32_16x16x32_bf16(Bt[n][k], At[m][k], acc[ai][bj][m][n], 0, 0, 0); __builtin_amdgcn_s_setprio(0); } while (0)
#define PG8_WAIT_V(n) asm volatile("s_waitcnt vmcnt(" #n ")" ::: "memory")
#define PG8_WAIT_L(n) asm volatile("s_waitcnt lgkmcnt(" #n ")" ::: "memory")
#define PG8_BAR __builtin_amdgcn_s_barrier()
#define PG8_SCHED __builtin_amdgcn_sched_barrier(0)
    Unit cur, nxt; int ui = 0;
    if (!S.next(0, cur)) return;
    f32x4 acc[2][2][4][2];
#pragma unroll
    for (int a = 0; a < 2; ++a)
#pragma unroll
        for (int b = 0; b < 2; ++b)
#pragma unroll
            for (int m = 0; m < 4; ++m)
#pragma unroll
                for (int n = 0; n < 2; ++n) acc[a][b][m][n] = (f32x4){0.f, 0.f, 0.f, 0.f};
    bf16x8 At[4][2], B0[2][2], B1[2][2];
    const char* cA = (const char*)g.A + (size_t)cur.pm * tstep; const char* cB = (const char*)g.Bt + (size_t)cur.pn * tstep;
    S.a_ready(cur);
    if constexpr (SP2) {
        PG8_STAGE(PG8_SB(0, 0), cB, voffB); PG8_STAGE(PG8_SB(0, 1), cB + hstep, voffB); PG8_STAGE(PG8_SA(0, 0), cA, voffA); PG8_STAGE(PG8_SA(0, 1), cA + hstep, voffA);
        if (wr == 1) PG8_BAR;
        PG8_WAIT_V(2); PG8_BAR;
        PG8_STAGE(PG8_SB(1, 0), cB + kstep, voffB); PG8_STAGE(PG8_SA(1, 0), cA + kstep, voffA); PG8_STAGE(PG8_SB(1, 1), cB + hstep + kstep, voffB);
        PG8_WAIT_V(6); PG8_BAR;
    } else {
        PG8_STAGE(PG8_SB(0, 0), cB, voffB); PG8_STAGE(PG8_SA(0, 0), cA, voffA); PG8_STAGE(PG8_SB(0, 1), cB + hstep, voffB); PG8_STAGE(PG8_SA(0, 1), cA + hstep, voffA);
        if (wr == 1) PG8_BAR;
        PG8_WAIT_V(4); PG8_BAR;
        PG8_STAGE(PG8_SB(1, 0), cB + kstep, voffB); PG8_STAGE(PG8_SA(1, 0), cA + kstep, voffA); PG8_STAGE(PG8_SB(1, 1), cB + hstep + kstep, voffB);
        PG8_WAIT_V(6); PG8_BAR;
    }
    for (;;) {
        const bool has_next = S.next(ui + 1, nxt);
        const char* nA = has_next ? (const char*)g.A + (size_t)nxt.pm * tstep : cA; const char* nB = has_next ? (const char*)g.Bt + (size_t)nxt.pn * tstep : cB;
        for (int t = 0; t < nt; t += 2) {
            const bool last = (t == nt - 2);
            const char* a1 = cA + (size_t)(t + 1) * kstep;
            const char* a2 = last ? nA : cA + (size_t)(t + 2) * kstep; const char* b2 = last ? nB : cB + (size_t)(t + 2) * kstep;
            const char* a3 = a2 + kstep; const char* b3 = b2 + kstep;
            if (last && has_next) S.a_ready(nxt);
            if constexpr (SP2) {
            PG8_LDB(B0, 0, 0); PG8_LDB(B1, 0, 1); PG8_SCHED; PG8_LDA(At, 0, 0); PG8_STAGE(PG8_SA(1, 1), a1 + hstep, voffA);
            PG8_WAIT_V(8); PG8_WAIT_L(0); PG8_BAR; PG8_MMA(0, 0, At, B0); PG8_MMA(0, 1, At, B1); PG8_BAR; PG8_SCHED;
            PG8_LDA(At, 0, 1); PG8_STAGE(PG8_SB(0, 0), b2, voffB); PG8_STAGE(PG8_SB(0, 1), b2 + hstep, voffB); PG8_STAGE(PG8_SA(0, 0), a2, voffA);
            PG8_WAIT_V(8); PG8_WAIT_L(0); PG8_BAR; PG8_MMA(1, 0, At, B0); PG8_MMA(1, 1, At, B1); PG8_BAR; PG8_SCHED;
            PG8_LDB(B0, 1, 0); PG8_LDB(B1, 1, 1); PG8_SCHED; PG8_LDA(At, 1, 0); PG8_STAGE(PG8_SA(0, 1), a2 + hstep, voffA);
            PG8_WAIT_V(8); PG8_WAIT_L(0); PG8_BAR; PG8_MMA(0, 0, At, B0); PG8_MMA(0, 1, At, B1); PG8_BAR; PG8_SCHED;
            PG8_LDA(At, 1, 1); PG8_STAGE(PG8_SB(1, 0), b3, voffB); PG8_STAGE(PG8_SB(1, 1), b3 + hstep, voffB); PG8_STAGE(PG8_SA(1, 0), a3, voffA);
            PG8_WAIT_V(8); PG8_WAIT_L(0); PG8_BAR; PG8_MMA(1, 0, At, B0); PG8_MMA(1, 1, At, B1); PG8_BAR; PG8_SCHED;
            } else {
            PG8_LDB(B0, 0, 0); PG8_SCHED; PG8_LDA(At, 0, 0); PG8_STAGE(PG8_SA(1, 1), a1 + hstep, voffA);
            PG8_WAIT_L(8); PG8_BAR; PG8_WAIT_L(0); PG8_MMA(0, 0, At, B0); PG8_BAR; PG8_SCHED;
            PG8_LDB(B1, 0, 1); PG8_STAGE(PG8_SB(0, 0), b2, voffB);
            PG8_BAR; PG8_WAIT_L(0); PG8_MMA(0, 1, At, B1); PG8_BAR;
            PG8_LDA(At, 0, 1); PG8_STAGE(PG8_SA(0, 0), a2, voffA);
            PG8_BAR; PG8_WAIT_L(0); PG8_MMA(1, 0, At, B0); PG8_BAR; PG8_SCHED;
            PG8_STAGE(PG8_SB(0, 1), b2 + hstep, voffB);
            PG8_WAIT_V(6); PG8_BAR; PG8_MMA(1, 1, At, B1); PG8_BAR;
            PG8_LDB(B0, 1, 0); PG8_SCHED; PG8_LDA(At, 1, 0); PG8_STAGE(PG8_SA(0, 1), a2 + hstep, voffA);
            PG8_WAIT_L(8); PG8_BAR; PG8_WAIT_L(0); PG8_MMA(0, 0, At, B0); PG8_BAR; PG8_SCHED;
            PG8_LDB(B1, 1, 1); PG8_STAGE(PG8_SB(1, 0), b3, voffB);
            PG8_BAR; PG8_WAIT_L(0); PG8_MMA(0, 1, At, B1); PG8_BAR;
            PG8_LDA(At, 1, 1); PG8_STAGE(PG8_SA(1, 0), a3, voffA);
            PG8_BAR; PG8_WAIT_L(0); PG8_MMA(1, 0, At, B0); PG8_BAR; PG8_SCHED;
            PG8_STAGE(PG8_SB(1, 1), b3 + hstep, voffB);
            PG8_WAIT_V(6); PG8_BAR; PG8_MMA(1, 1, At, B1); PG8_BAR;
            }
        }
        if constexpr (ALIGN_EPI) { if (wr == 0) PG8_BAR; }
        if constexpr (!Epi::AFTER_DRAIN) { E(acc, cur, wr, wc, fr, fq); S.done(cur); }
        if (!has_next) break;
#pragma unroll
        for (int a = 0; a < 2; ++a)
#pragma unroll
            for (int b = 0; b < 2; ++b)
#pragma unroll
                for (int m = 0; m < 4; ++m)
#pragma unroll
                    for (int n = 0; n < 2; ++n) acc[a][b][m][n] = (f32x4){0.f, 0.f, 0.f, 0.f};
        cur = nxt; cA = nA; cB = nB; ++ui;
        if constexpr (ALIGN_EPI) { if (wr == 1) PG8_BAR; }
    }
    PG8_WAIT_V(0);
    if constexpr (!ALIGN_EPI) { if (wr == 0) PG8_BAR; }
    PG8_BAR;
    if constexpr (Epi::AFTER_DRAIN) { E.fused(acc, cur, wr, wc, fr, fq, lds, wid, lane); S.done(cur); }
#undef PG8_SA
#undef PG8_SB
#undef PG8_STAGE
#undef PG8_LDA
#undef PG8_LDB
#undef PG8_MMA
#undef PG8_WAIT_V
#undef PG8_WAIT_L
#undef PG8_BAR
#undef PG8_SCHED
}
}

constexpr int NB = 32, T = 2048, D = 1024, M = NB * T, FF = 4096, NPROJ = 2304, PP = NPROJ;
constexpr int HB_QN = 0, HB_KC = 8, HB_VC = 10, HB_KSL = 12, HB_VSL = 14, HB_KW = 16, HB_VW = 18, HB_QD = 20, HB_KD = 28, HB_VD = 29, HB_QI = 30, HB_KI = 34, HB_MISC = 35;
constexpr int NWAVES = 8, NTHR = 512;
constexpr float RMS_EPS = 1e-6f;

constexpr size_t MiB = 1u << 20;
constexpr size_t WS_CTL = 0, CTL_ZERO_BYTES = 64 * 1024;
constexpr size_t WS_MOD = 1 * MiB;
constexpr size_t WS_BIASC = 1 * MiB + 800 * 1024;
constexpr size_t WS_CS = 2 * MiB;
constexpr size_t WS_WIN = 18 * MiB;
constexpr size_t WS_WOUT = 23 * MiB;
constexpr size_t WS_WUP = 25 * MiB;
constexpr size_t WS_WDOWN = 33 * MiB;
constexpr size_t WS_W1K = 41 * MiB, WS_W1V = 41 * MiB + 512 * 1024;
constexpr size_t WS_W2K = 42 * MiB, WS_W2V = 42 * MiB + 64 * 1024;
constexpr size_t WS_KCMP = 43 * MiB, WS_VCMP = 44 * MiB;
constexpr size_t WS_MISC = 45 * MiB;
constexpr size_t WS_XN = 64 * MiB;
constexpr size_t WS_P = 192 * MiB;
constexpr size_t WS_SC = 480 * MiB;
constexpr size_t WS_END = 992 * MiB;
constexpr int SC_TILES_PER_B = 528;

constexpr int RING_BYTES = 131072;
constexpr int MISC_OFF = RING_BYTES + 320;
constexpr int LDS_BYTES = 161792;

#define LAS __attribute__((address_space(3)))
typedef unsigned short bf16;
typedef short bf16x8 __attribute__((ext_vector_type(8)));
typedef short s16x4 __attribute__((ext_vector_type(4)));
typedef float f32x4 __attribute__((ext_vector_type(4)));
typedef float f32x16 __attribute__((ext_vector_type(16)));
typedef unsigned u32x4 __attribute__((ext_vector_type(4)));
typedef unsigned u32x2 __attribute__((ext_vector_type(2)));
typedef unsigned long long u64;
#define MFMA32(a, b, c) __builtin_amdgcn_mfma_f32_32x32x16_bf16((a), (b), (c), 0, 0, 0)
#define LDS_WAIT() asm volatile("s_waitcnt lgkmcnt(0)" ::: "memory")

DI unsigned pk2(float lo, float hi) { return pg8::cvt_pk_bf16(lo, hi); }
DI float bf2f(unsigned short v) { return __uint_as_float((unsigned)v << 16); }
DI int crow(int r, int hi) { return (r & 3) + 8 * (r >> 2) + 4 * hi; }
DI float wave_sum(float v) {
#pragma unroll
    for (int o = 1; o < 64; o <<= 1) v += __shfl_xor(v, o);
    return v;
}
DI int launder(int x) { asm volatile("" : "+v"(x)); return x; }
DI float fast_exp2(float x) { return __builtin_amdgcn_exp2f(x); }
DI float gelu_tanh(float x) {
    const float u = 0.7978845608028654f * (x + 0.044715f * x * x * x);
    const float e = __expf(2.0f * u);
    const float th = 1.0f - 2.0f / (e + 1.0f);
    return 0.5f * x * (1.0f + th);
}

struct Frame {
    LAS unsigned char* lds;
    volatile LAS unsigned* MISC;
    unsigned char* ws;
    int tid, lane, wave, G, bid;
    unsigned long long pacc;
};
#ifndef PROBE_SEC
#define PROBE_SEC 0
#endif
#define SEC_BEGIN(k) unsigned long long _ps##k = 0; if (PROBE_SEC == (k)) _ps##k = __builtin_amdgcn_s_memrealtime()
#define SEC_END(k) do { if (PROBE_SEC == (k)) F.pacc += __builtin_amdgcn_s_memrealtime() - _ps##k; } while (0)
struct Args { const void* in[19]; float* out; unsigned char* ws; int ph_lo, ph_hi, coop, pad; };
#define WSP(type, off) ((type*)(F.ws + (off)))
#define INP(type, i) ((const type*)A.in[i])

DI int q_next(Frame& F, unsigned* ctr) {
    __syncthreads();
    if (F.tid == 0) F.MISC[0] = __hip_atomic_fetch_add(ctr, 1u, __ATOMIC_RELAXED, __HIP_MEMORY_SCOPE_AGENT);
    __syncthreads();
    return (int)F.MISC[0];
}

DI int proj_src_col(int n) {
    const int hb = n >> 6, p = n & 63;
    if (hb == 35) return p < 24 ? 1280 + p : (p < 28 ? 2264 + (p - 24) : -1);
    const int base = hb < 20 ? 64 * hb : 1304 + 64 * (hb - 20);
    constexpr u64 ROPE_MASK = 0x00000007DFF333FFull;
    int d = p;
    if ((ROPE_MASK >> hb) & 1ull) { const int q = p >> 3, i = p & 7; d = i < 4 ? 4 * q + i : 32 + 4 * q + (i - 4); }
    return base + d;
}
template <bool PERMUTE> DI void transpose_item(const float* W, int ldw, int K, int N, bf16* WT, LAS float* scr, int item, int lane) {
    const int nblk = N / 32, kb = item / nblk, nb = item % nblk, k0 = 64 * kb, n0 = 32 * nb;
    const int ncol = n0 + (lane & 31); const int src = PERMUTE ? proj_src_col(ncol) : ncol;
    float tv[32];
    const int srcc = src >= 0 ? src : 0;
#pragma unroll
    for (int i = 0; i < 32; ++i) { const int kk = 2 * i + (lane >> 5); tv[i] = W[(size_t)(k0 + kk) * ldw + srcc]; }
#pragma unroll
    for (int i = 0; i < 32; ++i) { const int kk = 2 * i + (lane >> 5); scr[kk * 33 + (lane & 31)] = src >= 0 ? tv[i] : 0.f; }
    LDS_WAIT();
    const int cch = lane & 7;
#pragma unroll
    for (int j = 0; j < 4; ++j) { const int n = (lane >> 3) + 8 * j; const LAS float* s = scr + (8 * cch) * 33 + n;
        u32x4 o; o.x = pk2(s[0 * 33], s[1 * 33]); o.y = pk2(s[2 * 33], s[3 * 33]); o.z = pk2(s[4 * 33], s[5 * 33]); o.w = pk2(s[6 * 33], s[7 * 33]);
        *(u32x4*)(WT + (size_t)(n0 + n) * K + k0 + 8 * cch) = o; }
    LDS_WAIT();
}
DI void phase_p0(Frame& F, const Args& A) {
    LAS float* scr = (LAS float*)(F.lds + F.wave * 16384);
    const int gw = F.bid * NWAVES + F.wave, NGW = F.G * NWAVES;
    constexpr int I_IN = (D / 64) * (NPROJ / 32), I_OUT = (D / 64) * (D / 32), I_UP = (D / 64) * (FF / 32), I_DN = (FF / 64) * (D / 32), I_W1 = (2048 / 64) * (128 / 32), I_W2 = (128 / 64) * (64 / 32);
    constexpr int NITEMS = I_IN + I_OUT + I_UP + I_DN + 2 * I_W1 + 2 * I_W2;
    SEC_BEGIN(8);
    for (int it = gw; it < NITEMS; it += NGW) {
        int r = it;
        if (r < I_IN) { transpose_item<true>(INP(float, 9), 2268, D, NPROJ, WSP(bf16, WS_WIN), scr, r, F.lane); continue; } r -= I_IN;
        if (r < I_OUT) { transpose_item<false>(INP(float, 16), D, D, D, WSP(bf16, WS_WOUT), scr, r, F.lane); continue; } r -= I_OUT;
        if (r < I_UP) { transpose_item<false>(INP(float, 17), FF, D, FF, WSP(bf16, WS_WUP), scr, r, F.lane); continue; } r -= I_UP;
        if (r < I_DN) { transpose_item<false>(INP(float, 18), D, FF, D, WSP(bf16, WS_WDOWN), scr, r, F.lane); continue; } r -= I_DN;
        if (r < I_W1) { transpose_item<false>(INP(float, 12), 128, 2048, 128, WSP(bf16, WS_W1K), scr, r, F.lane); continue; } r -= I_W1;
        if (r < I_W1) { transpose_item<false>(INP(float, 14), 128, 2048, 128, WSP(bf16, WS_W1V), scr, r, F.lane); continue; } r -= I_W1;
        if (r < I_W2) { transpose_item<false>(INP(float, 13), 64, 128, 64, WSP(bf16, WS_W2K), scr, r, F.lane); continue; } r -= I_W2;
        transpose_item<false>(INP(float, 15), 64, 128, 64, WSP(bf16, WS_W2V), scr, r, F.lane);
    }
    SEC_END(8);
    SEC_BEGIN(9);
    const int gt = F.bid * NTHR + F.tid, NGT = F.G * NTHR;
    for (int it = F.bid; it < (6 * D) / 32; it += F.G) {
        LAS float* cl = (LAS float*)(F.lds + F.wave * 16384);
        const int k0 = 128 * F.wave;
#pragma unroll 8
        for (int e = F.lane; e < 128 * 32; e += 64) { const int kk = e & 127, bb = e >> 7; cl[kk * 32 + bb] = INP(float, 1)[bb * D + k0 + kk]; }
        LDS_WAIT();
        const int n = F.lane & 31, bh = F.lane >> 5;
        const float* wp = INP(float, 3) + (size_t)k0 * (6 * D) + it * 32 + n;
        float acc[16];
#pragma unroll
        for (int i = 0; i < 16; ++i) acc[i] = 0.f;
#pragma unroll 1
        for (int kc = 0; kc < 128; kc += 32) {
          float wv[32];
#pragma unroll
          for (int u = 0; u < 32; ++u) wv[u] = wp[(size_t)(kc + u) * (6 * D)];
#pragma unroll
          for (int u = 0; u < 32; ++u) {
            const int kk = kc + u; const float w = wv[u];
            const LAS f32x4* cr = (const LAS f32x4*)(cl + kk * 32 + 16 * bh);
            const f32x4 c0 = cr[0], c1 = cr[1], c2 = cr[2], c3 = cr[3];
#pragma unroll
            for (int i = 0; i < 4; ++i) { acc[i] = fmaf(c0[i], w, acc[i]); acc[4 + i] = fmaf(c1[i], w, acc[4 + i]); acc[8 + i] = fmaf(c2[i], w, acc[8 + i]); acc[12 + i] = fmaf(c3[i], w, acc[12 + i]); }
          }
        }
        __syncthreads();
        LAS float* pr = (LAS float*)F.lds + F.wave * 1024;
#pragma unroll
        for (int i = 0; i < 16; ++i) pr[(16 * bh + i) * 32 + n] = acc[i];
        __syncthreads();
        for (int e = F.tid; e < 1024; e += NTHR) {
            const LAS float* q = (const LAS float*)F.lds + e;
            const float sum = ((q[0] + q[1024]) + (q[2048] + q[3072])) + ((q[4096] + q[5120]) + (q[6144] + q[7168]));
            const int bb = e >> 5, nn = e & 31;
            WSP(float, WS_MOD)[(size_t)bb * (6 * D) + it * 32 + nn] = INP(float, 4)[it * 32 + nn] + sum;
        }
        __syncthreads();
    }
    SEC_END(9);
    SEC_BEGIN(10);
    for (int idx = gt; idx < M * 32; idx += NGT) {
        const int m = idx >> 5, d = idx & 31;
        const float inv = powf(10000.0f, -(float)d / 32.0f);
        const float ang = (float)INP(int, 2)[m] * inv;
        WSP(float, WS_CS)[2 * (size_t)idx] = cosf(ang); WSP(float, WS_CS)[2 * (size_t)idx + 1] = sinf(ang);
    }
    SEC_END(10);
}

DI float sumsq4(const f32x4 (&v)[4]) { float s = 0.f;
#pragma unroll
    for (int j = 0; j < 4; ++j) s += (v[j].x * v[j].x + v[j].y * v[j].y) + (v[j].z * v[j].z + v[j].w * v[j].w);
    return s; }
DI void unpack_bf16x4(f32x4& o, u64 w) { o.x = bf2f((unsigned short)w); o.y = bf2f((unsigned short)(w >> 16)); o.z = bf2f((unsigned short)(w >> 32)); o.w = bf2f((unsigned short)(w >> 48)); }
DI void phase_e0(Frame& F, const Args& A) {
    const int gw = F.bid * NWAVES + F.wave, NGW = F.G * NWAVES;
    for (int o = F.bid; o < 256; o += F.G) {
        const int kv = o >> 7, j = o & 127;
        const float* pe = kv ? INP(float, 11) : INP(float, 10); const float* w1 = kv ? INP(float, 14) : INP(float, 12);
        float p = 0.f;
#pragma unroll
        for (int i = 0; i < 4; ++i) { const int k = F.tid + NTHR * i; p = fmaf(pe[k], w1[(size_t)k * 128 + j], p); }
        p = wave_sum(p);
        LAS float* red = (LAS float*)F.lds;
        if (F.lane == 0) red[F.wave] = p;
        __syncthreads();
        if (F.tid == 0) WSP(float, WS_BIASC)[o] = ((red[0] + red[1]) + (red[2] + red[3])) + ((red[4] + red[5]) + (red[6] + red[7]));
        __syncthreads();
    }
    for (int r0 = gw * 32; r0 < M; r0 += NGW * 32) {
        const int b = r0 / T;
        const float* mod = WSP(float, WS_MOD) + (size_t)b * 6 * D;
        f32x4 ga[4], sh[4];
#pragma unroll
        for (int j = 0; j < 4; ++j) { const int col = 4 * F.lane + 256 * j;
            ga[j] = *(const f32x4*)(INP(float, 5) + col) * (*(const f32x4*)(mod + D + col) + 1.0f); sh[j] = *(const f32x4*)(mod + col); }
#pragma unroll 1
        for (int m = r0; m < r0 + 32; m += 2) {
            const f32x4* xa = (const f32x4*)(INP(float, 0) + (size_t)m * D) + F.lane; const f32x4* xb = xa + D / 4;
            f32x4 va[4], vb[4];
#pragma unroll
            for (int j = 0; j < 4; ++j) { va[j] = xa[64 * j]; vb[j] = xb[64 * j]; }
            const float ra = 1.0f / sqrtf(wave_sum(sumsq4(va)) * (1.0f / D) + RMS_EPS), rb = 1.0f / sqrtf(wave_sum(sumsq4(vb)) * (1.0f / D) + RMS_EPS);
            u64* oa = (u64*)(WSP(bf16, WS_XN) + (size_t)m * D) + F.lane; u64* ob = oa + D / 4;
#pragma unroll
            for (int j = 0; j < 4; ++j) {
                const f32x4 ha = va[j] * ra * ga[j] + sh[j], hb = vb[j] * rb * ga[j] + sh[j];
                oa[64 * j] = (u64)pk2(ha.x, ha.y) | ((u64)pk2(ha.z, ha.w) << 32); ob[64 * j] = (u64)pk2(hb.x, hb.y) | ((u64)pk2(hb.z, hb.w) << 32);
            }
        }
    }
}

DI void phase_e1(Frame& F, const Args& A, const bf16* OPROJ) {
    const int gw = F.bid * NWAVES + F.wave, NGW = F.G * NWAVES;
    for (int r0 = gw * 32; r0 < M; r0 += NGW * 32) {
        const int b = r0 / T;
        const float* mod = WSP(float, WS_MOD) + (size_t)b * 6 * D;
        f32x4 g1[4], g2[4], sh[4];
#pragma unroll
        for (int j = 0; j < 4; ++j) { const int col = 4 * F.lane + 256 * j;
            g1[j] = *(const f32x4*)(INP(float, 6) + col) * *(const f32x4*)(mod + 2 * D + col);
            g2[j] = *(const f32x4*)(INP(float, 7) + col) * (*(const f32x4*)(mod + 4 * D + col) + 1.0f); sh[j] = *(const f32x4*)(mod + 3 * D + col); }
#pragma unroll 1
        for (int m = r0; m < r0 + 32; m += 2) {
            const f32x4* xa = (const f32x4*)(INP(float, 0) + (size_t)m * D) + F.lane; const f32x4* xb = xa + D / 4;
            const u64* pa = (const u64*)(OPROJ + (size_t)m * D) + F.lane; const u64* pb = pa + D / 4;
            f32x4 xva[4], xvb[4], oa[4], ob[4];
#pragma unroll
            for (int j = 0; j < 4; ++j) { xva[j] = xa[64 * j]; xvb[j] = xb[64 * j]; unpack_bf16x4(oa[j], pa[64 * j]); unpack_bf16x4(ob[j], pb[64 * j]); }
            const float ra = 1.0f / sqrtf(wave_sum(sumsq4(oa)) * (1.0f / D) + RMS_EPS), rb = 1.0f / sqrtf(wave_sum(sumsq4(ob)) * (1.0f / D) + RMS_EPS);
            f32x4* outa = (f32x4*)(A.out + (size_t)m * D) + F.lane; f32x4* outb = outa + D / 4;
#pragma unroll
            for (int j = 0; j < 4; ++j) { xva[j] = xva[j] + g1[j] * (oa[j] * ra); xvb[j] = xvb[j] + g1[j] * (ob[j] * rb); outa[64 * j] = xva[j]; outb[64 * j] = xvb[j]; }
            const float sa = 1.0f / sqrtf(wave_sum(sumsq4(xva)) * (1.0f / D) + RMS_EPS), sb = 1.0f / sqrtf(wave_sum(sumsq4(xvb)) * (1.0f / D) + RMS_EPS);
            u64* ha8 = (u64*)(WSP(bf16, WS_XN) + (size_t)m * D) + F.lane; u64* hb8 = ha8 + D / 4;
#pragma unroll
            for (int j = 0; j < 4; ++j) {
                const f32x4 ha = xva[j] * sa * g2[j] + sh[j], hb = xvb[j] * sb * g2[j] + sh[j];
                ha8[64 * j] = (u64)pk2(ha.x, ha.y) | ((u64)pk2(ha.z, ha.w) << 32); hb8[64 * j] = (u64)pk2(hb.x, hb.y) | ((u64)pk2(hb.z, hb.w) << 32);
            }
        }
    }
}
DI void phase_e2(Frame& F, const Args& A, const bf16* Y) {
    const int gw = F.bid * NWAVES + F.wave, NGW = F.G * NWAVES;
    for (int r0 = gw * 32; r0 < M; r0 += NGW * 32) {
        const int b = r0 / T;
        const float* mod = WSP(float, WS_MOD) + (size_t)b * 6 * D;
        f32x4 g1[4];
#pragma unroll
        for (int j = 0; j < 4; ++j) { const int col = 4 * F.lane + 256 * j; g1[j] = *(const f32x4*)(INP(float, 8) + col) * *(const f32x4*)(mod + 5 * D + col); }
#pragma unroll 1
        for (int m = r0; m < r0 + 32; m += 2) {
            const u64* pa = (const u64*)(Y + (size_t)m * D) + F.lane; const u64* pb = pa + D / 4;
            f32x4* outa = (f32x4*)(A.out + (size_t)m * D) + F.lane; f32x4* outb = outa + D / 4;
            f32x4 ya[4], yb[4], xa[4], xb[4];
#pragma unroll
            for (int j = 0; j < 4; ++j) { unpack_bf16x4(ya[j], pa[64 * j]); unpack_bf16x4(yb[j], pb[64 * j]); xa[j] = outa[64 * j]; xb[j] = outb[64 * j]; }
            const float ra = 1.0f / sqrtf(wave_sum(sumsq4(ya)) * (1.0f / D) + RMS_EPS), rb = 1.0f / sqrtf(wave_sum(sumsq4(yb)) * (1.0f / D) + RMS_EPS);
#pragma unroll
            for (int j = 0; j < 4; ++j) { outa[64 * j] = xa[j] + g1[j] * (ya[j] * ra); outb[64 * j] = xb[j] + g1[j] * (yb[j] * rb); }
        }
    }
}

constexpr int KT_STRIDE = 144, KT_BYTES = 64 * KT_STRIDE, VT_BYTES = 64 * 128;
DI int vt_off(int row, int colbyte) { return row * 128 + (colbyte ^ (((row >> 1) & 1) << 6)); }
struct KVRegs { u32x4 k, v; };
DI void kv_load(KVRegs& r, const bf16* Kg, const bf16* Vg, int tid) {
    const int row = tid >> 3, ch = tid & 7;
    r.k = *(const u32x4*)(Kg + (size_t)row * PP + ch * 8); r.v = *(const u32x4*)(Vg + (size_t)row * PP + ch * 8);
}
DI void kv_store(LAS unsigned char* Kl, LAS unsigned char* Vl, const KVRegs& r, int tid) {
    const int row = tid >> 3, ch = tid & 7;
    *(LAS u32x4*)(Kl + row * KT_STRIDE + ch * 16) = r.k; *(LAS u32x4*)(Vl + vt_off(row, ch * 16)) = r.v;
}
typedef short v4i16_t __attribute__((ext_vector_type(4)));
DI s16x4 vtr(LAS const unsigned char* p) { return __builtin_bit_cast(s16x4, __builtin_amdgcn_ds_read_tr16_b64_v4i16((LAS v4i16_t*)p)); }
DI bf16x8 pack8(const f32x16& p, const int base) {
    u32x4 w; w.x = pk2(p[base], p[base + 1]); w.y = pk2(p[base + 2], p[base + 3]); w.z = pk2(p[base + 4], p[base + 5]); w.w = pk2(p[base + 6], p[base + 7]);
    return __builtin_bit_cast(bf16x8, w);
}
struct LaneAddr { int kb, vb0, vb1; };
DI LaneAddr lane_addr(int lane) {
    const int r32 = lane & 31, hi = lane >> 5, a = lane & 15, g1 = (lane >> 4) & 1, swz = (a >> 3) & 1;
    const int common = (4 * hi + (a >> 2)) * 128 + 32 * g1 + 8 * (a & 3);
    LaneAddr la; la.kb = r32 * KT_STRIDE + hi * 16; la.vb0 = common + 64 * swz; la.vb1 = common + 64 * (1 - swz);
    return la;
}
DI f32x16 qk_block(LAS const unsigned char* lds, const int koff, const bf16x8 (&qr)[4], const LaneAddr& la) {
    f32x16 s;
#pragma unroll
    for (int i = 0; i < 16; ++i) s[i] = 0.f;
    LAS const unsigned char* kb = lds + la.kb;
#pragma unroll
    for (int st = 0; st < 4; ++st) { const bf16x8 a = *(LAS const bf16x8*)(kb + (koff + st * 32)); s = MFMA32(a, qr[st], s); }
    return s;
}
DI void pv_step(f32x16 (&o)[2], LAS const unsigned char* lds, const int voff, const bf16x8 pw, const LaneAddr& la) {
    { const s16x4 lo = vtr(lds + la.vb0 + voff), hh = vtr(lds + la.vb0 + (voff + 1024));
      const bf16x8 vf = __builtin_shufflevector(lo, hh, 0, 1, 2, 3, 4, 5, 6, 7); o[0] = MFMA32(vf, pw, o[0]); }
    { const s16x4 lo = vtr(lds + la.vb1 + voff), hh = vtr(lds + la.vb1 + (voff + 1024));
      const bf16x8 vf = __builtin_shufflevector(lo, hh, 0, 1, 2, 3, 4, 5, 6, 7); o[1] = MFMA32(vf, pw, o[1]); }
}
DI void mask_block(f32x16& s, unsigned w  ) {
#pragma unroll
    for (int r = 0; r < 16; ++r) { const int sh = (r & 3) + 8 * (r >> 2); if (!((w >> sh) & 1u)) s[r] = -INFINITY; }
}
DI float block_max(const f32x16& s) { float m = s[0];
#pragma unroll
    for (int r = 1; r < 16; ++r) m = fmaxf(m, s[r]);
    return m; }
DI float pl32_max(float m) { auto rr = __builtin_amdgcn_permlane32_swap(__float_as_uint(m), __float_as_uint(m), false, false); return fmaxf(__uint_as_float(rr[0]), __uint_as_float(rr[1])); }
DI float pl32_sum(float m) { auto rr = __builtin_amdgcn_permlane32_swap(__float_as_uint(m), __float_as_uint(m), false, false); return __uint_as_float(rr[0]) + __uint_as_float(rr[1]); }
constexpr float ATT_THR = 8.0f;
template <bool ROWLEVEL>
DI void attn_tile(const bf16x8 (&qr)[4], LAS const unsigned char* ldsb  , f32x16 (&o)[2], float& m_ref, float& l_run, u64 vb, const LaneAddr& la, int hi) {
    const float cinit = (ROWLEVEL && vb == 0ull) ? -INFINITY : -m_ref;
    f32x16 p0, p1;
#pragma unroll
    for (int i = 0; i < 16; ++i) { p0[i] = cinit; p1[i] = cinit; }
    {
        LAS const unsigned char* kb = ldsb + la.kb;
#pragma unroll
        for (int st = 0; st < 4; ++st) {
            const bf16x8 a0 = *(LAS const bf16x8*)(kb + st * 32), a1 = *(LAS const bf16x8*)(kb + (32 * KT_STRIDE + st * 32));
            p0 = MFMA32(a0, qr[st], p0); p1 = MFMA32(a1, qr[st], p1);
        }
    }
    float mx = fmaxf(block_max(p0), block_max(p1));
    mx = pl32_max(mx);
    if (__any(mx > ATT_THR)) {
        const float dl = fmaxf(mx, 0.f);
        m_ref += dl;
        const float f = fast_exp2(-dl);
        l_run *= f;
#pragma unroll
        for (int r = 0; r < 16; ++r) { p0[r] -= dl; p1[r] -= dl; o[0][r] *= f; o[1][r] *= f; }
    }
    float rs = 0.f;
    if (ROWLEVEL) {
#pragma unroll
        for (int r = 0; r < 16; ++r) { p0[r] = fast_exp2(p0[r]); p1[r] = fast_exp2(p1[r]); rs += p0[r] + p1[r]; }
    } else {
        const unsigned w0 = (unsigned)vb >> (4 * hi), w1 = (unsigned)(vb >> 32) >> (4 * hi);
#pragma unroll
        for (int r = 0; r < 16; ++r) {
            const int sh = (r & 3) + 8 * (r >> 2);
            const unsigned k0 = (unsigned)__builtin_amdgcn_sbfe(w0, sh, 1), k1 = (unsigned)__builtin_amdgcn_sbfe(w1, sh, 1);
            p0[r] = __uint_as_float(__float_as_uint(fast_exp2(p0[r])) & k0); p1[r] = __uint_as_float(__float_as_uint(fast_exp2(p1[r])) & k1);
            rs += p0[r] + p1[r];
        }
    }
    l_run += rs;
    LAS const unsigned char* vbp = ldsb + KT_BYTES;
    pv_step(o, vbp, 0 * 128, pack8(p0, 0), la);
    pv_step(o, vbp, 16 * 128, pack8(p0, 8), la);
    pv_step(o, vbp, 32 * 128, pack8(p1, 0), la);
    pv_step(o, vbp, 48 * 128, pack8(p1, 8), la);
}
DI u64 causal_bits(int ql) { return ql >= 63 ? ~0ull : ((1ull << (ql + 1)) - 1ull); }

DI void compress_item(Frame& F, int item) {
    const int kv = item & 1, half = (item >> 1) & 1, g = (item >> 2) & 1, b = item >> 3;
    const int lane = launder(F.lane), r32 = lane & 31, hi = lane >> 5, wid = F.wave;
    const bf16* Pb = WSP(bf16, WS_P) + (size_t)b * T * PP + ((kv ? HB_VC : HB_KC) + g) * 64;
    const bf16* W1 = kv ? WSP(bf16, WS_W1V) : WSP(bf16, WS_W1K); const bf16* W2 = kv ? WSP(bf16, WS_W2V) : WSP(bf16, WS_W2K);
    const float* bias = WSP(float, WS_BIASC) + kv * 128;
    bf16* OUT = (kv ? WSP(bf16, WS_VCMP) : WSP(bf16, WS_KCMP)) + (size_t)((b * 2 + g) * 128) * 64;
    LAS unsigned char* H1 = F.lds;
    {
        const int mh = wid & 1, nq = wid >> 1;
        const int n = 64 * half + 32 * mh + r32, nc = n < 126 ? n : 126;
        const bf16* arow = Pb + (size_t)(16 * nc) * PP + hi * 8;
        const bf16* brow = W1 + (size_t)(32 * nq + r32) * 2048 + hi * 8;
        f32x16 acc;
#pragma unroll
        for (int i = 0; i < 16; ++i) acc[i] = 0.f;
#pragma unroll 2
        for (int l = 0; l < 32; ++l) {
#pragma unroll
            for (int ss = 0; ss < 4; ++ss) {
                const bf16x8 a = *(const bf16x8*)(arow + (size_t)l * PP + ss * 16);
                const bf16x8 bb = *(const bf16x8*)(brow + (4 * l + ss) * 16);
                acc = MFMA32(a, bb, acc);
            }
        }
        const float bj = bias[32 * nq + r32];
#pragma unroll
        for (int r = 0; r < 16; ++r) {
            const float h = gelu_tanh(acc[r] + bj);
            *(LAS unsigned short*)(H1 + (32 * mh + crow(r, hi)) * 272 + (32 * nq + r32) * 2) = (unsigned short)(pk2(h, 0.f) & 0xffffu);
        }
    }
    __syncthreads();
    if (wid < 4) {
        const int mh = wid & 1, dh = wid >> 1;
        f32x16 acc;
#pragma unroll
        for (int i = 0; i < 16; ++i) acc[i] = 0.f;
        LAS const unsigned char* ar = H1 + (32 * mh + r32) * 272 + hi * 16;
        const bf16* br = W2 + (size_t)(32 * dh + r32) * 128 + hi * 8;
#pragma unroll
        for (int st = 0; st < 8; ++st) {
            const bf16x8 a = *(LAS const bf16x8*)(ar + st * 32);
            const bf16x8 bb = *(const bf16x8*)(br + st * 16);
            acc = MFMA32(a, bb, acc);
        }
#pragma unroll
        for (int r = 0; r < 16; ++r) OUT[(size_t)(64 * half + 32 * mh + crow(r, hi)) * 64 + 32 * dh + r32] = (bf16)(pk2(acc[r], 0.f) & 0xffffu);
    }
    __syncthreads();
}


constexpr int TILE_PAIR = KT_BYTES + VT_BYTES;
template <class MaskF>
DI void run_tiles(Frame& F, unsigned tmask, const bf16* Kg0, const bf16* Vg0,
                  const bf16x8 (&qr)[4], f32x16 (&o)[2], float& m_ref, float& l_run, const MaskF mf, const LaneAddr& la, const int tid) {
    if (tmask == 0u) return;
    const int hi = (tid >> 5) & 1;
    int j = __builtin_ctz(tmask); tmask &= tmask - 1u;
    KVRegs rg; kv_load(rg, Kg0 + (size_t)(64 * j) * PP, Vg0 + (size_t)(64 * j) * PP, tid);
    __syncthreads();
    kv_store(F.lds, F.lds + KT_BYTES, rg, tid);
    int jn = -1;
    if (tmask) { jn = __builtin_ctz(tmask); tmask &= tmask - 1u; kv_load(rg, Kg0 + (size_t)(64 * jn) * PP, Vg0 + (size_t)(64 * jn) * PP, tid); }
    __syncthreads();
    int par = 0;
    for (;;) {
        int jnn = -1;
        if (jn >= 0) {
            LAS unsigned char* nb = F.lds + (par ^ 1) * TILE_PAIR;
            kv_store(nb, nb + KT_BYTES, rg, tid);
            if (tmask) { jnn = __builtin_ctz(tmask); tmask &= tmask - 1u; kv_load(rg, Kg0 + (size_t)(64 * jnn) * PP, Vg0 + (size_t)(64 * jnn) * PP, tid); }
        }
        const u64 vb = mf(j);
        LAS const unsigned char* cb = F.lds + par * TILE_PAIR;
        if (__all(vb == 0ull || vb == ~0ull)) attn_tile<true>(qr, cb, o, m_ref, l_run, vb, la, hi);
        else attn_tile<false>(qr, cb, o, m_ref, l_run, vb, la, hi);
        if (jn < 0) break;
        __syncthreads();
        j = jn; jn = jnn; par ^= 1;
    }
}
struct SlcMask { unsigned sel; int tb, ql; DI u64 operator()(int j) const { return ((sel >> j) & 1u) ? (j == tb ? causal_bits(ql) : ~0ull) : 0ull; } };
struct WinMask { int tb, ql; DI u64 operator()(int j) const { return j == tb ? causal_bits(ql) : (j == tb - 8 ? ~causal_bits(ql) : ~0ull); } };
struct DsaMask { LAS const u64* row; DI u64 operator()(int j) const { return row[j]; } };

constexpr int NSA_KC = 2 * TILE_PAIR, NSA_VC = NSA_KC + 128 * KT_STRIDE, NSA_IMP = NSA_VC + 128 * 128,
              NSA_SELM = NSA_IMP + 4 * 64 * 33 * 4, NSA_UM = NSA_SELM + 256, NSA_END = NSA_UM + 16;
static_assert(NSA_END <= RING_BYTES, "NSA LDS map");

DI void nsa_unit(Frame& F, int b, int g, int tb) {
    const int tid = launder(F.tid), lane = tid & 63, r32 = lane & 31, hi = lane >> 5, wid = F.wave;
    const int r = wid & 3, th = wid >> 2, hq = 4 * g + r, ql = 32 * th + r32, t = 64 * tb + ql;
    const size_t rowg = (size_t)b * T + t;
    LAS unsigned char* KC = F.lds + NSA_KC; LAS unsigned char* VC = F.lds + NSA_VC;
    const LaneAddr la = lane_addr(lane);
    LAS float* IMP = (LAS float*)(F.lds + NSA_IMP); LAS unsigned* SELM = (LAS unsigned*)(F.lds + NSA_SELM); LAS unsigned* UM = (LAS unsigned*)(F.lds + NSA_UM);
    SEC_BEGIN(1);
    bf16x8 qr[4];
#pragma unroll
    for (int st = 0; st < 4; ++st) qr[st] = *(const bf16x8*)(WSP(bf16, WS_P) + rowg * PP + hq * 64 + 16 * st + 8 * hi);
    float gate[3];
#pragma unroll
    for (int br = 0; br < 3; ++br) { const float xg = WSP(float, WS_MISC)[rowg * 32 + hq * 3 + br]; gate[br] = 1.0f / (1.0f + __expf(-xg)); }
    f32x16 ot[2];
#pragma unroll
    for (int i = 0; i < 16; ++i) { ot[0][i] = 0.f; ot[1][i] = 0.f; }
    {
        const bf16* kc = WSP(bf16, WS_KCMP) + (size_t)((b * 2 + g) * 128) * 64; const bf16* vc = WSP(bf16, WS_VCMP) + (size_t)((b * 2 + g) * 128) * 64;
#pragma unroll
        for (int ps = 0; ps < 2; ++ps) { const int row = (tid >> 3) + 64 * ps, ch = tid & 7;
            const u32x4 kk = *(const u32x4*)(kc + row * 64 + ch * 8), vv = *(const u32x4*)(vc + row * 64 + ch * 8);
            *(LAS u32x4*)(KC + row * KT_STRIDE + ch * 16) = kk; *(LAS u32x4*)(VC + vt_off(row, ch * 16)) = vv; }
        if (tid == 0) UM[0] = 0u;
    }
    __syncthreads();
    {
        const int nq = (t - 31) >> 4;
        float mx = -INFINITY;
#pragma unroll 1
        for (int c = 0; c < 4; ++c) {
            const f32x16 s = qk_block(F.lds, NSA_KC + c * 32 * KT_STRIDE, qr, la);
#pragma unroll
            for (int rg = 0; rg < 16; ++rg) if (32 * c + crow(rg, hi) <= nq) mx = fmaxf(mx, s[rg]);
        }
        mx = fmaxf(mx, __shfl_xor(mx, 32));
        const float ms = fmaxf(mx, -1e30f);
        float l = 0.f, carry = 0.f;
        LAS float* irow = IMP + (r * 64 + ql) * 33;
        f32x16 oc[2];
#pragma unroll
        for (int i = 0; i < 16; ++i) { oc[0][i] = 0.f; oc[1][i] = 0.f; }
#pragma unroll 1
        for (int c = 0; c < 4; ++c) {
            f32x16 p = qk_block(F.lds, NSA_KC + c * 32 * KT_STRIDE, qr, la);
#pragma unroll
            for (int rg = 0; rg < 16; ++rg) { p[rg] = (32 * c + crow(rg, hi) <= nq) ? fast_exp2(p[rg] - ms) : 0.f; l += p[rg]; }
            float sw[4];
#pragma unroll
            for (int u = 0; u < 4; ++u) sw[u] = __shfl_xor(p[4 * u + 3], 32);
#pragma unroll
            for (int u = 0; u < 4; ++u) {
                const float quad = (p[4 * u] + p[4 * u + 1]) + (p[4 * u + 2] + p[4 * u + 3]);
                const float prevlo = u > 0 ? sw[u > 0 ? u - 1 : 0] : carry;
                irow[8 * c + 2 * u + hi] = quad + (hi ? sw[u] : prevlo);
            }
            carry = sw[3];
            pv_step(oc, F.lds, NSA_VC + (32 * c) * 128, pack8(p, 0), la); pv_step(oc, F.lds, NSA_VC + (32 * c + 16) * 128, pack8(p, 8), la);
        }
        l += __shfl_xor(l, 32);
        const float inv = l > 0.f ? 1.0f / l : 0.f;
#pragma unroll
        for (int i = 0; i < 16; ++i) irow[2 * i + hi] *= inv;
        const float gs = gate[0] * inv;
#pragma unroll
        for (int i = 0; i < 16; ++i) { ot[0][i] = gs * oc[0][i]; ot[1][i] = gs * oc[1][i]; }
    }
    __syncthreads();
    if (tb < 16) {
        if (tid < 64) SELM[tid] = (2u << tb) - 1u;
        if (tid == 0) UM[0] = (2u << tb) - 1u;
    } else {
        const int j = lane & 31;
        unsigned um = 0u;
#pragma unroll 1
        for (int ps = 0; ps < 4; ++ps) {
            const int tq = wid * 8 + ps * 2 + hi;
            float v = ((IMP[(0 * 64 + tq) * 33 + j] + IMP[(1 * 64 + tq) * 33 + j]) + IMP[(2 * 64 + tq) * 33 + j]) + IMP[(3 * 64 + tq) * 33 + j];
            if (j > tb) v = -INFINITY; else if (j == 0 || j == tb || j == tb - 1) v = INFINITY;
            int rank = 0;
#pragma unroll 8
            for (int sft = 1; sft < 32; ++sft) {
                const int oj = (j + sft) & 31;
                const float ov = __shfl(v, (lane & 32) | oj);
                rank += (ov > v || (ov == v && oj < j)) ? 1 : 0;
            }
            const u64 bm = __ballot(rank < 16 && j <= tb);
            if (j == 0) SELM[tq] = hi ? (unsigned)(bm >> 32) : (unsigned)bm;
            um |= (unsigned)bm | (unsigned)(bm >> 32);
        }
        if (lane == 0) __hip_atomic_fetch_or(UM, um, __ATOMIC_RELAXED, __HIP_MEMORY_SCOPE_WORKGROUP);
    }
    __syncthreads();
    const unsigned umask = UM[0];
    SEC_END(1);
    SEC_BEGIN(2);
    const unsigned sel = SELM[ql];
    const bf16* Pb = WSP(bf16, WS_P) + (size_t)b * T * PP;
    {
        f32x16 o[2];
#pragma unroll
        for (int i = 0; i < 16; ++i) { o[0][i] = 0.f; o[1][i] = 0.f; }
        float m_run = 0.f, l_run = 0.f;
        SlcMask mf{sel, tb, ql};
        run_tiles(F, umask, Pb + (HB_KSL + g) * 64, Pb + (HB_VSL + g) * 64, qr, o, m_run, l_run, mf, la, tid);
        float l = pl32_sum(l_run);
        const float sc = l > 0.f ? gate[1] / l : 0.f;
#pragma unroll
        for (int i = 0; i < 16; ++i) { ot[0][i] += sc * o[0][i]; ot[1][i] += sc * o[1][i]; }
    }
    SEC_END(2);
    SEC_BEGIN(3);
    {
        f32x16 o[2];
#pragma unroll
        for (int i = 0; i < 16; ++i) { o[0][i] = 0.f; o[1][i] = 0.f; }
        float m_run = 0.f, l_run = 0.f;
        const int jlo = tb >= 8 ? tb - 8 : 0;
        const unsigned wmask = (tb == 31 ? ~0u : ((2u << tb) - 1u)) & ~((1u << jlo) - 1u);
        WinMask mf{tb, ql};
        run_tiles(F, wmask, Pb + (HB_KW + g) * 64, Pb + (HB_VW + g) * 64, qr, o, m_run, l_run, mf, la, tid);
        float l = pl32_sum(l_run);
        const float sc = l > 0.f ? gate[2] / l : 0.f;
#pragma unroll
        for (int i = 0; i < 16; ++i) { ot[0][i] += sc * o[0][i]; ot[1][i] += sc * o[1][i]; }
    }
    SEC_END(3);
    bf16* orow = WSP(bf16, WS_XN) + rowg * D + hq * 64 + 4 * hi;
#pragma unroll
    for (int db = 0; db < 2; ++db)
#pragma unroll
        for (int u = 0; u < 4; ++u) { u32x2 w; w.x = pk2(ot[db][4 * u], ot[db][4 * u + 1]); w.y = pk2(ot[db][4 * u + 2], ot[db][4 * u + 3]); *(u32x2*)(orow + 32 * db + 8 * u) = w; }
}

constexpr int DSA_ROW = 8208, DSA_MB = 131584, DSA_HIST = DSA_MB + 32 * 33 * 8, DSA_END = DSA_HIST + 8 * 2560;
static_assert(16 * DSA_ROW <= MISC_OFF && DSA_MB >= MISC_OFF + 128 && DSA_END <= LDS_BYTES, "DSA LDS map");
typedef float f32x4v __attribute__((ext_vector_type(4)));
#define MFMA16(a, b, c) __builtin_amdgcn_mfma_f32_16x16x32_bf16((a), (b), (c), 0, 0, 0)

DI void dsa_scores16(Frame& F, const bf16* Pb, size_t rowq0, int KB, int lane, int wid) {
    const int q = lane & 15, kg = lane >> 4;
    bf16x8 qf[4][2];
#pragma unroll
    for (int h = 0; h < 4; ++h)
#pragma unroll
        for (int st = 0; st < 2; ++st) qf[h][st] = *(const bf16x8*)(Pb + (rowq0 + q) * PP + (HB_QI + h) * 64 + 32 * st + 8 * kg);
    const float idx_scale = 0.5f * 0.125f;
    const f32x4 wv = *(const f32x4*)(WSP(float, WS_MISC) + (rowq0 + q) * 32 + 24);
    const float w0 = wv[0] * idx_scale, w1 = wv[1] * idx_scale, w2 = wv[2] * idx_scale, w3 = wv[3] * idx_scale;
    LAS unsigned char* rowp = F.lds + q * DSA_ROW;
    const bf16* kbase = Pb + (rowq0 - (rowq0 % T) + q) * PP + HB_KI * 64 + 8 * kg;
    bf16x8 ka[4][2], kn[4][2];
    if (wid < KB) {
#pragma unroll
        for (int blk = 0; blk < 4; ++blk)
#pragma unroll
            for (int st = 0; st < 2; ++st) ka[blk][st] = *(const bf16x8*)(kbase + (size_t)(64 * wid + 16 * blk) * PP + 32 * st);
    }
    for (int kb = wid; kb < KB; kb += 8) {
        if (kb + 8 < KB) {
#pragma unroll
            for (int blk = 0; blk < 4; ++blk)
#pragma unroll
                for (int st = 0; st < 2; ++st) kn[blk][st] = *(const bf16x8*)(kbase + (size_t)(64 * (kb + 8) + 16 * blk) * PP + 32 * st);
        }
        const int g = kb >> 2, e = kb & 3;
#pragma unroll
        for (int blk = 0; blk < 4; ++blk) {
            f32x4v sc;
#pragma unroll
            for (int h = 0; h < 4; ++h) {
                f32x4v acc = {0.f, 0.f, 0.f, 0.f};
                acc = MFMA16(ka[blk][0], qf[h][0], acc); acc = MFMA16(ka[blk][1], qf[h][1], acc);
                const float wh = h == 0 ? w0 : (h == 1 ? w1 : (h == 2 ? w2 : w3));
#pragma unroll
                for (int i = 0; i < 4; ++i) { const float rl = fmaxf(acc[i], 0.f); sc[i] = h == 0 ? wh * rl : fmaf(wh, rl, sc[i]); }
            }
#pragma unroll
            for (int i = 0; i < 4; ++i) *(LAS float*)(rowp + ((g * 64 + 16 * blk + 4 * kg + i) * 4 + e) * 4) = sc[i];
        }
#pragma unroll
        for (int blk = 0; blk < 4; ++blk) { ka[blk][0] = kn[blk][0]; ka[blk][1] = kn[blk][1]; }
    }
}
template <int CTRL> DI int dpp_mov0(int x) { return __builtin_amdgcn_update_dpp(0, x, CTRL, 0xF, 0xF, false); }
DI int wave_incl_scan(int v, int lane) {
    const int rl = lane & 15;
    int t;
    t = v + dpp_mov0<0x111>(v); if (rl >= 1) v = t;
    t = v + dpp_mov0<0x112>(v); if (rl >= 2) v = t;
    t = v + dpp_mov0<0x114>(v); if (rl >= 4) v = t;
    t = v + dpp_mov0<0x118>(v); if (rl >= 8) v = t;
    t = v + dpp_mov0<0x142>(v); if ((lane & 31) >= 16) v = t;
    t = v + dpp_mov0<0x143>(v); if (lane >= 32) v = t;
    return v;
}
template <int CTRL> DI float dpp_movf(float x) { return __int_as_float(__builtin_amdgcn_update_dpp(0, __float_as_int(x), CTRL, 0xF, 0xF, false)); }
DI float wave_max_nonneg(float v, int lane) {
    v = fmaxf(v, dpp_movf<0x111>(v)); v = fmaxf(v, dpp_movf<0x112>(v)); v = fmaxf(v, dpp_movf<0x114>(v)); v = fmaxf(v, dpp_movf<0x118>(v));
    v = fmaxf(v, dpp_movf<0x142>(v)); v = fmaxf(v, dpp_movf<0x143>(v));
    return __int_as_float(__builtin_amdgcn_readlane(__float_as_int(v), 63));
}
DI void dsa_select2(const int t0q, const int KB, LAS unsigned* hist, LAS u32x4* keysA, LAS u32x4* keysB, LAS u64* mrowA, LAS u64* mrowB, int lane) {
    const int G4 = (KB + 3) >> 2;
    LAS u32x4* keys[2] = {keysA, keysB};
    LAS u64* mrow[2] = {mrowA, mrowB};
    float mxa[2] = {0.f, 0.f};
    for (int g = 0; g < G4; ++g) {
#pragma unroll
        for (int q = 0; q < 2; ++q) {
            const u32x4 kk = keys[q][g * 64 + lane];
#pragma unroll
            for (int e = 0; e < 4; ++e) { const int i = 4 * g + e; if (64 * i + lane <= t0q + q) mxa[q] = fmaxf(mxa[q], fabsf(__uint_as_float(kk[e]))); }
        }
    }
    mxa[0] = wave_max_nonneg(mxa[0], lane); mxa[1] = wave_max_nonneg(mxa[1], lane);
    float scl[2];
#pragma unroll
    for (int q = 0; q < 2; ++q) scl[q] = mxa[q] > 0.f ? 8388606.0f / mxa[q] : 0.f;
    for (int g = 0; g < G4; ++g) {
#pragma unroll
        for (int q = 0; q < 2; ++q) {
            u32x4 kk = keys[q][g * 64 + lane];
#pragma unroll
            for (int e = 0; e < 4; ++e) {
                const int i = 4 * g + e;
                const unsigned k = (unsigned)(__float2int_rn((__uint_as_float(kk[e]) + 0.0f) * scl[q]) + 8388608);
                kk[e] = (64 * i + lane <= t0q + q) ? k : 0u;
            }
            keys[q][g * 64 + lane] = kk;
        }
    }
    LDS_WAIT();
    unsigned prefix[2] = {0u, 0u}; int rem[2] = {256, 256};
#pragma unroll 1
    for (int pass = 0; pass < 3; ++pass) {
        const int shift = 16 - 8 * pass;
        { u32x4 z = {0u, 0u, 0u, 0u}; *(LAS u32x4*)(hist + 4 * lane) = z; *(LAS u32x4*)(hist + 320 + 4 * lane) = z; }
        LDS_WAIT();
#pragma unroll 2
        for (int g = 0; g < G4; ++g) {
#pragma unroll
            for (int q = 0; q < 2; ++q) {
                const u32x4 kk = keys[q][g * 64 + lane];
#pragma unroll
                for (int e = 0; e < 4; ++e) {
                    const unsigned k = kk[e];
                    const bool match = k != 0u && (k >> (shift + 8)) == prefix[q];
                    LAS unsigned* dst = hist + 320 * q + (match ? ((k >> shift) & 255u) : 256u + lane);
                    __hip_atomic_fetch_add(dst, 1u, __ATOMIC_RELAXED, __HIP_MEMORY_SCOPE_WORKGROUP);
                }
            }
        }
        LDS_WAIT();
        u32x4 cc[2];
#pragma unroll
        for (int q = 0; q < 2; ++q) cc[q] = *(LAS u32x4*)(hist + 320 * q + 4 * lane);
        LDS_WAIT();
#pragma unroll
        for (int q = 0; q < 2; ++q) {
            const int tot = (int)(cc[q].x + cc[q].y + cc[q].z + cc[q].w);
            const int pre = wave_incl_scan(tot, lane);
            const int total = __builtin_amdgcn_readlane(pre, 63);
            const int suf = total - pre + tot;
            const u64 bal = __ballot(suf >= rem[q]);
            const int L = __popcll(bal) - 1;
            int cum = suf - tot, dsel;
            if (cum + (int)cc[q].w >= rem[q]) dsel = 3;
            else { cum += (int)cc[q].w;
                if (cum + (int)cc[q].z >= rem[q]) dsel = 2;
                else { cum += (int)cc[q].z;
                    if (cum + (int)cc[q].y >= rem[q]) dsel = 1;
                    else { cum += (int)cc[q].y; dsel = 0; } } }
            const int dig = __builtin_amdgcn_readlane(4 * lane + dsel, L);
            rem[q] -= __builtin_amdgcn_readlane(cum, L);
            prefix[q] = (prefix[q] << 8) | (unsigned)dig;
        }
    }
    int running[2] = {0, 0};
    const u64 below = (1ull << lane) - 1ull;
    for (int g = 0; g < G4; ++g) {
#pragma unroll
        for (int q = 0; q < 2; ++q) {
            const u32x4 kk = keys[q][g * 64 + lane];
#pragma unroll
            for (int e = 0; e < 4; ++e) {
                const unsigned k = kk[e];
                const bool eq = k == prefix[q];
                const u64 beq = __ballot(eq);
                const bool sl = k > prefix[q] || (eq && running[q] + __popcll(beq & below) < rem[q]);
                running[q] += __popcll(beq);
                const u64 bm = __ballot(sl);
                if (lane == 0 && 4 * g + e < KB) mrow[q][4 * g + e] = bm;
            }
        }
    }
}
DI void dsa_unit(Frame& F, int b, int qb32) {
    const int tid = launder(F.tid), lane = tid & 63, r32 = lane & 31, hi = lane >> 5, wid = F.wave;
    const int t0 = 32 * qb32, KB = (qb32 >> 1) + 1;
    const LaneAddr la = lane_addr(lane);
    LAS u64* MB = (LAS u64*)(F.lds + DSA_MB); LAS unsigned* HIST = (LAS unsigned*)(F.lds + DSA_HIST) + wid * 640;
    const bf16* P0 = WSP(bf16, WS_P);
    SEC_BEGIN(4);
    if (t0 + 31 < 256) {
        for (int qq = 0; qq < 4; ++qq) { const int qi = wid * 4 + qq, t = t0 + qi;
            for (int i = 0; i < KB; ++i) { const u64 bm = __ballot(64 * i + lane <= t); if (lane == 0) MB[qi * 33 + i] = bm; } }
    } else {
#pragma unroll 1
        for (int rnd = 0; rnd < 2; ++rnd) {
            { SEC_BEGIN(6); dsa_scores16(F, P0, (size_t)b * T + t0 + 16 * rnd, KB, lane, wid); LDS_WAIT(); SEC_END(6); }
            __syncthreads();
            SEC_BEGIN(7);
            {
                const int ql = 2 * wid, qi = 16 * rnd + ql;
                dsa_select2(t0 + qi, KB, HIST, (LAS u32x4*)(F.lds + ql * DSA_ROW), (LAS u32x4*)(F.lds + (ql + 1) * DSA_ROW), MB + qi * 33, MB + (qi + 1) * 33, lane);
            }
            LDS_WAIT(); SEC_END(7);
            __syncthreads();
        }
    }
    __syncthreads();
    SEC_END(4);
    SEC_BEGIN(5);
    const size_t rowg = (size_t)b * T + t0 + r32;
    bf16x8 qr[4];
#pragma unroll
    for (int st = 0; st < 4; ++st) qr[st] = *(const bf16x8*)(WSP(bf16, WS_P) + rowg * PP + (HB_QD + wid) * 64 + 16 * st + 8 * hi);
    f32x16 o[2];
#pragma unroll
    for (int i = 0; i < 16; ++i) { o[0][i] = 0.f; o[1][i] = 0.f; }
    float m_run = 0.f, l_run = 0.f;
    const bf16* Pb = WSP(bf16, WS_P) + (size_t)b * T * PP;
    const unsigned tmask = KB >= 32 ? ~0u : ((1u << KB) - 1u);
    DsaMask mf{MB + r32 * 33};
    run_tiles(F, tmask, Pb + HB_KD * 64, Pb + HB_VD * 64, qr, o, m_run, l_run, mf, la, tid);
    const float l = pl32_sum(l_run);
    const float sc = l > 0.f ? 1.0f / l : 0.f;
    bf16* orow = WSP(bf16, WS_XN) + rowg * D + 512 + wid * 64 + 4 * hi;
#pragma unroll
    for (int db = 0; db < 2; ++db)
#pragma unroll
        for (int u = 0; u < 4; ++u) { u32x2 w; w.x = pk2(o[db][4 * u] * sc, o[db][4 * u + 1] * sc); w.y = pk2(o[db][4 * u + 2] * sc, o[db][4 * u + 3] * sc); *(u32x2*)(orow + 32 * db + 8 * u) = w; }
    SEC_END(5);
}
DI void phase_a1(Frame& F) {
    unsigned* ctr = WSP(unsigned, WS_CTL) + 64;
    for (;;) {
        const int it = q_next(F, ctr);
        if (it >= 256 + 2048) break;
        if (it < 256) compress_item(F, it);
        else { const int u = it - 256; dsa_unit(F, u & 31, 63 - (u >> 5)); }
    }
}
DI void phase_a2(Frame& F) {
    unsigned* ctr = WSP(unsigned, WS_CTL) + 128;
    for (;;) {
        const int it = q_next(F, ctr);
        if (it >= 2048) break;
        nsa_unit(F, (it & 63) >> 1, it & 1, 31 - (it >> 6));
    }
}

#define XB_TMO      128
#define XB_XCNT(j)  (256  + 64 * (j))
#define XB_XSUB(j)  (1280 + 64 * (j))
#define XB_XGEN(j)  (2304 + 64 * (j))
#define XB_TOP      3328
#define XB_TOPGEN   3392
#define XCD_BAR_WORDS 3456
#define XB_SPIN_CAP (1u << 18)

__device__ __forceinline__ unsigned xb_ld(unsigned* p)              { return __hip_atomic_load(p, __ATOMIC_RELAXED, __HIP_MEMORY_SCOPE_AGENT); }
__device__ __forceinline__ unsigned xb_add(unsigned* p, unsigned v) { return __hip_atomic_fetch_add(p, v, __ATOMIC_RELAXED, __HIP_MEMORY_SCOPE_AGENT); }
__device__ __forceinline__ unsigned xb_xcc_id() { return (unsigned)__builtin_amdgcn_s_getreg((3 << 11) | 20) & 0xFu; }
#define XB_SPIN(cond, bar) do { unsigned _sp = 0; while (cond) { __builtin_amdgcn_s_sleep(1); \
    if ((++_sp & 255u) == 0u) { if (xb_ld(&(bar)[XB_TMO])) break; if (_sp > XB_SPIN_CAP) { atomicAdd(&(bar)[XB_TMO], 1u); break; } } } } while (0)

struct XcdBarrier {
    unsigned* bar; unsigned x;
    volatile LAS unsigned* st;
};

__device__ __forceinline__ XcdBarrier xcd_barrier_post(unsigned* bar, volatile LAS unsigned* st) {
    XcdBarrier b; b.bar = bar; b.x = xb_xcc_id(); b.st = st;
    if (threadIdx.x == 0) (void)xb_add(&bar[XB_XCNT(b.x)], 1u);
    return b;
}
__device__ __forceinline__ void xcd_barrier_complete(unsigned* bar, unsigned x, unsigned& nloc, unsigned& nx) {
    const unsigned G = gridDim.x * gridDim.y * gridDim.z;
    unsigned sum, cnt, mine, sp = 0u;
    for (;;) {
        sum = 0u; cnt = 0u; mine = 0u;
#pragma unroll
        for (unsigned j = 0; j < 16; ++j) { const unsigned c = xb_ld(&bar[XB_XCNT(j)]); sum += c; cnt += (c > 0u) ? 1u : 0u; mine = (j == x) ? c : mine; }
        if (sum == G) break;
        __builtin_amdgcn_s_sleep(1);
        if ((++sp & 255u) == 0u) { if (xb_ld(&bar[XB_TMO])) break; if (sp > XB_SPIN_CAP) { atomicAdd(&bar[XB_TMO], 1u); break; } }
    }
    nloc = mine > 0u ? mine : 1u; nx = cnt > 0u ? cnt : 1u;
}

__device__ __forceinline__ void xcd_barrier(const XcdBarrier& b) {
    asm volatile("s_waitcnt vmcnt(0)" ::: "memory");
    __syncthreads();
    if (threadIdx.x == 0) {
        unsigned* bar = b.bar;
        __builtin_amdgcn_s_waitcnt(0);
        unsigned nloc = b.st[0], nx = b.st[1];
        if (nloc == 0u) { xcd_barrier_complete(bar, b.x, nloc, nx); b.st[0] = nloc; b.st[1] = nx; }
        const unsigned old = xb_add(&bar[XB_XSUB(b.x)], 1u);
        const unsigned gen = old / nloc;
        if (old + 1u == (gen + 1u) * nloc) {
            __builtin_amdgcn_fence(__ATOMIC_RELEASE, "agent");
            asm volatile("s_waitcnt vmcnt(0)" ::: "memory");
            const unsigned og = xb_add(&bar[XB_TOP], 1u);
            const unsigned tg = og / nx;
            if (og + 1u == (tg + 1u) * nx) xb_add(&bar[XB_TOPGEN], 1u);
            else XB_SPIN(xb_ld(&bar[XB_TOPGEN]) == tg, bar);
            __builtin_amdgcn_fence(__ATOMIC_ACQUIRE, "agent");
            xb_add(&bar[XB_XGEN(b.x)], 1u);
            asm volatile("s_waitcnt vmcnt(0)" ::: "memory");
        } else {
            XB_SPIN(xb_ld(&bar[XB_XGEN(b.x)]) == gen, bar);
            __builtin_amdgcn_fence(__ATOMIC_ACQUIRE, "agent");
            asm volatile("s_waitcnt vmcnt(0)" ::: "memory");
        }
    }
    __syncthreads();
}


constexpr int CW_BAR = 4096;
constexpr int N_PHASES = 10;
#ifndef PHASE_MASK
#define PHASE_MASK 0x3FF
#endif
#ifndef PROBE_LO
#define PROBE_LO -1
#endif
#ifndef PROBE_HI
#define PROBE_HI -1
#endif
#ifndef MK_COOP
#define MK_COOP 1
#endif

__global__ void __launch_bounds__(NTHR, 2) mega_fwd(Args args) {
    extern __shared__ __attribute__((aligned(16))) unsigned char lds_raw[];
    Frame F;
    F.lds = (LAS unsigned char*)lds_raw;
    F.MISC = (volatile LAS unsigned*)(F.lds + MISC_OFF);
    F.tid = threadIdx.x; F.lane = F.tid & 63; F.wave = __builtin_amdgcn_readfirstlane(F.tid >> 6);
    F.G = gridDim.x; F.bid = blockIdx.x; F.pacc = 0ull;
    if (F.tid < 32) F.MISC[F.tid] = 0u;
    __syncthreads();
    F.ws = args.ws;
    const Args& A = args;
    bf16* OPROJ = WSP(bf16, WS_P); bf16* Y = WSP(bf16, WS_P);

    const int lo = args.ph_lo, hi = args.ph_hi;
    XcdBarrier xbar; xbar.bar = WSP(unsigned, WS_CTL) + CW_BAR; xbar.x = 0; xbar.st = nullptr;
    if (args.coop) xbar = xcd_barrier_post(WSP(unsigned, WS_CTL) + CW_BAR, F.MISC + 8);
#define IN(k) (lo <= (k) && (k) < hi)
    unsigned long long pr_a = 0ull, pr_b = 0ull;
#define SEAM(k) do { if (IN(k) && IN((k) + 1)) { if (args.coop) { if ((k) == 0) cg::this_grid().sync(); else xcd_barrier(xbar); } } \
        if (PROBE_LO == (k) + 1) pr_a = __builtin_amdgcn_s_memrealtime(); if (PROBE_HI == (k)) pr_b = __builtin_amdgcn_s_memrealtime(); } while (0)
    if (PROBE_LO == 0) pr_a = __builtin_amdgcn_s_memrealtime();

    if (((PHASE_MASK >> 0) & 1) && IN(0)) { phase_p0(F, A); }
    SEAM(0);
    if (((PHASE_MASK >> 1) & 1) && IN(1)) { phase_e0(F, A); }
    SEAM(1);
    if (((PHASE_MASK >> 2) & 1) && IN(2)) {
        pg8::Gemm g{WSP(bf16, WS_XN), WSP(bf16, WS_WIN), M, NPROJ, D}; pg8::StaticOrder S; S.init(M, NPROJ, F.G, F.bid);
        pg8::EpiProj E{WSP(bf16, WS_P), WSP(float, WS_MISC), WSP(float, WS_CS)};
        pg8::gemm_phase<pg8::EpiProj, pg8::StaticOrder, true, true>(F.lds, g, S, E);
    }
    SEAM(2);
    if (((PHASE_MASK >> 3) & 1) && IN(3)) { phase_a1(F); }
    SEAM(3);
    if (((PHASE_MASK >> 4) & 1) && IN(4)) { phase_a2(F); }
    SEAM(4);
    if (((PHASE_MASK >> 5) & 1) && IN(5)) {
        pg8::Gemm g{WSP(bf16, WS_XN), WSP(bf16, WS_WOUT), M, D, D}; pg8::StaticOrder S; S.init(M, D, F.G, F.bid);
        pg8::EpiStore<0> E{OPROJ, D};
        pg8::gemm_phase<pg8::EpiStore<0>, pg8::StaticOrder, true, true>(F.lds, g, S, E);
    }
    SEAM(5);
    if (((PHASE_MASK >> 6) & 1) && IN(6)) { phase_e1(F, A, OPROJ); }
    SEAM(6);
    if (((PHASE_MASK >> 7) & 1) && IN(7)) {
        pg8::Gemm g{WSP(bf16, WS_XN), WSP(bf16, WS_WUP), M, FF, D}; pg8::StaticOrder S; S.init(M, FF, F.G, F.bid);
        pg8::EpiStore<1> E{WSP(bf16, WS_SC), FF};
        pg8::gemm_phase<pg8::EpiStore<1>, pg8::StaticOrder, true, true>(F.lds, g, S, E);
    }
    SEAM(7);
    if (((PHASE_MASK >> 8) & 1) && IN(8)) {
        pg8::Gemm g{WSP(bf16, WS_SC), WSP(bf16, WS_WDOWN), M, D, FF}; pg8::StaticOrder S; S.init(M, D, F.G, F.bid);
        pg8::EpiStore<0> E{Y, D};
        pg8::gemm_phase<pg8::EpiStore<0>, pg8::StaticOrder, true, true>(F.lds, g, S, E);
    }
    SEAM(8);
    if (((PHASE_MASK >> 9) & 1) && IN(9)) { phase_e2(F, A, Y); }
    if (PROBE_HI == 9) { __syncthreads(); pr_b = __builtin_amdgcn_s_memrealtime(); }
    if ((PROBE_LO >= 0 || PROBE_SEC > 0) && F.bid == 0 && F.tid == 0) {
        const unsigned long long t0 = __builtin_amdgcn_s_memrealtime(), span = PROBE_SEC > 0 ? F.pacc : pr_b - pr_a;
        while (__builtin_amdgcn_s_memrealtime() - t0 < span) __builtin_amdgcn_s_sleep(32);
    }
#undef IN
#undef SEAM
}

extern "C" void kernel_launch(void* const* d_in, const int* in_sizes, int n_in, void* d_out, int out_size, void* d_ws, size_t ws_size, hipStream_t stream) {
    static int grid = 0;
    if (grid == 0) {
        if (n_in != 19 || in_sizes[0] != M * D || out_size != M * D || ws_size < WS_END) {
            fprintf(stderr, "kernel_launch: unexpected shapes: n_in %d in0 %d out %d ws %zu (need %zu)\n", n_in, n_in > 0 ? in_sizes[0] : -1, out_size, ws_size, (size_t)WS_END); grid = -1; return; }
        int dev = 0, cus = 0, per_cu = 0;
        if (hipGetDevice(&dev) != hipSuccess || hipDeviceGetAttribute(&cus, hipDeviceAttributeMultiprocessorCount, dev) != hipSuccess) { fprintf(stderr, "kernel_launch: device query failed\n"); grid = -1; return; }
        if (hipFuncSetAttribute((const void*)mega_fwd, hipFuncAttributeMaxDynamicSharedMemorySize, LDS_BYTES) != hipSuccess) { fprintf(stderr, "kernel_launch: hipFuncSetAttribute failed\n"); grid = -1; return; }
        if (hipOccupancyMaxActiveBlocksPerMultiprocessor(&per_cu, (const void*)mega_fwd, NTHR, LDS_BYTES) != hipSuccess || per_cu < 1) { fprintf(stderr, "kernel_launch: occupancy query says %d\n", per_cu); per_cu = 1; }
        (void)hipGetLastError();
        grid = cus;
        fprintf(stderr, "kernel_launch: cus %d per_cu %d grid %d\n", cus, per_cu, grid);
    }
    if (grid < 0) return;
    if (hipMemsetAsync((char*)d_ws + WS_CTL, 0, CTL_ZERO_BYTES, stream) != hipSuccess) { fprintf(stderr, "kernel_launch: memset failed\n"); return; }
    Args a{};
    for (int i = 0; i < 19; ++i) a.in[i] = d_in[i];
    a.out = (float*)d_out; a.ws = (unsigned char*)d_ws;
#if MK_COOP
    a.ph_lo = 0; a.ph_hi = N_PHASES; a.coop = 1;
    void* kargs[] = {&a};
    hipError_t e = hipLaunchCooperativeKernel((const void*)mega_fwd, dim3(grid), dim3(NTHR), kargs, LDS_BYTES, stream);
    if (e != hipSuccess) fprintf(stderr, "kernel_launch: cooperative launch failed: %s (grid %d)\n", hipGetErrorString(e), grid);
#else
    for (int ph = 0; ph < N_PHASES; ++ph) {
        a.ph_lo = ph; a.ph_hi = ph + 1; a.coop = 0;
        hipLaunchKernelGGL(mega_fwd, dim3(grid), dim3(NTHR), LDS_BYTES, stream, a);
        const hipError_t le = hipPeekAtLastError();
        if (le != hipSuccess) { fprintf(stderr, "kernel_launch: launch %d failed: %s\n", ph, hipGetErrorName(le)); break; }
    }
#endif
}
```

```cpp
#include <hip/hip_runtime.h>
#include <hip/hip_cooperative_groups.h>
#include <cstdio>
#include <cstdint>
namespace cg = cooperative_groups;
#define DI __device__ __forceinline__
namespace pg8 {
#define PG8_LAS __attribute__((address_space(3)))
typedef unsigned short bf16_t;
typedef short bf16x8 __attribute__((ext_vector_type(8)));
typedef float f32x4 __attribute__((ext_vector_type(4)));
typedef unsigned u32x4 __attribute__((ext_vector_type(4)));
constexpr int BM = 256, BK = 64, HALF = 128, HTB = HALF * BK * 2  , STAGE_BYTES = 8 * HTB, NXCD = 8, WGM = 8;

__host__ __device__ __forceinline__ int lds_byte(int r, int c) { const int st = (r >> 4) * 2 + (c >> 5), rr = r & 15, cc = c & 31, ob = rr * 64 + cc * 2; return st * 1024 + (ob ^ (((ob >> 9) & 1) << 5)); }
__host__ __device__ __forceinline__ void stage_rc(int b, int& R, int& C) { const int st = b / 1024, sb = b % 1024, swz = sb ^ (((sb >> 9) & 1) << 5); R = (st >> 1) * 16 + swz / 64; C = (st & 1) * 32 + (swz % 64) / 2; }
__host__ __device__ __forceinline__ int perm32(int rho) { const int n = rho >> 4, i = rho & 15; return 8 * (i >> 2) + 4 * n + (i & 3); }

struct Unit { int pm, pn; };
struct Gemm { const bf16_t* A; const bf16_t* Bt; int M, N, K; };

struct StaticOrder {
    int nM, nN, nwg, G, c;
    __host__ __device__ void init(int M, int N, int G_, int c_) { nM = M / BM; nN = N / BM; nwg = nM * nN; G = G_; c = c_; }
    __host__ __device__ bool next(int i, Unit& u) const {
        const long L = (long)i * G + c; if (L >= nwg) return false;
        int wgid = (int)L; { const int q = nwg / NXCD, r = nwg % NXCD, xcd = wgid % NXCD, off = wgid / NXCD; wgid = (xcd < r ? xcd * (q + 1) : r * (q + 1) + (xcd - r) * q) + off; }
        const int nig = WGM * nN, gid = wgid / nig, fm = gid * WGM, gsz = (nM - fm) < WGM ? (nM - fm) : WGM;
        u.pm = fm + ((wgid % nig) % gsz); u.pn = (wgid % nig) / gsz; return true;
    }
    __device__ __forceinline__ void a_ready(const Unit&) const {}
    __device__ __forceinline__ void done(const Unit&) const {}
};


typedef float f32x2 __attribute__((ext_vector_type(2)));
typedef unsigned u32x2 __attribute__((ext_vector_type(2)));
typedef __bf16 bf16x2_t __attribute__((ext_vector_type(2)));
__device__ __forceinline__ unsigned cvt_pk_bf16(float lo, float hi) { f32x2 v = {lo, hi}; bf16x2_t b = __builtin_convertvector(v, bf16x2_t); return __builtin_bit_cast(unsigned, b); }

template <int ACT  > struct EpiStore {
    static constexpr bool PERM = true, AFTER_DRAIN = false;
    bf16_t* O; int ldc;
    __device__ __forceinline__ void operator()(const f32x4 (&acc)[2][2][4][2], const Unit& u, int wr, int wc, int fr, int fq) const {
        const int row0 = u.pm * BM + wr * 64 + fr; const int col0 = u.pn * BM + wc * 32 + 8 * fq;
#pragma unroll
        for (int ai = 0; ai < 2; ++ai)
#pragma unroll
            for (int m = 0; m < 4; ++m) { bf16_t* rowp = O + (size_t)(row0 + ai * HALF + m * 16) * ldc + col0;
#pragma unroll
                for (int bj = 0; bj < 2; ++bj) { f32x4 v0 = acc[ai][bj][m][0], v1 = acc[ai][bj][m][1];
                    if (ACT == 1) {
#pragma unroll
                        for (int i = 0; i < 4; ++i) { const float a = v0[i] > 0.f ? v0[i] : 0.f, b = v1[i] > 0.f ? v1[i] : 0.f; v0[i] = a * a; v1[i] = b * b; } }
                    u32x4 w; w.x = cvt_pk_bf16(v0[0], v0[1]); w.y = cvt_pk_bf16(v0[2], v0[3]); w.z = cvt_pk_bf16(v1[0], v1[1]); w.w = cvt_pk_bf16(v1[2], v1[3]);
                    *(u32x4*)(rowp + bj * HALF) = w; } }
    }
};

struct EpiStoreF8 {
    static constexpr bool PERM = true, AFTER_DRAIN = false;
    unsigned char* O; int ldc; float scale;
    __device__ __forceinline__ void operator()(const f32x4 (&acc)[2][2][4][2], const Unit& u, int wr, int wc, int fr, int fq) const {
        const int row0 = u.pm * BM + wr * 64 + fr; const int col0 = u.pn * BM + wc * 32 + 8 * fq;
#pragma unroll
        for (int ai = 0; ai < 2; ++ai)
#pragma unroll
            for (int m = 0; m < 4; ++m) { unsigned char* rowp = O + (size_t)(row0 + ai * HALF + m * 16) * ldc + col0;
#pragma unroll
                for (int bj = 0; bj < 2; ++bj) { f32x4 v0 = acc[ai][bj][m][0], v1 = acc[ai][bj][m][1];
#pragma unroll
                    for (int i = 0; i < 4; ++i) { const float a = v0[i] > 0.f ? v0[i] : 0.f, b = v1[i] > 0.f ? v1[i] : 0.f; v0[i] = fminf(a * a * scale, 448.f); v1[i] = fminf(b * b * scale, 448.f); }
                    u32x2 w;
                    w.x = (unsigned)__builtin_amdgcn_cvt_pk_fp8_f32(v0[0], v0[1], 0, false); w.x = (unsigned)__builtin_amdgcn_cvt_pk_fp8_f32(v0[2], v0[3], (int)w.x, true);
                    w.y = (unsigned)__builtin_amdgcn_cvt_pk_fp8_f32(v1[0], v1[1], 0, false); w.y = (unsigned)__builtin_amdgcn_cvt_pk_fp8_f32(v1[2], v1[3], (int)w.y, true);
                    *(u32x2*)(rowp + bj * HALF) = w; } }
    }
};
struct EpiStoreScaled {
    static constexpr bool PERM = true, AFTER_DRAIN = false;
    bf16_t* O; int ldc; float scale;
    __device__ __forceinline__ void operator()(const f32x4 (&acc)[2][2][4][2], const Unit& u, int wr, int wc, int fr, int fq) const {
        const int row0 = u.pm * BM + wr * 64 + fr; const int col0 = u.pn * BM + wc * 32 + 8 * fq;
#pragma unroll
        for (int ai = 0; ai < 2; ++ai)
#pragma unroll
            for (int m = 0; m < 4; ++m) { bf16_t* rowp = O + (size_t)(row0 + ai * HALF + m * 16) * ldc + col0;
#pragma unroll
                for (int bj = 0; bj < 2; ++bj) { const f32x4 v0 = acc[ai][bj][m][0] * scale, v1 = acc[ai][bj][m][1] * scale;
                    u32x4 w; w.x = cvt_pk_bf16(v0[0], v0[1]); w.y = cvt_pk_bf16(v0[2], v0[3]); w.z = cvt_pk_bf16(v1[0], v1[1]); w.w = cvt_pk_bf16(v1[2], v1[3]);
                    *(u32x4*)(rowp + bj * HALF) = w; } }
    }
};

struct EpiProj {
    static constexpr bool PERM = true, AFTER_DRAIN = false;
    bf16_t* P; float* MISC; const float* CS;
    __device__ __forceinline__ void operator()(const f32x4 (&acc)[2][2][4][2], const Unit& u, int wr, int wc, int fr, int fq) const {
        const int row0 = u.pm * BM + wr * 64 + fr; const int qd = 4 * (wc & 1) + fq;
        constexpr unsigned long long ROPE_MASK = 0x00000007DFF333FFull;
        constexpr float QSCALE = 0.125f * 1.4426950408889634f;
#pragma unroll
        for (int ai = 0; ai < 2; ++ai)
#pragma unroll
            for (int m = 0; m < 4; ++m) {
                const int row = row0 + ai * HALF + m * 16;
                const f32x4 c01 = *(const f32x4*)(CS + (size_t)row * 64 + 8 * qd), c23 = *(const f32x4*)(CS + (size_t)row * 64 + 8 * qd + 4);
                const float cs[4] = {c01[0], c01[2], c23[0], c23[2]}, sn[4] = {c01[1], c01[3], c23[1], c23[3]};
#pragma unroll
                for (int bj = 0; bj < 2; ++bj) {
                    const int hb = u.pn * 4 + bj * 2 + (wc >> 1);
                    const f32x4 v0 = acc[ai][bj][m][0], v1 = acc[ai][bj][m][1];
                    if (hb == 35) {
                        if (qd < 4) { *(f32x4*)(MISC + (size_t)row * 32 + 8 * qd) = v0; *(f32x4*)(MISC + (size_t)row * 32 + 8 * qd + 4) = v1; }
                    } else if ((ROPE_MASK >> hb) & 1ull) {
                        const float sc = (hb < 8 || (hb >= 20 && hb < 28)) ? QSCALE : 1.0f;
                        float o1[4], o2[4];
#pragma unroll
                        for (int i = 0; i < 4; ++i) { o1[i] = (v0[i] * cs[i] - v1[i] * sn[i]) * sc; o2[i] = (v1[i] * cs[i] + v0[i] * sn[i]) * sc; }
                        bf16_t* rp = P + (size_t)row * 2304 + hb * 64 + 4 * qd;
                        u32x2 a, b; a.x = cvt_pk_bf16(o1[0], o1[1]); a.y = cvt_pk_bf16(o1[2], o1[3]); b.x = cvt_pk_bf16(o2[0], o2[1]); b.y = cvt_pk_bf16(o2[2], o2[3]);
                        *(u32x2*)rp = a; *(u32x2*)(rp + 32) = b;
                    } else {
                        u32x4 w; w.x = cvt_pk_bf16(v0[0], v0[1]); w.y = cvt_pk_bf16(v0[2], v0[3]); w.z = cvt_pk_bf16(v1[0], v1[1]); w.w = cvt_pk_bf16(v1[2], v1[3]);
                        *(u32x4*)(P + (size_t)row * 2304 + hb * 64 + 8 * qd) = w;
                    }
                }
            }
    }
};
template <class Epi, class Sched, bool ALIGN_EPI = false, bool SP2 = false>
__device__ __forceinline__ void gemm_phase(PG8_LAS unsigned char* lds, const Gemm g, const Sched& S, const Epi& E) {
    const int tid = threadIdx.x, wid = __builtin_amdgcn_readfirstlane(tid >> 6), lane = tid & 63, wr = wid >> 2, wc = wid & 3, fr = lane & 15, fq = lane >> 4;
    const int K = g.K, nt = K / BK;
    unsigned voffA[2], voffB[2];
#pragma unroll
    for (int i = 0; i < 2; ++i) { int R, C; stage_rc(tid * 16 + i * 8192, R, C); const int Rb = Epi::PERM ? ((R & ~31) + perm32(R & 31)) : R;
        voffA[i] = (unsigned)(R * K + C) * 2u; voffB[i] = (unsigned)(Rb * K + C) * 2u; }
    const size_t kstep = (size_t)(BK * 2);
    const size_t hstep = (size_t)HALF * K * 2;
    const size_t tstep = 2 * hstep;
    const unsigned ldsw = (unsigned)wid * 1024u;
    const int aoff = lds_byte(wr * 64 + fr, fq * 8), boff = lds_byte(wc * 32 + fr, fq * 8);
#define PG8_SA(b, h) (((b) * 2 + (h)) * HTB)
#define PG8_SB(b, h) ((4 + (b) * 2 + (h)) * HTB)
#define PG8_STAGE(bufoff, gbase, voff) do { _Pragma("unroll") for (int _i = 0; _i < 2; ++_i) \
        __builtin_amdgcn_global_load_lds((const unsigned*)((const char*)(gbase) + (voff)[_i]), (PG8_LAS unsigned*)(lds + (bufoff) + ldsw + _i * 8192), 16, 0, 0); } while (0)
#define PG8_LDA(dst, b, h) do { _Pragma("unroll") for (int m = 0; m < 4; ++m) _Pragma("unroll") for (int k = 0; k < 2; ++k) dst[m][k] = *(const PG8_LAS bf16x8*)(lds + PG8_SA(b, h) + aoff + m * 2048 + k * 1024); } while (0)
#define PG8_LDB(dst, b, h) do { _Pragma("unroll") for (int n = 0; n < 2; ++n) _Pragma("unroll") for (int k = 0; k < 2; ++k) dst[n][k] = *(const PG8_LAS bf16x8*)(lds + PG8_SB(b, h) + boff + n * 2048 + k * 1024); } while (0)
#define PG8_MMA(ai, bj, At, Bt) do { __builtin_amdgcn_s_setprio(1); _Pragma("unroll") for (int m = 0; m < 4; ++m) _Pragma("unroll") for (int n = 0; n < 2; ++n) _Pragma("unroll") for (int k = 0; k < 2; ++k) \
        acc[ai][bj][m][n] = __builtin_amdgcn_mfma_f32_16x16x32_bf16(Bt[n][k], At[m][k], acc[ai][bj][m][n], 0, 0, 0); __builtin_amdgcn_s_setprio(0); } while (0)
#define PG8_WAIT_V(n) asm volatile("s_waitcnt vmcnt(" #n ")" ::: "memory")
#define PG8_WAIT_L(n) asm volatile("s_waitcnt lgkmcnt(" #n ")" ::: "memory")
#define PG8_BAR __builtin_amdgcn_s_barrier()
#define PG8_SCHED __builtin_amdgcn_sched_barrier(0)
    Unit cur, nxt; int ui = 0;
    if (!S.next(0, cur)) return;
    f32x4 acc[2][2][4][2];
#pragma unroll
    for (int a = 0; a < 2; ++a)
#pragma unroll
        for (int b = 0; b < 2; ++b)
#pragma unroll
            for (int m = 0; m < 4; ++m)
#pragma unroll
                for (int n = 0; n < 2; ++n) acc[a][b][m][n] = (f32x4){0.f, 0.f, 0.f, 0.f};
    bf16x8 At[4][2], B0[2][2], B1[2][2];
    const char* cA = (const char*)g.A + (size_t)cur.pm * tstep; const char* cB = (const char*)g.Bt + (size_t)cur.pn * tstep;
    S.a_ready(cur);
    if constexpr (SP2) {
        PG8_STAGE(PG8_SB(0, 0), cB, voffB); PG8_STAGE(PG8_SB(0, 1), cB + hstep, voffB); PG8_STAGE(PG8_SA(0, 0), cA, voffA); PG8_STAGE(PG8_SA(0, 1), cA + hstep, voffA);
        if (wr == 1) PG8_BAR;
        PG8_WAIT_V(2); PG8_BAR;
        PG8_STAGE(PG8_SB(1, 0), cB + kstep, voffB); PG8_STAGE(PG8_SA(1, 0), cA + kstep, voffA); PG8_STAGE(PG8_SB(1, 1), cB + hstep + kstep, voffB);
        PG8_WAIT_V(6); PG8_BAR;
    } else {
        PG8_STAGE(PG8_SB(0, 0), cB, voffB); PG8_STAGE(PG8_SA(0, 0), cA, voffA); PG8_STAGE(PG8_SB(0, 1), cB + hstep, voffB); PG8_STAGE(PG8_SA(0, 1), cA + hstep, voffA);
        if (wr == 1) PG8_BAR;
        PG8_WAIT_V(4); PG8_BAR;
        PG8_STAGE(PG8_SB(1, 0), cB + kstep, voffB); PG8_STAGE(PG8_SA(1, 0), cA + kstep, voffA); PG8_STAGE(PG8_SB(1, 1), cB + hstep + kstep, voffB);
        PG8_WAIT_V(6); PG8_BAR;
    }
    for (;;) {
        const bool has_next = S.next(ui + 1, nxt);
        const char* nA = has_next ? (const char*)g.A + (size_t)nxt.pm * tstep : cA; const char* nB = has_next ? (const char*)g.Bt + (size_t)nxt.pn * tstep : cB;
        for (int t = 0; t < nt; t += 2) {
            const bool last = (t == nt - 2);
            const char* a1 = cA + (size_t)(t + 1) * kstep;
            const char* a2 = last ? nA : cA + (size_t)(t + 2) * kstep; const char* b2 = last ? nB : cB + (size_t)(t + 2) * kstep;
            const char* a3 = a2 + kstep; const char* b3 = b2 + kstep;
            if (last && has_next) S.a_ready(nxt);
            if constexpr (SP2) {
            PG8_LDB(B0, 0, 0); PG8_LDB(B1, 0, 1); PG8_SCHED; PG8_LDA(At, 0, 0); PG8_STAGE(PG8_SA(1, 1), a1 + hstep, voffA);
            PG8_WAIT_V(8); PG8_WAIT_L(0); PG8_BAR; PG8_MMA(0, 0, At, B0); PG8_MMA(0, 1, At, B1); PG8_BAR; PG8_SCHED;
            PG8_LDA(At, 0, 1); PG8_STAGE(PG8_SB(0, 0), b2, voffB); PG8_STAGE(PG8_SB(0, 1), b2 + hstep, voffB); PG8_STAGE(PG8_SA(0, 0), a2, voffA);
            PG8_WAIT_V(8); PG8_WAIT_L(0); PG8_BAR; PG8_MMA(1, 0, At, B0); PG8_MMA(1, 1, At, B1); PG8_BAR; PG8_SCHED;
            PG8_LDB(B0, 1, 0); PG8_LDB(B1, 1, 1); PG8_SCHED; PG8_LDA(At, 1, 0); PG8_STAGE(PG8_SA(0, 1), a2 + hstep, voffA);
            PG8_WAIT_V(8); PG8_WAIT_L(0); PG8_BAR; PG8_MMA(0, 0, At, B0); PG8_MMA(0, 1, At, B1); PG8_BAR; PG8_SCHED;
            PG8_LDA(At, 1, 1); PG8_STAGE(PG8_SB(1, 0), b3, voffB); PG8_STAGE(PG8_SB(1, 1), b3 + hstep, voffB); PG8_STAGE(PG8_SA(1, 0), a3, voffA);
            PG8_WAIT_V(8); PG8_WAIT_L(0); PG8_BAR; PG8_MMA(1, 0, At, B0); PG8_MMA(1, 1, At, B1); PG8_BAR; PG8_SCHED;
            } else {
            PG8_LDB(B0, 0, 0); PG8_SCHED; PG8_LDA(At, 0, 0); PG8_STAGE(PG8_SA(1, 1), a1 + hstep, voffA);
            PG8_WAIT_L(8); PG8_BAR; PG8_WAIT_L(0); PG8_MMA(0, 0, At, B0); PG8_BAR; PG8_SCHED;
            PG8_LDB(B1, 0, 1); PG8_STAGE(PG8_SB(0, 0), b2, voffB);
            PG8_BAR; PG8_WAIT_L(0); PG8_MMA(0, 1, At, B1); PG8_BAR;
            PG8_LDA(At, 0, 1); PG8_STAGE(PG8_SA(0, 0), a2, voffA);
            PG8_BAR; PG8_WAIT_L(0); PG8_MMA(1, 0, At, B0); PG8_BAR; PG8_SCHED;
            PG8_STAGE(PG8_SB(0, 1), b2 + hstep, voffB);
            PG8_WAIT_V(6); PG8_BAR; PG8_MMA(1, 1, At, B1); PG8_BAR;
            PG8_LDB(B0, 1, 0); PG8_SCHED; PG8_LDA(At, 1, 0); PG8_STAGE(PG8_SA(0, 1), a2 + hstep, voffA);
            PG8_WAIT_L(8); PG8_BAR; PG8_WAIT_L(0); PG8_MMA(0, 0, At, B0); PG8_BAR; PG8_SCHED;
            PG8_LDB(B1, 1, 1); PG8_STAGE(PG8_SB(1, 0), b3, voffB);
            PG8_BAR; PG8_WAIT_L(0); PG8_MMA(0, 1, At, B1); PG8_BAR;
            PG8_LDA(At, 1, 1); PG8_STAGE(PG8_SA(1, 0), a3, voffA);
            PG8_BAR; PG8_WAIT_L(0); PG8_MMA(1, 0, At, B0); PG8_BAR; PG8_SCHED;
            PG8_STAGE(PG8_SB(1, 1), b3 + hstep, voffB);
            PG8_WAIT_V(6); PG8_BAR; PG8_MMA(1, 1, At, B1); PG8_BAR;
            }
        }
        if constexpr (ALIGN_EPI) { if (wr == 0) PG8_BAR; }
        if constexpr (!Epi::AFTER_DRAIN) { E(acc, cur, wr, wc, fr, fq); S.done(cur); }
        if (!has_next) break;
#pragma unroll
        for (int a = 0; a < 2; ++a)
#pragma unroll
            for (int b = 0; b < 2; ++b)
#pragma unroll
                for (int m = 0; m < 4; ++m)
#pragma unroll
                    for (int n = 0; n < 2; ++n) acc[a][b][m][n] = (f32x4){0.f, 0.f, 0.f, 0.f};
        cur = nxt; cA = nA; cB = nB; ++ui;
        if constexpr (ALIGN_EPI) { if (wr == 1) PG8_BAR; }
    }
    PG8_WAIT_V(0);
    if constexpr (!ALIGN_EPI) { if (wr == 0) PG8_BAR; }
    PG8_BAR;
    if constexpr (Epi::AFTER_DRAIN) { E.fused(acc, cur, wr, wc, fr, fq, lds, wid, lane); S.done(cur); }
#undef PG8_SA
#undef PG8_SB
#undef PG8_STAGE
#undef PG8_LDA
#undef PG8_LDB
#undef PG8_MMA
#undef PG8_WAIT_V
#undef PG8_WAIT_L
#undef PG8_BAR
#undef PG8_SCHED
}
typedef int i32x8 __attribute__((ext_vector_type(8)));
template <class Epi, class Sched, bool ALIGN_EPI = false, bool SP2 = false>
__device__ __forceinline__ void gemm_phase_f8(PG8_LAS unsigned char* lds, const Gemm g, const Sched& S, const Epi& E) {
    const int tid = threadIdx.x, wid = __builtin_amdgcn_readfirstlane(tid >> 6), lane = tid & 63, wr = wid >> 2, wc = wid & 3, fr = lane & 15, fq = lane >> 4;
    const int K = g.K, nt = K / BK;
    unsigned voffA[2], voffB[2];
#pragma unroll
    for (int i = 0; i < 2; ++i) { int R, C; stage_rc(tid * 16 + i * 8192, R, C); const int Rb = Epi::PERM ? ((R & ~31) + perm32(R & 31)) : R;
        voffA[i] = (unsigned)(R * K + C) * 2u; voffB[i] = (unsigned)(Rb * K + C) * 2u; }
    const size_t kstep = (size_t)(BK * 2);
    const size_t hstep = (size_t)HALF * K * 2;
    const size_t tstep = 2 * hstep;
    const unsigned ldsw = (unsigned)wid * 1024u;
    const int aoff = lds_byte(wr * 64 + fr, fq * 16), boff = lds_byte(wc * 32 + fr, fq * 16);
#define PG8_SA(b, h) (((b) * 2 + (h)) * HTB)
#define PG8_SB(b, h) ((4 + (b) * 2 + (h)) * HTB)
#define PG8_STAGE(bufoff, gbase, voff) do { _Pragma("unroll") for (int _i = 0; _i < 2; ++_i) \
        __builtin_amdgcn_global_load_lds((const unsigned*)((const char*)(gbase) + (voff)[_i]), (PG8_LAS unsigned*)(lds + (bufoff) + ldsw + _i * 8192), 16, 0, 0); } while (0)
#define PG8_LDA(dst, b, h) do { _Pragma("unroll") for (int m = 0; m < 4; ++m) dst[m] = *(const PG8_LAS i32x8*)(lds + PG8_SA(b, h) + aoff + m * 2048); } while (0)
#define PG8_LDB(dst, b, h) do { _Pragma("unroll") for (int n = 0; n < 2; ++n) dst[n] = *(const PG8_LAS i32x8*)(lds + PG8_SB(b, h) + boff + n * 2048); } while (0)
#define PG8_MMA(ai, bj, At, Bt) do { __builtin_amdgcn_s_setprio(1); _Pragma("unroll") for (int m = 0; m < 4; ++m) _Pragma("unroll") for (int n = 0; n < 2; ++n) \
        asm volatile("v_mfma_scale_f32_16x16x128_f8f6f4 %0, %1, %2, %0, %3, %3 op_sel_hi:[0,0,0]" : "+v"(acc[ai][bj][m][n]) : "v"(Bt[n]), "v"(At[m]), "v"(f8scale)); __builtin_amdgcn_s_setprio(0); } while (0)
#define PG8_WAIT_V(n) asm volatile("s_waitcnt vmcnt(" #n ")" ::: "memory")
#define PG8_WAIT_L(n) asm volatile("s_waitcnt lgkmcnt(" #n ")" ::: "memory")
#define PG8_BAR __builtin_amdgcn_s_barrier()
#define PG8_SCHED __builtin_amdgcn_sched_barrier(0)
    Unit cur, nxt; int ui = 0;
    if (!S.next(0, cur)) return;
    f32x4 acc[2][2][4][2];
#pragma unroll
    for (int a = 0; a < 2; ++a)
#pragma unroll
        for (int b = 0; b < 2; ++b)
#pragma unroll
            for (int m = 0; m < 4; ++m)
#pragma unroll
                for (int n = 0; n < 2; ++n) acc[a][b][m][n] = (f32x4){0.f, 0.f, 0.f, 0.f};
    i32x8 At[4], B0[2], B1[2];
    const int f8scale = 0x7F7F7F7F;
    const char* cA = (const char*)g.A + (size_t)cur.pm * tstep; const char* cB = (const char*)g.Bt + (size_t)cur.pn * tstep;
    S.a_ready(cur);
    if constexpr (SP2) {
        PG8_STAGE(PG8_SB(0, 0), cB, voffB); PG8_STAGE(PG8_SB(0, 1), cB + hstep, voffB); PG8_STAGE(PG8_SA(0, 0), cA, voffA); PG8_STAGE(PG8_SA(0, 1), cA + hstep, voffA);
        if (wr == 1) PG8_BAR;
        PG8_WAIT_V(2); PG8_BAR;
        PG8_STAGE(PG8_SB(1, 0), cB + kstep, voffB); PG8_STAGE(PG8_SA(1, 0), cA + kstep, voffA); PG8_STAGE(PG8_SB(1, 1), cB + hstep + kstep, voffB);
        PG8_WAIT_V(6); PG8_BAR;
    } else {
        PG8_STAGE(PG8_SB(0, 0), cB, voffB); PG8_STAGE(PG8_SA(0, 0), cA, voffA); PG8_STAGE(PG8_SB(0, 1), cB + hstep, voffB); PG8_STAGE(PG8_SA(0, 1), cA + hstep, voffA);
        if (wr == 1) PG8_BAR;
        PG8_WAIT_V(4); PG8_BAR;
        PG8_STAGE(PG8_SB(1, 0), cB + kstep, voffB); PG8_STAGE(PG8_SA(1, 0), cA + kstep, voffA); PG8_STAGE(PG8_SB(1, 1), cB + hstep + kstep, voffB);
        PG8_WAIT_V(6); PG8_BAR;
    }
    for (;;) {
        const bool has_next = S.next(ui + 1, nxt);
        const char* nA = has_next ? (const char*)g.A + (size_t)nxt.pm * tstep : cA; const char* nB = has_next ? (const char*)g.Bt + (size_t)nxt.pn * tstep : cB;
        for (int t = 0; t < nt; t += 2) {
            const bool last = (t == nt - 2);
            const char* a1 = cA + (size_t)(t + 1) * kstep;
            const char* a2 = last ? nA : cA + (size_t)(t + 2) * kstep; const char* b2 = last ? nB : cB + (size_t)(t + 2) * kstep;
            const char* a3 = a2 + kstep; const char* b3 = b2 + kstep;
            if (last && has_next) S.a_ready(nxt);
            if constexpr (SP2) {
            PG8_LDB(B0, 0, 0); PG8_LDB(B1, 0, 1); PG8_SCHED; PG8_LDA(At, 0, 0); PG8_STAGE(PG8_SA(1, 1), a1 + hstep, voffA);
            PG8_WAIT_V(8); PG8_WAIT_L(0); PG8_BAR; PG8_MMA(0, 0, At, B0); PG8_MMA(0, 1, At, B1); PG8_BAR; PG8_SCHED;
            PG8_LDA(At, 0, 1); PG8_STAGE(PG8_SB(0, 0), b2, voffB); PG8_STAGE(PG8_SB(0, 1), b2 + hstep, voffB); PG8_STAGE(PG8_SA(0, 0), a2, voffA);
            PG8_WAIT_V(8); PG8_WAIT_L(0); PG8_BAR; PG8_MMA(1, 0, At, B0); PG8_MMA(1, 1, At, B1); PG8_BAR; PG8_SCHED;
            PG8_LDB(B0, 1, 0); PG8_LDB(B1, 1, 1); PG8_SCHED; PG8_LDA(At, 1, 0); PG8_STAGE(PG8_SA(0, 1), a2 + hstep, voffA);
            PG8_WAIT_V(8); PG8_WAIT_L(0); PG8_BAR; PG8_MMA(0, 0, At, B0); PG8_MMA(0, 1, At, B1); PG8_BAR; PG8_SCHED;
            PG8_LDA(At, 1, 1); PG8_STAGE(PG8_SB(1, 0), b3, voffB); PG8_STAGE(PG8_SB(1, 1), b3 + hstep, voffB); PG8_STAGE(PG8_SA(1, 0), a3, voffA);
            PG8_WAIT_V(8); PG8_WAIT_L(0); PG8_BAR; PG8_MMA(1, 0, At, B0); PG8_MMA(1, 1, At, B1); PG8_BAR; PG8_SCHED;
            } else {
            PG8_LDB(B0, 0, 0); PG8_SCHED; PG8_LDA(At, 0, 0); PG8_STAGE(PG8_SA(1, 1), a1 + hstep, voffA);
            PG8_WAIT_L(8); PG8_BAR; PG8_WAIT_L(0); PG8_MMA(0, 0, At, B0); PG8_BAR; PG8_SCHED;
            PG8_LDB(B1, 0, 1); PG8_STAGE(PG8_SB(0, 0), b2, voffB);
            PG8_BAR; PG8_WAIT_L(0); PG8_MMA(0, 1, At, B1); PG8_BAR;
            PG8_LDA(At, 0, 1); PG8_STAGE(PG8_SA(0, 0), a2, voffA);
            PG8_BAR; PG8_WAIT_L(0); PG8_MMA(1, 0, At, B0); PG8_BAR; PG8_SCHED;
            PG8_STAGE(PG8_SB(0, 1), b2 + hstep, voffB);
            PG8_WAIT_V(6); PG8_BAR; PG8_MMA(1, 1, At, B1); PG8_BAR;
            PG8_LDB(B0, 1, 0); PG8_SCHED; PG8_LDA(At, 1, 0); PG8_STAGE(PG8_SA(0, 1), a2 + hstep, voffA);
            PG8_WAIT_L(8); PG8_BAR; PG8_WAIT_L(0); PG8_MMA(0, 0, At, B0); PG8_BAR; PG8_SCHED;
            PG8_LDB(B1, 1, 1); PG8_STAGE(PG8_SB(1, 0), b3, voffB);
            PG8_BAR; PG8_WAIT_L(0); PG8_MMA(0, 1, At, B1); PG8_BAR;
            PG8_LDA(At, 1, 1); PG8_STAGE(PG8_SA(1, 0), a3, voffA);
            PG8_BAR; PG8_WAIT_L(0); PG8_MMA(1, 0, At, B0); PG8_BAR; PG8_SCHED;
            PG8_STAGE(PG8_SB(1, 1), b3 + hstep, voffB);
            PG8_WAIT_V(6); PG8_BAR; PG8_MMA(1, 1, At, B1); PG8_BAR;
            }
        }
        asm volatile("s_nop 15\n\ts_nop 15" ::: "memory");
        if constexpr (ALIGN_EPI) { if (wr == 0) PG8_BAR; }
        if constexpr (!Epi::AFTER_DRAIN) { E(acc, cur, wr, wc, fr, fq); S.done(cur); }
        if (!has_next) break;
#pragma unroll
        for (int a = 0; a < 2; ++a)
#pragma unroll
            for (int b = 0; b < 2; ++b)
#pragma unroll
                for (int m = 0; m < 4; ++m)
#pragma unroll
                    for (int n = 0; n < 2; ++n) acc[a][b][m][n] = (f32x4){0.f, 0.f, 0.f, 0.f};
        cur = nxt; cA = nA; cB = nB; ++ui;
        if constexpr (ALIGN_EPI) { if (wr == 1) PG8_BAR; }
    }
    PG8_WAIT_V(0);
    if constexpr (!ALIGN_EPI) { if (wr == 0) PG8_BAR; }
    PG8_BAR;
    if constexpr (Epi::AFTER_DRAIN) { E.fused(acc, cur, wr, wc, fr, fq, lds, wid, lane); S.done(cur); }
#undef PG8_SA
#undef PG8_SB
#undef PG8_STAGE
#undef PG8_LDA
#undef PG8_LDB
#undef PG8_MMA
#undef PG8_WAIT_V
#undef PG8_WAIT_L
#undef PG8_BAR
#undef PG8_SCHED
}

}

constexpr int NB = 32, T = 2048, D = 1024, M = NB * T, FF = 4096, NPROJ = 2304, PP = NPROJ;
constexpr int HB_QN = 0, HB_KC = 8, HB_VC = 10, HB_KSL = 12, HB_VSL = 14, HB_KW = 16, HB_VW = 18, HB_QD = 20, HB_KD = 28, HB_VD = 29, HB_QI = 30, HB_KI = 34, HB_MISC = 35;
constexpr int NWAVES = 8, NTHR = 512;
constexpr float RMS_EPS = 1e-6f;

constexpr size_t MiB = 1u << 20;
constexpr size_t WS_CTL = 0, CTL_ZERO_BYTES = 64 * 1024;
constexpr size_t WS_MOD = 1 * MiB;
constexpr size_t WS_BIASC = 1 * MiB + 800 * 1024;
constexpr size_t WS_CS = 2 * MiB;
constexpr size_t WS_WIN = 18 * MiB;
constexpr size_t WS_WOUT = 23 * MiB;
constexpr size_t WS_WUP = 25 * MiB;
constexpr size_t WS_WDOWN = 33 * MiB;
constexpr size_t WS_W1K = 41 * MiB, WS_W1V = 41 * MiB + 512 * 1024;
constexpr size_t WS_W2K = 42 * MiB, WS_W2V = 42 * MiB + 64 * 1024;
constexpr size_t WS_KCMP = 43 * MiB, WS_VCMP = 44 * MiB;
constexpr size_t WS_MISC = 45 * MiB;
constexpr size_t WS_X2B = 192 * MiB + 128 * MiB;
constexpr size_t WS_XN = 64 * MiB;
constexpr size_t WS_P = 192 * MiB;
constexpr size_t WS_SC = 480 * MiB;
constexpr size_t WS_END = 992 * MiB;
constexpr int SC_TILES_PER_B = 528;

constexpr int RING_BYTES = 131072;
constexpr int MISC_OFF = RING_BYTES + 320;
constexpr int LDS_BYTES = 161792;

#define LAS __attribute__((address_space(3)))
typedef unsigned short bf16;
typedef short bf16x8 __attribute__((ext_vector_type(8)));
typedef short s16x4 __attribute__((ext_vector_type(4)));
typedef float f32x2 __attribute__((ext_vector_type(2)));
typedef float f32x4 __attribute__((ext_vector_type(4)));
typedef float f32x16 __attribute__((ext_vector_type(16)));
typedef unsigned u32x4 __attribute__((ext_vector_type(4)));
typedef unsigned u32x2 __attribute__((ext_vector_type(2)));
typedef unsigned long long u64;
#define MFMA32(a, b, c) __builtin_amdgcn_mfma_f32_32x32x16_bf16((a), (b), (c), 0, 0, 0)
#define LDS_WAIT() asm volatile("s_waitcnt lgkmcnt(0)" ::: "memory")

DI unsigned pk2(float lo, float hi) { return pg8::cvt_pk_bf16(lo, hi); }
DI float bf2f(unsigned short v) { return __uint_as_float((unsigned)v << 16); }
DI int crow(int r, int hi) { return (r & 3) + 8 * (r >> 2) + 4 * hi; }
DI float wave_sum(float v) {
#pragma unroll
    for (int o = 1; o < 64; o <<= 1) v += __shfl_xor(v, o);
    return v;
}
DI int launder(int x) { asm volatile("" : "+v"(x)); return x; }
DI float fast_exp2(float x) { return __builtin_amdgcn_exp2f(x); }
DI float gelu_tanh(float x) {
    const float u = 0.7978845608028654f * (x + 0.044715f * x * x * x);
    const float e = __expf(2.0f * u);
    const float th = 1.0f - 2.0f / (e + 1.0f);
    return 0.5f * x * (1.0f + th);
}

struct Frame {
    LAS unsigned char* lds;
    volatile LAS unsigned* MISC;
    unsigned char* ws;
    int tid, lane, wave, G, bid;
    unsigned long long pacc;
};
#ifndef PROBE_SEC
#define PROBE_SEC 0
#endif
#define SEC_BEGIN(k) unsigned long long _ps##k = 0; if (PROBE_SEC == (k)) _ps##k = __builtin_amdgcn_s_memrealtime()
#define SEC_END(k) do { if (PROBE_SEC == (k)) F.pacc += __builtin_amdgcn_s_memrealtime() - _ps##k; } while (0)
struct Args { const void* in[19]; float* out; unsigned char* ws; int ph_lo, ph_hi, coop, pad; };
#define WSP(type, off) ((type*)(F.ws + (off)))
#define INP(type, i) ((const type*)A.in[i])

DI unsigned xcc_id() { return (unsigned)__builtin_amdgcn_s_getreg((3 << 11) | 20) & 7u; }
DI int q_next(Frame& F, unsigned* ctr, int per_queue) {
    __syncthreads();
    if (F.tid == 0) {
        const unsigned own = xcc_id();
        int res = -1;
        for (unsigned k = 0; k < 8; ++k) {
            const unsigned q = (own + k) & 7u;
            if (k > 0 && __hip_atomic_load(ctr + 64 * q, __ATOMIC_RELAXED, __HIP_MEMORY_SCOPE_AGENT) >= (unsigned)per_queue) continue;
            const unsigned it = __hip_atomic_fetch_add(ctr + 64 * q, 1u, __ATOMIC_RELAXED, __HIP_MEMORY_SCOPE_AGENT);
            if (it < (unsigned)per_queue) { res = (int)(q * 65536u + it); break; }
        }
        F.MISC[0] = (unsigned)res;
    }
    __syncthreads();
    return (int)F.MISC[0];
}

DI int proj_src_col(int n) {
    const int hb = n >> 6, p = n & 63;
    if (hb == 35) return p < 24 ? 1280 + p : (p < 28 ? 2264 + (p - 24) : -1);
    const int base = hb < 20 ? 64 * hb : 1304 + 64 * (hb - 20);
    constexpr u64 ROPE_MASK = 0x00000007DFF333FFull;
    int d = p;
    if ((ROPE_MASK >> hb) & 1ull) { const int q = p >> 3, i = p & 7; d = i < 4 ? 4 * q + i : 32 + 4 * q + (i - 4); }
    return base + d;
}
template <bool PERMUTE> DI void transpose_item(const float* W, int ldw, int K, int N, bf16* WT, LAS float* scr, int item, int lane) {
    const int nblk = N / 32, kb = item / nblk, nb = item % nblk, k0 = 64 * kb, n0 = 32 * nb;
    const int ncol = n0 + (lane & 31); const int src = PERMUTE ? proj_src_col(ncol) : ncol;
    float tv[32];
    const int srcc = src >= 0 ? src : 0;
#pragma unroll
    for (int i = 0; i < 32; ++i) { const int kk = 2 * i + (lane >> 5); tv[i] = W[(size_t)(k0 + kk) * ldw + srcc]; }
#pragma unroll
    for (int i = 0; i < 32; ++i) { const int kk = 2 * i + (lane >> 5); scr[kk * 33 + (lane & 31)] = src >= 0 ? tv[i] : 0.f; }
    LDS_WAIT();
    const int cch = lane & 7;
#pragma unroll
    for (int j = 0; j < 4; ++j) { const int n = (lane >> 3) + 8 * j; const LAS float* s = scr + (8 * cch) * 33 + n;
        u32x4 o; o.x = pk2(s[0 * 33], s[1 * 33]); o.y = pk2(s[2 * 33], s[3 * 33]); o.z = pk2(s[4 * 33], s[5 * 33]); o.w = pk2(s[6 * 33], s[7 * 33]);
        *(u32x4*)(WT + (size_t)(n0 + n) * K + k0 + 8 * cch) = o; }
    LDS_WAIT();
}
DI void transpose_item_f8(const float* W, int ldw, int K, int N, unsigned char* WT, LAS float* scr, int item, int lane, float scale) {
    const int nblk = N / 32, kb = item / nblk, nb = item % nblk, k0 = 64 * kb, n0 = 32 * nb;
    const int ncol = n0 + (lane & 31);
    float tv[32];
#pragma unroll
    for (int i = 0; i < 32; ++i) { const int kk = 2 * i + (lane >> 5); tv[i] = W[(size_t)(k0 + kk) * ldw + ncol]; }
#pragma unroll
    for (int i = 0; i < 32; ++i) { const int kk = 2 * i + (lane >> 5); scr[kk * 33 + (lane & 31)] = fminf(fmaxf(tv[i] * scale, -448.f), 448.f); }
    LDS_WAIT();
    const int cch = lane & 7;
#pragma unroll
    for (int j = 0; j < 4; ++j) { const int n = (lane >> 3) + 8 * j; const LAS float* sp = scr + (8 * cch) * 33 + n;
        u32x2 o;
        o.x = (unsigned)__builtin_amdgcn_cvt_pk_fp8_f32(sp[0 * 33], sp[1 * 33], 0, false); o.x = (unsigned)__builtin_amdgcn_cvt_pk_fp8_f32(sp[2 * 33], sp[3 * 33], (int)o.x, true);
        o.y = (unsigned)__builtin_amdgcn_cvt_pk_fp8_f32(sp[4 * 33], sp[5 * 33], 0, false); o.y = (unsigned)__builtin_amdgcn_cvt_pk_fp8_f32(sp[6 * 33], sp[7 * 33], (int)o.y, true);
        *(u32x2*)(WT + (size_t)(n0 + n) * K + k0 + 8 * cch) = o; }
    LDS_WAIT();
}
DI void phase_p0(Frame& F, const Args& A) {
    const int gt = F.bid * NTHR + F.tid, NGT = F.G * NTHR;
    for (int it = F.bid; it < (6 * D) / 32; it += F.G) {
        LAS float* cl = (LAS float*)(F.lds + F.wave * 16384);
        const int k0 = 128 * F.wave;
#pragma unroll 8
        for (int e = F.lane; e < 128 * 32; e += 64) { const int kk = e & 127, bb = e >> 7; cl[kk * 32 + bb] = INP(float, 1)[bb * D + k0 + kk]; }
        LDS_WAIT();
        const int n = F.lane & 31, bh = F.lane >> 5;
        const float* wp = INP(float, 3) + (size_t)k0 * (6 * D) + it * 32 + n;
        float acc[16];
#pragma unroll
        for (int i = 0; i < 16; ++i) acc[i] = 0.f;
#pragma unroll 1
        for (int kc = 0; kc < 128; kc += 32) {
          float wv[32];
#pragma unroll
          for (int u = 0; u < 32; ++u) wv[u] = wp[(size_t)(kc + u) * (6 * D)];
#pragma unroll
          for (int u = 0; u < 32; ++u) {
            const int kk = kc + u; const float w = wv[u];
            const LAS f32x4* cr = (const LAS f32x4*)(cl + kk * 32 + 16 * bh);
            const f32x4 c0 = cr[0], c1 = cr[1], c2 = cr[2], c3 = cr[3];
#pragma unroll
            for (int i = 0; i < 4; ++i) { acc[i] = fmaf(c0[i], w, acc[i]); acc[4 + i] = fmaf(c1[i], w, acc[4 + i]); acc[8 + i] = fmaf(c2[i], w, acc[8 + i]); acc[12 + i] = fmaf(c3[i], w, acc[12 + i]); }
          }
        }
        __syncthreads();
        LAS float* pr = (LAS float*)F.lds + F.wave * 1024;
#pragma unroll
        for (int i = 0; i < 16; ++i) pr[(16 * bh + i) * 32 + n] = acc[i];
        __syncthreads();
        for (int e = F.tid; e < 1024; e += NTHR) {
            const LAS float* q = (const LAS float*)F.lds + e;
            const float sum = ((q[0] + q[1024]) + (q[2048] + q[3072])) + ((q[4096] + q[5120]) + (q[6144] + q[7168]));
            const int bb = e >> 5, nn = e & 31;
            WSP(float, WS_MOD)[(size_t)bb * (6 * D) + it * 32 + nn] = INP(float, 4)[it * 32 + nn] + sum;
        }
        __syncthreads();
    }
}

DI void prep_weights_rope(Frame& F, const Args& A) {
    LAS float* scr = (LAS float*)(F.lds + F.wave * 16384);
    const int gw = F.bid * NWAVES + F.wave, NGW = F.G * NWAVES;
    constexpr int I_IN = (D / 64) * (NPROJ / 32), I_OUT = (D / 64) * (D / 32), I_UP = (D / 64) * (FF / 32), I_DN = (FF / 64) * (D / 32), I_W1 = (2048 / 64) * (128 / 32), I_W2 = (128 / 64) * (64 / 32);
    constexpr int NITEMS = I_IN + I_OUT + I_UP + I_DN + 2 * I_W1 + 2 * I_W2;
    for (int it = gw; it < NITEMS; it += NGW) {
        int r = it;
        if (r < I_IN) { transpose_item<true>(INP(float, 9), 2268, D, NPROJ, WSP(bf16, WS_WIN), scr, r, F.lane); continue; } r -= I_IN;
        if (r < I_OUT) { transpose_item_f8(INP(float, 16), D, D, D, WSP(unsigned char, WS_WOUT), scr, r, F.lane, 128.0f); continue; } r -= I_OUT;
        if (r < I_UP) { transpose_item_f8(INP(float, 17), FF, D, FF, WSP(unsigned char, WS_WUP), scr, r, F.lane, 128.0f); continue; } r -= I_UP;
        if (r < I_DN) { transpose_item_f8(INP(float, 18), D, FF, D, WSP(unsigned char, WS_WDOWN), scr, r, F.lane, 256.0f); continue; } r -= I_DN;
        if (r < I_W1) { transpose_item<false>(INP(float, 12), 128, 2048, 128, WSP(bf16, WS_W1K), scr, r, F.lane); continue; } r -= I_W1;
        if (r < I_W1) { transpose_item<false>(INP(float, 14), 128, 2048, 128, WSP(bf16, WS_W1V), scr, r, F.lane); continue; } r -= I_W1;
        if (r < I_W2) { transpose_item<false>(INP(float, 13), 64, 128, 64, WSP(bf16, WS_W2K), scr, r, F.lane); continue; } r -= I_W2;
        transpose_item<false>(INP(float, 15), 64, 128, 64, WSP(bf16, WS_W2V), scr, r, F.lane);
    }
    const int gt = F.bid * NTHR + F.tid, NGT = F.G * NTHR;
    for (int idx = gt; idx < M * 32; idx += NGT) {
        const int m = idx >> 5, d = idx & 31;
        const float inv = exp2f(-(float)d * (13.287712379549449f / 32.0f));
        const float ang = (float)INP(int, 2)[m] * inv;
        const float k = rintf(ang * 0.15915494309189535f);
        float r = fmaf(-k, 6.2831854820251465f, ang);
        r = fmaf(-k, -1.7484555e-7f, r);
        const float rev = r * 0.15915494309189535f;
        *(f32x2*)(WSP(float, WS_CS) + 2 * (size_t)idx) = (f32x2){__builtin_amdgcn_cosf(rev), __builtin_amdgcn_sinf(rev)};
    }
}

DI unsigned pk4_f8(f32x4 v) {
    v.x = fminf(fmaxf(v.x, -448.f), 448.f); v.y = fminf(fmaxf(v.y, -448.f), 448.f); v.z = fminf(fmaxf(v.z, -448.f), 448.f); v.w = fminf(fmaxf(v.w, -448.f), 448.f);
    int w = __builtin_amdgcn_cvt_pk_fp8_f32(v.x, v.y, 0, false); w = __builtin_amdgcn_cvt_pk_fp8_f32(v.z, v.w, w, true); return (unsigned)w; }
DI float sumsq4(const f32x4 (&v)[4]) { float s = 0.f;
#pragma unroll
    for (int j = 0; j < 4; ++j) s += (v[j].x * v[j].x + v[j].y * v[j].y) + (v[j].z * v[j].z + v[j].w * v[j].w);
    return s; }
DI void unpack_bf16x4(f32x4& o, u64 w) { o.x = bf2f((unsigned short)w); o.y = bf2f((unsigned short)(w >> 16)); o.z = bf2f((unsigned short)(w >> 32)); o.w = bf2f((unsigned short)(w >> 48)); }
DI void phase_e0(Frame& F, const Args& A) {
    const int gw = F.bid * NWAVES + F.wave, NGW = F.G * NWAVES;
    prep_weights_rope(F, A);
    __syncthreads();
    for (int o = F.bid; o < 256; o += F.G) {
        const int kv = o >> 7, j = o & 127;
        const float* pe = kv ? INP(float, 11) : INP(float, 10); const float* w1 = kv ? INP(float, 14) : INP(float, 12);
        float p = 0.f;
#pragma unroll
        for (int i = 0; i < 4; ++i) { const int k = F.tid + NTHR * i; p = fmaf(pe[k], w1[(size_t)k * 128 + j], p); }
        p = wave_sum(p);
        LAS float* red = (LAS float*)F.lds;
        if (F.lane == 0) red[F.wave] = p;
        __syncthreads();
        if (F.tid == 0) WSP(float, WS_BIASC)[o] = ((red[0] + red[1]) + (red[2] + red[3])) + ((red[4] + red[5]) + (red[6] + red[7]));
        __syncthreads();
    }
    for (int r0 = gw * 32; r0 < M; r0 += NGW * 32) {
        const int b = r0 / T;
        const float* mod = WSP(float, WS_MOD) + (size_t)b * 6 * D;
        f32x4 ga[4], sh[4];
#pragma unroll
        for (int j = 0; j < 4; ++j) { const int col = 4 * F.lane + 256 * j;
            ga[j] = *(const f32x4*)(INP(float, 5) + col) * (*(const f32x4*)(mod + D + col) + 1.0f); sh[j] = *(const f32x4*)(mod + col); }
#pragma unroll 1
        for (int m = r0; m < r0 + 32; m += 4) {
            const f32x4* xa = (const f32x4*)(INP(float, 0) + (size_t)m * D) + F.lane;
            f32x4 v[4][4];
#pragma unroll
            for (int r = 0; r < 4; ++r)
#pragma unroll
                for (int j = 0; j < 4; ++j) v[r][j] = xa[r * (D / 4) + 64 * j];
            u64* oa = (u64*)(WSP(bf16, WS_XN) + (size_t)m * D) + F.lane;
#pragma unroll
            for (int r = 0; r < 4; ++r) {
                const float rs = 1.0f / sqrtf(wave_sum(sumsq4(v[r])) * (1.0f / D) + RMS_EPS);
#pragma unroll
                for (int j = 0; j < 4; ++j) { const f32x4 h = v[r][j] * rs * ga[j] + sh[j]; oa[r * (D / 4) + 64 * j] = (u64)pk2(h.x, h.y) | ((u64)pk2(h.z, h.w) << 32); }
            }
        }
    }
}

DI void phase_e1(Frame& F, const Args& A, const bf16* OPROJ) {
    const int gw = F.bid * NWAVES + F.wave, NGW = F.G * NWAVES;
    for (int r0 = gw * 32; r0 < M; r0 += NGW * 32) {
        const int b = r0 / T;
        const float* mod = WSP(float, WS_MOD) + (size_t)b * 6 * D;
        f32x4 g1[4], g2[4], sh[4];
#pragma unroll
        for (int j = 0; j < 4; ++j) { const int col = 4 * F.lane + 256 * j;
            g1[j] = *(const f32x4*)(INP(float, 6) + col) * *(const f32x4*)(mod + 2 * D + col);
            g2[j] = *(const f32x4*)(INP(float, 7) + col) * (*(const f32x4*)(mod + 4 * D + col) + 1.0f); sh[j] = *(const f32x4*)(mod + 3 * D + col); }
#pragma unroll 1
        for (int m = r0; m < r0 + 32; m += 2) {
            const f32x4* xa = (const f32x4*)(INP(float, 0) + (size_t)m * D) + F.lane; const f32x4* xb = xa + D / 4;
            const u64* pa = (const u64*)(OPROJ + (size_t)m * D) + F.lane; const u64* pb = pa + D / 4;
            f32x4 xva[4], xvb[4], oa[4], ob[4];
#pragma unroll
            for (int j = 0; j < 4; ++j) { xva[j] = xa[64 * j]; xvb[j] = xb[64 * j]; unpack_bf16x4(oa[j], pa[64 * j]); unpack_bf16x4(ob[j], pb[64 * j]); }
            const float ra = 1.0f / sqrtf(wave_sum(sumsq4(oa)) * (1.0f / D) + RMS_EPS), rb = 1.0f / sqrtf(wave_sum(sumsq4(ob)) * (1.0f / D) + RMS_EPS);
            u64* outa = (u64*)(WSP(bf16, WS_X2B) + (size_t)m * D) + F.lane; u64* outb = outa + D / 4;
#pragma unroll
            for (int j = 0; j < 4; ++j) { xva[j] = xva[j] + g1[j] * (oa[j] * ra); xvb[j] = xvb[j] + g1[j] * (ob[j] * rb);
                outa[64 * j] = (u64)pk2(xva[j].x, xva[j].y) | ((u64)pk2(xva[j].z, xva[j].w) << 32); outb[64 * j] = (u64)pk2(xvb[j].x, xvb[j].y) | ((u64)pk2(xvb[j].z, xvb[j].w) << 32); }
            const float sa = 1.0f / sqrtf(wave_sum(sumsq4(xva)) * (1.0f / D) + RMS_EPS), sb = 1.0f / sqrtf(wave_sum(sumsq4(xvb)) * (1.0f / D) + RMS_EPS);
            unsigned* ha8 = (unsigned*)(WSP(unsigned char, WS_XN) + (size_t)m * D) + F.lane; unsigned* hb8 = ha8 + D / 4;
#pragma unroll
            for (int j = 0; j < 4; ++j) {
                const f32x4 ha = xva[j] * sa * g2[j] + sh[j], hb = xvb[j] * sb * g2[j] + sh[j];
                ha8[64 * j] = pk4_f8(ha * 32.0f); hb8[64 * j] = pk4_f8(hb * 32.0f);
            }
        }
    }
}
DI void phase_e2(Frame& F, const Args& A, const bf16* Y) {
    const int gw = F.bid * NWAVES + F.wave, NGW = F.G * NWAVES;
    for (int r0 = gw * 32; r0 < M; r0 += NGW * 32) {
        const int b = r0 / T;
        const float* mod = WSP(float, WS_MOD) + (size_t)b * 6 * D;
        f32x4 g1[4];
#pragma unroll
        for (int j = 0; j < 4; ++j) { const int col = 4 * F.lane + 256 * j; g1[j] = *(const f32x4*)(INP(float, 8) + col) * *(const f32x4*)(mod + 5 * D + col); }
#pragma unroll 1
        for (int m = r0; m < r0 + 32; m += 2) {
            const u64* pa = (const u64*)(Y + (size_t)m * D) + F.lane; const u64* pb = pa + D / 4;
            f32x4* outa = (f32x4*)(A.out + (size_t)m * D) + F.lane; f32x4* outb = outa + D / 4;
            const u64* xa8 = (const u64*)(WSP(bf16, WS_X2B) + (size_t)m * D) + F.lane; const u64* xb8 = xa8 + D / 4;
            f32x4 ya[4], yb[4], xa[4], xb[4];
#pragma unroll
            for (int j = 0; j < 4; ++j) { unpack_bf16x4(ya[j], pa[64 * j]); unpack_bf16x4(yb[j], pb[64 * j]); unpack_bf16x4(xa[j], xa8[64 * j]); unpack_bf16x4(xb[j], xb8[64 * j]); }
            const float ra = 1.0f / sqrtf(wave_sum(sumsq4(ya)) * (1.0f / D) + RMS_EPS), rb = 1.0f / sqrtf(wave_sum(sumsq4(yb)) * (1.0f / D) + RMS_EPS);
#pragma unroll
            for (int j = 0; j < 4; ++j) { outa[64 * j] = xa[j] + g1[j] * (ya[j] * ra); outb[64 * j] = xb[j] + g1[j] * (yb[j] * rb); }
        }
    }
}

constexpr int KT_BYTES = 64 * 128, VT_BYTES = 64 * 128;
DI int kt_off(int row, int chunk) { return row * 128 + ((chunk ^ ((row >> 1) & 7)) << 4); }
DI int vt_off(int row, int colbyte) { return row * 128 + (colbyte ^ (((row >> 1) & 1) << 6)); }
DI void glds16(const void* gsrc, unsigned lds_dst) { unsigned keep;
    asm volatile("s_mov_b32 %0, m0\n\ts_mov_b32 m0, %2\n\ts_nop 0\n\tglobal_load_lds_dwordx4 %1, off\n\ts_mov_b32 m0, %0" : "=&s"(keep) : "v"(gsrc), "s"(lds_dst) : "memory"); }
typedef short v4i16_t __attribute__((ext_vector_type(4)));
DI s16x4 vtr(LAS const unsigned char* p) { return __builtin_bit_cast(s16x4, __builtin_amdgcn_ds_read_tr16_b64_v4i16((LAS v4i16_t*)p)); }
DI bf16x8 pack8(const f32x16& p, const int base) {
    u32x4 w; w.x = pk2(p[base], p[base + 1]); w.y = pk2(p[base + 2], p[base + 3]); w.z = pk2(p[base + 4], p[base + 5]); w.w = pk2(p[base + 6], p[base + 7]);
    return __builtin_bit_cast(bf16x8, w);
}
struct LaneAddr { int kb[4], vb0, vb1; };
DI LaneAddr lane_addr(int lane) {
    const int r32 = lane & 31, hi = lane >> 5, a = lane & 15, g1 = (lane >> 4) & 1, swz = (a >> 3) & 1;
    const int common = (4 * hi + (a >> 2)) * 128 + 32 * g1 + 8 * (a & 3);
    LaneAddr la;
#pragma unroll
    for (int st = 0; st < 4; ++st) la.kb[st] = kt_off(r32, 2 * st + hi);
    la.vb0 = common + 64 * swz; la.vb1 = common + 64 * (1 - swz);
    return la;
}
DI f32x16 qk_block(LAS const unsigned char* lds, const int koff, const bf16x8 (&qr)[4], const LaneAddr& la) {
    f32x16 s;
#pragma unroll
    for (int i = 0; i < 16; ++i) s[i] = 0.f;
#pragma unroll
    for (int st = 0; st < 4; ++st) { const bf16x8 a = *(LAS const bf16x8*)(lds + la.kb[st] + koff); s = MFMA32(a, qr[st], s); }
    return s;
}
DI void pv_step(f32x16 (&o)[2], LAS const unsigned char* lds, const int voff, const bf16x8 pw, const LaneAddr& la) {
    { const s16x4 lo = vtr(lds + la.vb0 + voff), hh = vtr(lds + la.vb0 + (voff + 1024));
      const bf16x8 vf = __builtin_shufflevector(lo, hh, 0, 1, 2, 3, 4, 5, 6, 7); o[0] = MFMA32(vf, pw, o[0]); }
    { const s16x4 lo = vtr(lds + la.vb1 + voff), hh = vtr(lds + la.vb1 + (voff + 1024));
      const bf16x8 vf = __builtin_shufflevector(lo, hh, 0, 1, 2, 3, 4, 5, 6, 7); o[1] = MFMA32(vf, pw, o[1]); }
}
DI void mask_block(f32x16& s, unsigned w  ) {
#pragma unroll
    for (int r = 0; r < 16; ++r) { const int sh = (r & 3) + 8 * (r >> 2); if (!((w >> sh) & 1u)) s[r] = -INFINITY; }
}
DI float block_max(const f32x16& s) { float m = s[0];
#pragma unroll
    for (int r = 1; r < 16; ++r) m = fmaxf(m, s[r]);
    return m; }
DI float pl32_max(float m) { auto rr = __builtin_amdgcn_permlane32_swap(__float_as_uint(m), __float_as_uint(m), false, false); return fmaxf(__uint_as_float(rr[0]), __uint_as_float(rr[1])); }
DI float pl32_sum(float m) { auto rr = __builtin_amdgcn_permlane32_swap(__float_as_uint(m), __float_as_uint(m), false, false); return __uint_as_float(rr[0]) + __uint_as_float(rr[1]); }
constexpr float ATT_THR = 8.0f;
#define SBAR() __builtin_amdgcn_sched_barrier(0)
#define PIN(x) asm volatile("" : "+v"(x))
DI void qk_tile(f32x16& p0, f32x16& p1, const bf16x8 (&qr)[4], LAS const unsigned char* kbuf, const float cinit, const LaneAddr& la) {
#pragma unroll
    for (int i = 0; i < 16; ++i) { p0[i] = cinit; p1[i] = cinit; }
#pragma unroll
    for (int st = 0; st < 4; ++st) {
        const bf16x8 a0 = *(LAS const bf16x8*)(kbuf + la.kb[st]), a1 = *(LAS const bf16x8*)(kbuf + la.kb[st] + 4096);
        p0 = MFMA32(a0, qr[st], p0); p1 = MFMA32(a1, qr[st], p1);
    }
}
template <bool PC>
DI void softmax_decide(f32x16& p0, f32x16& p1, float mx, f32x16 (&o)[2], float& m_ref, f32x16& lacc, f32x16& cvec) {
    mx = pl32_max(mx);
    if (__any(mx > ATT_THR)) {
        const float dl = fmaxf(mx, 0.f);
        m_ref += dl;
        const float f = fast_exp2(-dl);
        const float nm = -m_ref;
#pragma unroll
        for (int r = 0; r < 16; ++r) { p0[r] -= dl; p1[r] -= dl; o[0][r] *= f; o[1][r] *= f; lacc[r] *= f; if (PC) cvec[r] = nm; }
    }
}
template <bool MASKED> DI float exp_masked(float x, unsigned w, const int sh) {
    const float e = fast_exp2(x);
    if (!MASKED) return e;
    return __uint_as_float(__float_as_uint(e) & (unsigned)__builtin_amdgcn_sbfe(w, sh, 1));
}
template <bool MASKED>
DI void attn_tail(f32x16& p0, f32x16& p1, LAS const unsigned char* vbuf, f32x16 (&o)[2], f32x16& lacc, const bf16x8 ones, u64 vb, const LaneAddr& la, int hi) {
    const unsigned w0 = (unsigned)vb >> (4 * hi), w1 = (unsigned)(vb >> 32) >> (4 * hi);
#pragma unroll
    for (int r = 0; r < 16; ++r) { const int sh = (r & 3) + 8 * (r >> 2); p0[r] = exp_masked<MASKED>(p0[r], w0, sh); p1[r] = exp_masked<MASKED>(p1[r], w1, sh); }
    { const bf16x8 pw = pack8(p0, 0); pv_step(o, vbuf, 0 * 128, pw, la); lacc = MFMA32(ones, pw, lacc); }
    { const bf16x8 pw = pack8(p0, 8); pv_step(o, vbuf, 16 * 128, pw, la); lacc = MFMA32(ones, pw, lacc); }
    { const bf16x8 pw = pack8(p1, 0); pv_step(o, vbuf, 32 * 128, pw, la); lacc = MFMA32(ones, pw, lacc); }
    { const bf16x8 pw = pack8(p1, 8); pv_step(o, vbuf, 48 * 128, pw, la); lacc = MFMA32(ones, pw, lacc); }
}
template <bool MASKED>
DI void attn_step(const bf16x8 (&qr)[4], LAS const unsigned char* knext, LAS const unsigned char* vbuf, f32x16 (&o)[2], float& m_ref, f32x16& lacc, f32x16& cvec, const bf16x8 ones,
                  f32x16& p0, f32x16& p1, const u64 vb, const float cinit_next, const LaneAddr& la, const int hi) {
    const unsigned w0 = (unsigned)vb >> (4 * hi), w1 = (unsigned)(vb >> 32) >> (4 * hi);
    LAS const unsigned char* v0 = vbuf + la.vb0; LAS const unsigned char* v1 = vbuf + la.vb1;
    bf16x8 kf[2];
    s16x4 vf[2][2];
    unsigned pw[16];
    f32x16 n0, n1;
#define SHF(R) (((R) & 3) + 8 * ((R) >> 2))
#define EXPP(P, W, R) do { float a_ = P[R], b_ = P[(R) + 1]; PIN(a_); PIN(b_); a_ = exp_masked<MASKED>(a_, W, SHF(R)); b_ = exp_masked<MASKED>(b_, W, SHF((R) + 1)); \
        pw[((&P == &p1) ? 8 : 0) + (R) / 2] = pk2(a_, b_); } while (0)
#define KRD(B, ST) do { kf[(ST) & 1] = *(LAS const bf16x8*)(knext + la.kb[ST] + (B) * 4096); } while (0)
#define VRD(M) do { LAS const unsigned char* vp_ = ((M) & 1) ? v1 : v0; vf[(M) & 1][0] = vtr(vp_ + ((M) >> 1) * 2048); vf[(M) & 1][1] = vtr(vp_ + (((M) >> 1) * 2048 + 1024)); } while (0)
#define PVM(M, PW) do { const u32x4 pw_ = {pw[4 * (PW)], pw[4 * (PW) + 1], pw[4 * (PW) + 2], pw[4 * (PW) + 3]}; \
        o[(M) & 1] = MFMA32(__builtin_shufflevector(vf[(M) & 1][0], vf[(M) & 1][1], 0, 1, 2, 3, 4, 5, 6, 7), __builtin_bit_cast(bf16x8, pw_), o[(M) & 1]); } while (0)
#define MX2(N, B) do { mx = fmaxf(fmaxf(mx, N[B]), N[(B) + 1]); } while (0)
#define LSUM(PW) do { const u32x4 pw_ = {pw[4 * (PW)], pw[4 * (PW) + 1], pw[4 * (PW) + 2], pw[4 * (PW) + 3]}; lacc = MFMA32(ones, __builtin_bit_cast(bf16x8, pw_), lacc); } while (0)
    KRD(0, 0); KRD(0, 1);
    if (!MASKED) {
#pragma unroll
        for (int i = 0; i < 16; ++i) cvec[i] = cinit_next;
    }
    EXPP(p0, w0, 0); EXPP(p0, w0, 2); SBAR();
    n0 = MFMA32(kf[0], qr[0], cvec); KRD(0, 2); EXPP(p0, w0, 4); EXPP(p0, w0, 6); SBAR();
    n0 = MFMA32(kf[1], qr[1], n0); KRD(0, 3); EXPP(p0, w0, 8); SBAR();
    n0 = MFMA32(kf[0], qr[2], n0); VRD(0);    EXPP(p0, w0, 10); EXPP(p0, w0, 12); SBAR();
    n0 = MFMA32(kf[1], qr[3], n0); VRD(1);    EXPP(p0, w0, 14); SBAR();
    PVM(0, 0); VRD(2);    EXPP(p1, w1, 0); SBAR();
    PVM(1, 0); VRD(3);    EXPP(p1, w1, 2); SBAR();
    LSUM(0);              SBAR();
    PVM(2, 1); KRD(1, 0); EXPP(p1, w1, 4); SBAR();
    PVM(3, 1); KRD(1, 1); EXPP(p1, w1, 6); SBAR();
    LSUM(1);              SBAR();
    float mx = n0[0];
    n1 = MFMA32(kf[0], qr[0], cvec); KRD(1, 2); EXPP(p1, w1, 8);  MX2(n0, 0); MX2(n0, 2);   PIN(mx); SBAR();
    n1 = MFMA32(kf[1], qr[1], n1); KRD(1, 3); EXPP(p1, w1, 10); MX2(n0, 4); MX2(n0, 6);   PIN(mx); SBAR();
    n1 = MFMA32(kf[0], qr[2], n1); VRD(4);    EXPP(p1, w1, 12); MX2(n0, 8); MX2(n0, 10);  PIN(mx); SBAR();
    n1 = MFMA32(kf[1], qr[3], n1); VRD(5);    EXPP(p1, w1, 14); MX2(n0, 12); MX2(n0, 14); PIN(mx); SBAR();
    PVM(4, 2); VRD(6); MX2(n1, 0); MX2(n1, 2);   PIN(mx); SBAR();
    PVM(5, 2); VRD(7); MX2(n1, 4); MX2(n1, 6);   PIN(mx); SBAR();
    LSUM(2);           SBAR();
    PVM(6, 3); MX2(n1, 8); MX2(n1, 10);  PIN(mx); SBAR();
    PVM(7, 3); MX2(n1, 12); MX2(n1, 14); PIN(mx); SBAR();
    LSUM(3);
#undef SHF
#undef EXPP
#undef KRD
#undef VRD
#undef PVM
#undef MX2
#undef LSUM
    softmax_decide<MASKED>(n0, n1, mx, o, m_ref, lacc, cvec);
    p0 = n0; p1 = n1;
}
DI u64 causal_bits(int ql) { return ql >= 63 ? ~0ull : ((1ull << (ql + 1)) - 1ull); }

DI void compress_item(Frame& F, int item) {
    const int kv = item & 1, half = (item >> 1) & 1, g = (item >> 2) & 1, b = item >> 3;
    const int lane = launder(F.lane), r32 = lane & 31, hi = lane >> 5, wid = F.wave;
    const bf16* Pb = WSP(bf16, WS_P) + (size_t)b * T * PP + ((kv ? HB_VC : HB_KC) + g) * 64;
    const bf16* W1 = kv ? WSP(bf16, WS_W1V) : WSP(bf16, WS_W1K); const bf16* W2 = kv ? WSP(bf16, WS_W2V) : WSP(bf16, WS_W2K);
    const float* bias = WSP(float, WS_BIASC) + kv * 128;
    bf16* OUT = (kv ? WSP(bf16, WS_VCMP) : WSP(bf16, WS_KCMP)) + (size_t)((b * 2 + g) * 128) * 64;
    LAS unsigned char* H1 = F.lds;
    {
        const int mh = wid & 1, nq = wid >> 1;
        const int n = 64 * half + 32 * mh + r32, nc = n < 126 ? n : 126;
        const bf16* arow = Pb + (size_t)(16 * nc) * PP + hi * 8;
        const bf16* brow = W1 + (size_t)(32 * nq + r32) * 2048 + hi * 8;
        f32x16 acc;
#pragma unroll
        for (int i = 0; i < 16; ++i) acc[i] = 0.f;
#pragma unroll 2
        for (int l = 0; l < 32; ++l) {
#pragma unroll
            for (int ss = 0; ss < 4; ++ss) {
                const bf16x8 a = *(const bf16x8*)(arow + (size_t)l * PP + ss * 16);
                const bf16x8 bb = *(const bf16x8*)(brow + (4 * l + ss) * 16);
                acc = MFMA32(a, bb, acc);
            }
        }
        const float bj = bias[32 * nq + r32];
#pragma unroll
        for (int r = 0; r < 16; ++r) {
            const float h = gelu_tanh(acc[r] + bj);
            *(LAS unsigned short*)(H1 + (32 * mh + crow(r, hi)) * 272 + (32 * nq + r32) * 2) = (unsigned short)(pk2(h, 0.f) & 0xffffu);
        }
    }
    __syncthreads();
    if (wid < 4) {
        const int mh = wid & 1, dh = wid >> 1;
        f32x16 acc;
#pragma unroll
        for (int i = 0; i < 16; ++i) acc[i] = 0.f;
        LAS const unsigned char* ar = H1 + (32 * mh + r32) * 272 + hi * 16;
        const bf16* br = W2 + (size_t)(32 * dh + r32) * 128 + hi * 8;
#pragma unroll
        for (int st = 0; st < 8; ++st) {
            const bf16x8 a = *(LAS const bf16x8*)(ar + st * 32);
            const bf16x8 bb = *(const bf16x8*)(br + st * 16);
            acc = MFMA32(a, bb, acc);
        }
#pragma unroll
        for (int r = 0; r < 16; ++r) OUT[(size_t)(64 * half + 32 * mh + crow(r, hi)) * 64 + 32 * dh + r32] = (bf16)(pk2(acc[r], 0.f) & 0xffffu);
    }
    __syncthreads();
}


constexpr int KR_OFF = 0, VR_OFF = 3 * KT_BYTES, TILE_BUFS = 3 * KT_BYTES + 3 * VT_BYTES;
#define WAIT_VM_BAR(N) asm volatile("s_waitcnt vmcnt(" #N ") lgkmcnt(0)\n\ts_barrier" ::: "memory")
DI void wait_vm_bar(int c) { if (c >= 2) WAIT_VM_BAR(2); else if (c == 1) WAIT_VM_BAR(1); else WAIT_VM_BAR(0); }
template <bool ALWAYS_MASKED, class MaskF>
DI void run_tiles(Frame& F, unsigned tmask, const bf16* Kg0, const bf16* Vg0,
                  const bf16x8 (&qr)[4], f32x16 (&o)[2], float& m_ref, float& l_run, const MaskF mf, const LaneAddr& la, const int tid) {
    if (tmask == 0u) return;
    const int hi = (tid >> 5) & 1, lane = tid & 63, wid = F.wave;
    const int drow = 8 * wid + (lane >> 3), dch = lane & 7;
    const bf16* ksrc = Kg0 + (size_t)drow * PP + ((dch ^ ((drow >> 1) & 7)) << 3);
    const bf16* vsrc = Vg0 + (size_t)drow * PP + ((dch ^ (((drow >> 1) & 1) << 2)) << 3);
    const unsigned lds0 = (unsigned)(size_t)F.lds + (unsigned)wid * 1024u;
#define POP(J) do { J = -1; if (tmask) { J = __builtin_ctz(tmask); tmask &= tmask - 1u; } } while (0)
#define DMA_K(J, ST) glds16(ksrc + (size_t)(64 * (J)) * PP, (unsigned)__builtin_amdgcn_readfirstlane(lds0 + KR_OFF + (ST) * KT_BYTES))
#define DMA_V(J, ST) glds16(vsrc + (size_t)(64 * (J)) * PP, (unsigned)__builtin_amdgcn_readfirstlane(lds0 + VR_OFF + (ST) * VT_BYTES))
    int tA, tB, tC, tD;
    POP(tA); POP(tB); POP(tC);
    WAIT_VM_BAR(0);
    DMA_K(tA, 0); DMA_V(tA, 0);
    if (tB >= 0) { DMA_K(tB, 1); DMA_V(tB, 1); }
    if (tC >= 0) DMA_K(tC, 2);
    WAIT_VM_BAR(0);
    u64 vb = mf(tA);
    bool rl = !ALWAYS_MASKED && __all(vb == 0ull || vb == ~0ull);
    f32x16 p0, p1, lacc, cvec;
    const u32x4 ones_ = {0x3F803F80u, 0x3F803F80u, 0x3F803F80u, 0x3F803F80u};
    const bf16x8 ones = __builtin_bit_cast(bf16x8, ones_);
#pragma unroll
    for (int i = 0; i < 16; ++i) { lacc[i] = 0.f; cvec[i] = -m_ref; }
    qk_tile(p0, p1, qr, F.lds + KR_OFF, (rl && vb == 0ull) ? -INFINITY : -m_ref, la);
    softmax_decide<ALWAYS_MASKED>(p0, p1, fmaxf(block_max(p0), block_max(p1)), o, m_ref, lacc, cvec);
    int s0 = 0, s1 = 1, s2 = 2;
    int cprev = 0;
    for (;;) {
        SEC_BEGIN(11);
        SEC_BEGIN(16);
        wait_vm_bar(cprev);
        SEC_END(16);
        SEC_BEGIN(17);
        POP(tD);
        int c = 0;
        if (tD >= 0) { DMA_K(tD, s0); ++c; }
        if (tC >= 0) { DMA_V(tC, s2); ++c; }
        cprev = c;
        SEC_END(17);
        LAS const unsigned char* vcur = F.lds + VR_OFF + s0 * VT_BYTES;
        SEC_END(11);
        if (tB < 0) {
            if (rl) attn_tail<false>(p0, p1, vcur, o, lacc, ones, vb, la, hi); else attn_tail<true>(p0, p1, vcur, o, lacc, ones, vb, la, hi);
            break;
        }
        SEC_BEGIN(12);
        const u64 vbn = mf(tB);
        const bool rln = !ALWAYS_MASKED && __all(vbn == 0ull || vbn == ~0ull);
        const float cn = (rln && vbn == 0ull) ? -INFINITY : -m_ref;
        LAS const unsigned char* knext = F.lds + KR_OFF + s1 * KT_BYTES;
        if (ALWAYS_MASKED) attn_step<true>(qr, knext, vcur, o, m_ref, lacc, cvec, ones, p0, p1, vb, cn, la, hi);
        else if (rl) attn_step<false>(qr, knext, vcur, o, m_ref, lacc, cvec, ones, p0, p1, vb, cn, la, hi);
        else {
            attn_tail<true>(p0, p1, vcur, o, lacc, ones, vb, la, hi);
            qk_tile(p0, p1, qr, knext, cn, la);
            softmax_decide<false>(p0, p1, fmaxf(block_max(p0), block_max(p1)), o, m_ref, lacc, cvec);
        }
        vb = vbn; rl = rln;
        SEC_END(12);
        tA = tB; tB = tC; tC = tD;
        { const int t = s0; s0 = s1; s1 = s2; s2 = t; }
    }
    asm volatile("s_waitcnt vmcnt(0)" ::: "memory");
    l_run = lacc[0];
#undef POP
#undef DMA_K
#undef DMA_V
}
struct SlcMask { unsigned sel; int tb, ql; DI u64 operator()(int j) const { return ((sel >> j) & 1u) ? (j == tb ? causal_bits(ql) : ~0ull) : 0ull; } };
struct WinMask { int tb, ql; DI u64 operator()(int j) const { return j == tb ? causal_bits(ql) : (j == tb - 8 ? ~causal_bits(ql) : ~0ull); } };
struct DsaMask { LAS const u64* row; DI u64 operator()(int j) const { return row[j]; } };

constexpr int NSA_KC = TILE_BUFS, NSA_VC = NSA_KC + 128 * 128, NSA_IMP = NSA_VC + 128 * 128,
              NSA_SELM = NSA_IMP + 4 * 64 * 33 * 4, NSA_UM = NSA_SELM + 256, NSA_END = NSA_UM + 16,
              NSA_PARK = NSA_KC;
static_assert(NSA_END <= RING_BYTES && NSA_PARK + 8 * 8192 <= NSA_SELM, "NSA LDS map");

DI void nsa_unit(Frame& F, int b, int g, int tb) {
    const int tid = launder(F.tid), lane = tid & 63, r32 = lane & 31, hi = lane >> 5, wid = F.wave;
    const int r = wid & 3, th = wid >> 2, hq = 4 * g + r, ql = 32 * th + r32, t = 64 * tb + ql;
    const size_t rowg = (size_t)b * T + t;
    LAS unsigned char* KC = F.lds + NSA_KC; LAS unsigned char* VC = F.lds + NSA_VC;
    const LaneAddr la = lane_addr(lane);
    LAS float* IMP = (LAS float*)(F.lds + NSA_IMP); LAS unsigned* SELM = (LAS unsigned*)(F.lds + NSA_SELM); LAS unsigned* UM = (LAS unsigned*)(F.lds + NSA_UM);
    SEC_BEGIN(1);
    bf16x8 qr[4];
#pragma unroll
    for (int st = 0; st < 4; ++st) qr[st] = *(const bf16x8*)(WSP(bf16, WS_P) + rowg * PP + hq * 64 + 16 * st + 8 * hi);
    float gate[3];
#pragma unroll
    for (int br = 0; br < 3; ++br) { const float xg = WSP(float, WS_MISC)[rowg * 32 + hq * 3 + br]; gate[br] = 1.0f / (1.0f + __expf(-xg)); }
    f32x16 ot[2];
#pragma unroll
    for (int i = 0; i < 16; ++i) { ot[0][i] = 0.f; ot[1][i] = 0.f; }
    {
        const bf16* kc = WSP(bf16, WS_KCMP) + (size_t)((b * 2 + g) * 128) * 64; const bf16* vc = WSP(bf16, WS_VCMP) + (size_t)((b * 2 + g) * 128) * 64;
#pragma unroll
        for (int ps = 0; ps < 2; ++ps) { const int row = (tid >> 3) + 64 * ps, ch = tid & 7;
            const u32x4 kk = *(const u32x4*)(kc + row * 64 + ch * 8), vv = *(const u32x4*)(vc + row * 64 + ch * 8);
            *(LAS u32x4*)(KC + kt_off(row, ch)) = kk; *(LAS u32x4*)(VC + vt_off(row, ch * 16)) = vv; }
        if (tid == 0) UM[0] = 0u;
    }
    __syncthreads();
    {
        const int nq = (t - 31) >> 4;
        float mx = -INFINITY;
#pragma unroll 1
        for (int c = 0; c < 4; ++c) {
            const f32x16 s = qk_block(F.lds, NSA_KC + c * 32 * 128, qr, la);
#pragma unroll
            for (int rg = 0; rg < 16; ++rg) if (32 * c + crow(rg, hi) <= nq) mx = fmaxf(mx, s[rg]);
        }
        mx = fmaxf(mx, __shfl_xor(mx, 32));
        const float ms = fmaxf(mx, -1e30f);
        float l = 0.f, carry = 0.f;
        LAS float* irow = IMP + (r * 64 + ql) * 33;
        f32x16 oc[2];
#pragma unroll
        for (int i = 0; i < 16; ++i) { oc[0][i] = 0.f; oc[1][i] = 0.f; }
#pragma unroll 1
        for (int c = 0; c < 4; ++c) {
            f32x16 p = qk_block(F.lds, NSA_KC + c * 32 * 128, qr, la);
#pragma unroll
            for (int rg = 0; rg < 16; ++rg) { p[rg] = (32 * c + crow(rg, hi) <= nq) ? fast_exp2(p[rg] - ms) : 0.f; l += p[rg]; }
            float sw[4];
#pragma unroll
            for (int u = 0; u < 4; ++u) sw[u] = __shfl_xor(p[4 * u + 3], 32);
#pragma unroll
            for (int u = 0; u < 4; ++u) {
                const float quad = (p[4 * u] + p[4 * u + 1]) + (p[4 * u + 2] + p[4 * u + 3]);
                const float prevlo = u > 0 ? sw[u > 0 ? u - 1 : 0] : carry;
                irow[8 * c + 2 * u + hi] = quad + (hi ? sw[u] : prevlo);
            }
            carry = sw[3];
            pv_step(oc, F.lds, NSA_VC + (32 * c) * 128, pack8(p, 0), la); pv_step(oc, F.lds, NSA_VC + (32 * c + 16) * 128, pack8(p, 8), la);
        }
        l += __shfl_xor(l, 32);
        const float inv = l > 0.f ? 1.0f / l : 0.f;
#pragma unroll
        for (int i = 0; i < 16; ++i) irow[2 * i + hi] *= inv;
        const float gs = gate[0] * inv;
#pragma unroll
        for (int i = 0; i < 16; ++i) { ot[0][i] = gs * oc[0][i]; ot[1][i] = gs * oc[1][i]; }
    }
    __syncthreads();
    if (tb < 16) {
        if (tid < 64) SELM[tid] = (2u << tb) - 1u;
        if (tid == 0) UM[0] = (2u << tb) - 1u;
    } else {
        const int j = lane & 31;
        unsigned um = 0u;
#pragma unroll 1
        for (int ps = 0; ps < 4; ++ps) {
            const int tq = wid * 8 + ps * 2 + hi;
            float v = ((IMP[(0 * 64 + tq) * 33 + j] + IMP[(1 * 64 + tq) * 33 + j]) + IMP[(2 * 64 + tq) * 33 + j]) + IMP[(3 * 64 + tq) * 33 + j];
            if (j > tb) v = -INFINITY; else if (j == 0 || j == tb || j == tb - 1) v = INFINITY;
            int rank = 0;
#pragma unroll 8
            for (int sft = 1; sft < 32; ++sft) {
                const int oj = (j + sft) & 31;
                const float ov = __shfl(v, (lane & 32) | oj);
                rank += (ov > v || (ov == v && oj < j)) ? 1 : 0;
            }
            const u64 bm = __ballot(rank < 16 && j <= tb);
            if (j == 0) SELM[tq] = hi ? (unsigned)(bm >> 32) : (unsigned)bm;
            um |= (unsigned)bm | (unsigned)(bm >> 32);
        }
        if (lane == 0) __hip_atomic_fetch_or(UM, um, __ATOMIC_RELAXED, __HIP_MEMORY_SCOPE_WORKGROUP);
    }
    __syncthreads();
    const unsigned umask = UM[0];
    SEC_END(1);
    SEC_BEGIN(2);
    LAS f32x4* park = (LAS f32x4*)(F.lds + NSA_PARK + wid * 8192) + lane;
#pragma unroll
    for (int u = 0; u < 4; ++u) { park[64 * u] = (f32x4){ot[0][4 * u], ot[0][4 * u + 1], ot[0][4 * u + 2], ot[0][4 * u + 3]}; park[64 * (4 + u)] = (f32x4){ot[1][4 * u], ot[1][4 * u + 1], ot[1][4 * u + 2], ot[1][4 * u + 3]}; }
    const unsigned sel = SELM[ql];
    const bf16* Pb = WSP(bf16, WS_P) + (size_t)b * T * PP;
    {
        f32x16 o[2];
#pragma unroll
        for (int i = 0; i < 16; ++i) { o[0][i] = 0.f; o[1][i] = 0.f; }
        float m_run = 0.f, l_run = 0.f;
        SlcMask mf{sel, tb, ql};
        run_tiles<false>(F, umask, Pb + (HB_KSL + g) * 64, Pb + (HB_VSL + g) * 64, qr, o, m_run, l_run, mf, la, tid);
        float l = l_run;
        const float sc = l > 0.f ? gate[1] / l : 0.f;
#pragma unroll
        for (int u = 0; u < 4; ++u) {
            f32x4 a = park[64 * u], c = park[64 * (4 + u)];
#pragma unroll
            for (int i = 0; i < 4; ++i) { a[i] += sc * o[0][4 * u + i]; c[i] += sc * o[1][4 * u + i]; }
            park[64 * u] = a; park[64 * (4 + u)] = c;
        }
    }
    SEC_END(2);
    SEC_BEGIN(3);
    {
        f32x16 o[2];
#pragma unroll
        for (int i = 0; i < 16; ++i) { o[0][i] = 0.f; o[1][i] = 0.f; }
        float m_run = 0.f, l_run = 0.f;
        const int jlo = tb >= 8 ? tb - 8 : 0;
        const unsigned wmask = (tb == 31 ? ~0u : ((2u << tb) - 1u)) & ~((1u << jlo) - 1u);
        WinMask mf{tb, ql};
        run_tiles<false>(F, wmask, Pb + (HB_KW + g) * 64, Pb + (HB_VW + g) * 64, qr, o, m_run, l_run, mf, la, tid);
        float l = l_run;
        const float sc = l > 0.f ? gate[2] / l : 0.f;
#pragma unroll
        for (int u = 0; u < 4; ++u) {
            const f32x4 a = park[64 * u], c = park[64 * (4 + u)];
#pragma unroll
            for (int i = 0; i < 4; ++i) { ot[0][4 * u + i] = a[i] + sc * o[0][4 * u + i]; ot[1][4 * u + i] = c[i] + sc * o[1][4 * u + i]; }
        }
    }
    SEC_END(3);
    unsigned char* orow = WSP(unsigned char, WS_XN) + rowg * D + hq * 64 + 4 * hi;
#pragma unroll
    for (int db = 0; db < 2; ++db)
#pragma unroll
        for (int u = 0; u < 4; ++u) *(unsigned*)(orow + 32 * db + 8 * u) = pk4_f8((f32x4){ot[db][4 * u], ot[db][4 * u + 1], ot[db][4 * u + 2], ot[db][4 * u + 3]} * 64.0f);
}

constexpr int DSA_ROW = 8208, DSA_MB = 131584, DSA_HIST = DSA_MB + 32 * 33 * 8, DSA_END = DSA_HIST + 8 * 2560;
static_assert(16 * DSA_ROW <= MISC_OFF && DSA_MB >= MISC_OFF + 128 && DSA_END <= LDS_BYTES, "DSA LDS map");
typedef float f32x4v __attribute__((ext_vector_type(4)));
#define MFMA16(a, b, c) __builtin_amdgcn_mfma_f32_16x16x32_bf16((a), (b), (c), 0, 0, 0)

DI void dsa_scores16(Frame& F, const bf16* Pb, size_t rowq0, int KB, int lane, int wid) {
    const int q = lane & 15, kg = lane >> 4;
    bf16x8 qf[4][2];
#pragma unroll
    for (int h = 0; h < 4; ++h)
#pragma unroll
        for (int st = 0; st < 2; ++st) qf[h][st] = *(const bf16x8*)(Pb + (rowq0 + q) * PP + (HB_QI + h) * 64 + 32 * st + 8 * kg);
    const float idx_scale = 0.5f * 0.125f;
    const f32x4 wv = *(const f32x4*)(WSP(float, WS_MISC) + (rowq0 + q) * 32 + 24);
    const float w0 = wv[0] * idx_scale, w1 = wv[1] * idx_scale, w2 = wv[2] * idx_scale, w3 = wv[3] * idx_scale;
    LAS unsigned char* rowp = F.lds + q * DSA_ROW;
    const bf16* kbase = Pb + (rowq0 - (rowq0 % T) + q) * PP + HB_KI * 64 + 8 * kg;
    bf16x8 ka[4][2], kn[4][2];
    if (wid < KB) {
#pragma unroll
        for (int blk = 0; blk < 4; ++blk)
#pragma unroll
            for (int st = 0; st < 2; ++st) ka[blk][st] = *(const bf16x8*)(kbase + (size_t)(64 * wid + 16 * blk) * PP + 32 * st);
    }
    for (int kb = wid; kb < KB; kb += 8) {
        if (kb + 8 < KB) {
#pragma unroll
            for (int blk = 0; blk < 4; ++blk)
#pragma unroll
                for (int st = 0; st < 2; ++st) kn[blk][st] = *(const bf16x8*)(kbase + (size_t)(64 * (kb + 8) + 16 * blk) * PP + 32 * st);
        }
        const int g = kb >> 2, e = kb & 3;
#pragma unroll
        for (int blk = 0; blk < 4; ++blk) {
            f32x4v sc;
#pragma unroll
            for (int h = 0; h < 4; ++h) {
                f32x4v acc = {0.f, 0.f, 0.f, 0.f};
                acc = MFMA16(ka[blk][0], qf[h][0], acc); acc = MFMA16(ka[blk][1], qf[h][1], acc);
                const float wh = h == 0 ? w0 : (h == 1 ? w1 : (h == 2 ? w2 : w3));
#pragma unroll
                for (int i = 0; i < 4; ++i) { const float rl = fmaxf(acc[i], 0.f); sc[i] = h == 0 ? wh * rl : fmaf(wh, rl, sc[i]); }
            }
#pragma unroll
            for (int i = 0; i < 4; ++i) *(LAS float*)(rowp + ((g * 64 + 16 * blk + 4 * kg + i) * 4 + e) * 4) = sc[i];
        }
#pragma unroll
        for (int blk = 0; blk < 4; ++blk) { ka[blk][0] = kn[blk][0]; ka[blk][1] = kn[blk][1]; }
    }
}
template <int CTRL> DI int dpp_mov0(int x) { return __builtin_amdgcn_update_dpp(0, x, CTRL, 0xF, 0xF, false); }
DI int wave_incl_scan(int v, int lane) {
    const int rl = lane & 15;
    int t;
    t = v + dpp_mov0<0x111>(v); if (rl >= 1) v = t;
    t = v + dpp_mov0<0x112>(v); if (rl >= 2) v = t;
    t = v + dpp_mov0<0x114>(v); if (rl >= 4) v = t;
    t = v + dpp_mov0<0x118>(v); if (rl >= 8) v = t;
    t = v + dpp_mov0<0x142>(v); if ((lane & 31) >= 16) v = t;
    t = v + dpp_mov0<0x143>(v); if (lane >= 32) v = t;
    return v;
}
template <int CTRL> DI float dpp_movf(float x) { return __int_as_float(__builtin_amdgcn_update_dpp(0, __float_as_int(x), CTRL, 0xF, 0xF, false)); }
DI float wave_max_nonneg(float v, int lane) {
    v = fmaxf(v, dpp_movf<0x111>(v)); v = fmaxf(v, dpp_movf<0x112>(v)); v = fmaxf(v, dpp_movf<0x114>(v)); v = fmaxf(v, dpp_movf<0x118>(v));
    v = fmaxf(v, dpp_movf<0x142>(v)); v = fmaxf(v, dpp_movf<0x143>(v));
    return __int_as_float(__builtin_amdgcn_readlane(__float_as_int(v), 63));
}
DI void dsa_select2(const int t0q, const int KB, LAS unsigned* hist, LAS u32x4* keysA, LAS u32x4* keysB, LAS u64* mrowA, LAS u64* mrowB, int lane) {
    const int G4 = (KB + 3) >> 2;
    LAS u32x4* keys[2] = {keysA, keysB};
    LAS u64* mrow[2] = {mrowA, mrowB};
    float mxa[2] = {0.f, 0.f};
    for (int g = 0; g < G4; ++g) {
#pragma unroll
        for (int q = 0; q < 2; ++q) {
            const u32x4 kk = keys[q][g * 64 + lane];
#pragma unroll
            for (int e = 0; e < 4; ++e) { const int i = 4 * g + e; if (64 * i + lane <= t0q + q) mxa[q] = fmaxf(mxa[q], fabsf(__uint_as_float(kk[e]))); }
        }
    }
    mxa[0] = wave_max_nonneg(mxa[0], lane); mxa[1] = wave_max_nonneg(mxa[1], lane);
    float scl[2];
#pragma unroll
    for (int q = 0; q < 2; ++q) scl[q] = mxa[q] > 0.f ? 8388606.0f / mxa[q] : 0.f;
    for (int g = 0; g < G4; ++g) {
#pragma unroll
        for (int q = 0; q < 2; ++q) {
            u32x4 kk = keys[q][g * 64 + lane];
#pragma unroll
            for (int e = 0; e < 4; ++e) {
                const int i = 4 * g + e;
                const unsigned k = (unsigned)(__float2int_rn((__uint_as_float(kk[e]) + 0.0f) * scl[q]) + 8388608);
                kk[e] = (64 * i + lane <= t0q + q) ? k : 0u;
            }
            keys[q][g * 64 + lane] = kk;
        }
    }
    LDS_WAIT();
    unsigned prefix[2] = {0u, 0u}; int rem[2] = {256, 256};
#pragma unroll 1
    for (int pass = 0; pass < 3; ++pass) {
        const int shift = 16 - 8 * pass;
        { u32x4 z = {0u, 0u, 0u, 0u}; *(LAS u32x4*)(hist + 4 * lane) = z; *(LAS u32x4*)(hist + 320 + 4 * lane) = z; }
        LDS_WAIT();
#pragma unroll 2
        for (int g = 0; g < G4; ++g) {
#pragma unroll
            for (int q = 0; q < 2; ++q) {
                const u32x4 kk = keys[q][g * 64 + lane];
#pragma unroll
                for (int e = 0; e < 4; ++e) {
                    const unsigned k = kk[e];
                    const bool match = k != 0u && (k >> (shift + 8)) == prefix[q];
                    LAS unsigned* dst = hist + 320 * q + (match ? ((k >> shift) & 255u) : 256u + lane);
                    __hip_atomic_fetch_add(dst, 1u, __ATOMIC_RELAXED, __HIP_MEMORY_SCOPE_WORKGROUP);
                }
            }
        }
        LDS_WAIT();
        u32x4 cc[2];
#pragma unroll
        for (int q = 0; q < 2; ++q) cc[q] = *(LAS u32x4*)(hist + 320 * q + 4 * lane);
        LDS_WAIT();
#pragma unroll
        for (int q = 0; q < 2; ++q) {
            const int tot = (int)(cc[q].x + cc[q].y + cc[q].z + cc[q].w);
            const int pre = wave_incl_scan(tot, lane);
            const int total = __builtin_amdgcn_readlane(pre, 63);
            const int suf = total - pre + tot;
            const u64 bal = __ballot(suf >= rem[q]);
            const int L = __popcll(bal) - 1;
            int cum = suf - tot, dsel;
            if (cum + (int)cc[q].w >= rem[q]) dsel = 3;
            else { cum += (int)cc[q].w;
                if (cum + (int)cc[q].z >= rem[q]) dsel = 2;
                else { cum += (int)cc[q].z;
                    if (cum + (int)cc[q].y >= rem[q]) dsel = 1;
                    else { cum += (int)cc[q].y; dsel = 0; } } }
            const int dig = __builtin_amdgcn_readlane(4 * lane + dsel, L);
            rem[q] -= __builtin_amdgcn_readlane(cum, L);
            prefix[q] = (prefix[q] << 8) | (unsigned)dig;
        }
    }
    int running[2] = {0, 0};
    const u64 below = (1ull << lane) - 1ull;
    for (int g = 0; g < G4; ++g) {
#pragma unroll
        for (int q = 0; q < 2; ++q) {
            const u32x4 kk = keys[q][g * 64 + lane];
#pragma unroll
            for (int e = 0; e < 4; ++e) {
                const unsigned k = kk[e];
                const bool eq = k == prefix[q];
                const u64 beq = __ballot(eq);
                const bool sl = k > prefix[q] || (eq && running[q] + __popcll(beq & below) < rem[q]);
                running[q] += __popcll(beq);
                const u64 bm = __ballot(sl);
                if (lane == 0 && 4 * g + e < KB) mrow[q][4 * g + e] = bm;
            }
        }
    }
}
DI void dsa_unit(Frame& F, int b, int qb32) {
    const int tid = launder(F.tid), lane = tid & 63, r32 = lane & 31, hi = lane >> 5, wid = F.wave;
    const int t0 = 32 * qb32, KB = (qb32 >> 1) + 1;
    const LaneAddr la = lane_addr(lane);
    LAS u64* MB = (LAS u64*)(F.lds + DSA_MB); LAS unsigned* HIST = (LAS unsigned*)(F.lds + DSA_HIST) + wid * 640;
    const bf16* P0 = WSP(bf16, WS_P);
    SEC_BEGIN(4);
    if (t0 + 31 < 256) {
        for (int qq = 0; qq < 4; ++qq) { const int qi = wid * 4 + qq, t = t0 + qi;
            for (int i = 0; i < KB; ++i) { const u64 bm = __ballot(64 * i + lane <= t); if (lane == 0) MB[qi * 33 + i] = bm; } }
    } else {
#pragma unroll 1
        for (int rnd = 0; rnd < 2; ++rnd) {
            { SEC_BEGIN(6); dsa_scores16(F, P0, (size_t)b * T + t0 + 16 * rnd, KB, lane, wid); LDS_WAIT(); SEC_END(6); }
            __syncthreads();
            SEC_BEGIN(7);
            {
                const int ql = 2 * wid, qi = 16 * rnd + ql;
                dsa_select2(t0 + qi, KB, HIST, (LAS u32x4*)(F.lds + ql * DSA_ROW), (LAS u32x4*)(F.lds + (ql + 1) * DSA_ROW), MB + qi * 33, MB + (qi + 1) * 33, lane);
            }
            LDS_WAIT(); SEC_END(7);
            __syncthreads();
        }
    }
    __syncthreads();
    SEC_END(4);
    SEC_BEGIN(5);
    const size_t rowg = (size_t)b * T + t0 + r32;
    bf16x8 qr[4];
#pragma unroll
    for (int st = 0; st < 4; ++st) qr[st] = *(const bf16x8*)(WSP(bf16, WS_P) + rowg * PP + (HB_QD + wid) * 64 + 16 * st + 8 * hi);
    f32x16 o[2];
#pragma unroll
    for (int i = 0; i < 16; ++i) { o[0][i] = 0.f; o[1][i] = 0.f; }
    float m_run = 0.f, l_run = 0.f;
    const bf16* Pb = WSP(bf16, WS_P) + (size_t)b * T * PP;
    const unsigned tmask = KB >= 32 ? ~0u : ((1u << KB) - 1u);
    DsaMask mf{MB + r32 * 33};
    run_tiles<true>(F, tmask, Pb + HB_KD * 64, Pb + HB_VD * 64, qr, o, m_run, l_run, mf, la, tid);
    const float l = l_run;
    const float sc = l > 0.f ? 1.0f / l : 0.f;
    unsigned char* orow = WSP(unsigned char, WS_XN) + rowg * D + 512 + wid * 64 + 4 * hi;
    const float sc64 = sc * 64.0f;
#pragma unroll
    for (int db = 0; db < 2; ++db)
#pragma unroll
        for (int u = 0; u < 4; ++u) *(unsigned*)(orow + 32 * db + 8 * u) = pk4_f8((f32x4){o[db][4 * u], o[db][4 * u + 1], o[db][4 * u + 2], o[db][4 * u + 3]} * sc64);
    SEC_END(5);
}
DI void phase_a1(Frame& F) {
    unsigned* ctr = WSP(unsigned, WS_CTL) + 512;
    for (;;) {
        SEC_BEGIN(15);
        const int r = q_next(F, ctr, 32 + 256);
        SEC_END(15);
        if (r < 0) break;
        const int x = r >> 16, it = r & 65535;
        if (it < 32) { SEC_BEGIN(14); compress_item(F, (it & 7) + 8 * (x + 8 * (it >> 3))); SEC_END(14); }
        else { SEC_BEGIN(13); const int u = it - 32; dsa_unit(F, x + 8 * (u & 3), 63 - (u >> 2)); SEC_END(13); }
    }
}
DI void phase_a2(Frame& F) {
    unsigned* ctr = WSP(unsigned, WS_CTL) + 1024;
    for (;;) {
        const int r = q_next(F, ctr, 256);
        if (r < 0) break;
        const int x = r >> 16, it = r & 65535;
        const int pair = x + 8 * (it & 7);
        nsa_unit(F, pair >> 1, pair & 1, 31 - (it >> 3));
    }
}

#define XB_TMO      128
#define XB_XCNT(j)  (256  + 64 * (j))
#define XB_XSUB(j)  (1280 + 64 * (j))
#define XB_XGEN(j)  (2304 + 64 * (j))
#define XB_TOP      3328
#define XB_TOPGEN   3392
#define XCD_BAR_WORDS 3456
#define XB_SPIN_CAP (1u << 18)

__device__ __forceinline__ unsigned xb_ld(unsigned* p)              { return __hip_atomic_load(p, __ATOMIC_RELAXED, __HIP_MEMORY_SCOPE_AGENT); }
__device__ __forceinline__ unsigned xb_add(unsigned* p, unsigned v) { return __hip_atomic_fetch_add(p, v, __ATOMIC_RELAXED, __HIP_MEMORY_SCOPE_AGENT); }
__device__ __forceinline__ unsigned xb_xcc_id() { return (unsigned)__builtin_amdgcn_s_getreg((3 << 11) | 20) & 0xFu; }
#define XB_SPIN(cond, bar) do { unsigned _sp = 0; while (cond) { __builtin_amdgcn_s_sleep(1); \
    if ((++_sp & 255u) == 0u) { if (xb_ld(&(bar)[XB_TMO])) break; if (_sp > XB_SPIN_CAP) { atomicAdd(&(bar)[XB_TMO], 1u); break; } } } } while (0)

struct XcdBarrier {
    unsigned* bar; unsigned x;
    volatile LAS unsigned* st;
};

__device__ __forceinline__ XcdBarrier xcd_barrier_post(unsigned* bar, volatile LAS unsigned* st) {
    XcdBarrier b; b.bar = bar; b.x = xb_xcc_id(); b.st = st;
    if (threadIdx.x == 0) (void)xb_add(&bar[XB_XCNT(b.x)], 1u);
    return b;
}
__device__ __forceinline__ void xcd_barrier_complete(unsigned* bar, unsigned x, unsigned& nloc, unsigned& nx) {
    const unsigned G = gridDim.x * gridDim.y * gridDim.z;
    unsigned sum, cnt, mine, sp = 0u;
    for (;;) {
        sum = 0u; cnt = 0u; mine = 0u;
#pragma unroll
        for (unsigned j = 0; j < 16; ++j) { const unsigned c = xb_ld(&bar[XB_XCNT(j)]); sum += c; cnt += (c > 0u) ? 1u : 0u; mine = (j == x) ? c : mine; }
        if (sum == G) break;
        __builtin_amdgcn_s_sleep(1);
        if ((++sp & 255u) == 0u) { if (xb_ld(&bar[XB_TMO])) break; if (sp > XB_SPIN_CAP) { atomicAdd(&bar[XB_TMO], 1u); break; } }
    }
    nloc = mine > 0u ? mine : 1u; nx = cnt > 0u ? cnt : 1u;
}

__device__ __forceinline__ void xcd_barrier(const XcdBarrier& b) {
    asm volatile("s_waitcnt vmcnt(0)" ::: "memory");
    __syncthreads();
    if (threadIdx.x == 0) {
        unsigned* bar = b.bar;
        __builtin_amdgcn_s_waitcnt(0);
        unsigned nloc = b.st[0], nx = b.st[1];
        if (nloc == 0u) { xcd_barrier_complete(bar, b.x, nloc, nx); b.st[0] = nloc; b.st[1] = nx; }
        const unsigned old = xb_add(&bar[XB_XSUB(b.x)], 1u);
        const unsigned gen = old / nloc;
        if (old + 1u == (gen + 1u) * nloc) {
            __builtin_amdgcn_fence(__ATOMIC_RELEASE, "agent");
            asm volatile("s_waitcnt vmcnt(0)" ::: "memory");
            const unsigned og = xb_add(&bar[XB_TOP], 1u);
            const unsigned tg = og / nx;
            if (og + 1u == (tg + 1u) * nx) xb_add(&bar[XB_TOPGEN], 1u);
            else XB_SPIN(xb_ld(&bar[XB_TOPGEN]) == tg, bar);
            __builtin_amdgcn_fence(__ATOMIC_ACQUIRE, "agent");
            xb_add(&bar[XB_XGEN(b.x)], 1u);
            asm volatile("s_waitcnt vmcnt(0)" ::: "memory");
        } else {
            XB_SPIN(xb_ld(&bar[XB_XGEN(b.x)]) == gen, bar);
            __builtin_amdgcn_fence(__ATOMIC_ACQUIRE, "agent");
            asm volatile("s_waitcnt vmcnt(0)" ::: "memory");
        }
    }
    __syncthreads();
}


constexpr int CW_BAR = 4096;
constexpr int N_PHASES = 10;
#ifndef PHASE_MASK
#define PHASE_MASK 0x3FF
#endif
#ifndef PROBE_LO
#define PROBE_LO -1
#endif
#ifndef PROBE_HI
#define PROBE_HI -1
#endif
#ifndef MK_COOP
#define MK_COOP 1
#endif

__global__ void __launch_bounds__(NTHR, 2) mega_fwd(Args args) {
    extern __shared__ __attribute__((aligned(16))) unsigned char lds_raw[];
    Frame F;
    F.lds = (LAS unsigned char*)lds_raw;
    F.MISC = (volatile LAS unsigned*)(F.lds + MISC_OFF);
    F.tid = threadIdx.x; F.lane = F.tid & 63; F.wave = __builtin_amdgcn_readfirstlane(F.tid >> 6);
    F.G = gridDim.x; F.bid = blockIdx.x; F.pacc = 0ull;
    if (F.tid < 32) F.MISC[F.tid] = 0u;
    __syncthreads();
    F.ws = args.ws;
    const Args& A = args;
    bf16* OPROJ = WSP(bf16, WS_P); bf16* Y = WSP(bf16, WS_P);

    const int lo = args.ph_lo, hi = args.ph_hi;
    XcdBarrier xbar; xbar.bar = WSP(unsigned, WS_CTL) + CW_BAR; xbar.x = 0; xbar.st = nullptr;
    if (args.coop) xbar = xcd_barrier_post(WSP(unsigned, WS_CTL) + CW_BAR, F.MISC + 8);
#define IN(k) (lo <= (k) && (k) < hi)
    unsigned long long pr_a = 0ull, pr_b = 0ull;
#define SEAM(k) do { if (IN(k) && IN((k) + 1)) { if (args.coop) { if ((k) == 0) cg::this_grid().sync(); else xcd_barrier(xbar); } } \
        if (PROBE_LO == (k) + 1) pr_a = __builtin_amdgcn_s_memrealtime(); if (PROBE_HI == (k)) pr_b = __builtin_amdgcn_s_memrealtime(); } while (0)
    if (PROBE_LO == 0) pr_a = __builtin_amdgcn_s_memrealtime();

    if (((PHASE_MASK >> 0) & 1) && IN(0)) { phase_p0(F, A); }
    SEAM(0);
    if (((PHASE_MASK >> 1) & 1) && IN(1)) { phase_e0(F, A); }
    SEAM(1);
    if (((PHASE_MASK >> 2) & 1) && IN(2)) {
        pg8::Gemm g{WSP(bf16, WS_XN), WSP(bf16, WS_WIN), M, NPROJ, D}; pg8::StaticOrder S; S.init(M, NPROJ, F.G, F.bid);
        pg8::EpiProj E{WSP(bf16, WS_P), WSP(float, WS_MISC), WSP(float, WS_CS)};
        pg8::gemm_phase<pg8::EpiProj, pg8::StaticOrder, true, true>(F.lds, g, S, E);
    }
    SEAM(2);
    if (((PHASE_MASK >> 3) & 1) && IN(3)) { phase_a1(F); }
    SEAM(3);
    if (((PHASE_MASK >> 4) & 1) && IN(4)) { phase_a2(F); }
    SEAM(4);
    if (((PHASE_MASK >> 5) & 1) && IN(5)) {
        pg8::Gemm g{WSP(bf16, WS_XN), WSP(bf16, WS_WOUT), M, D, D / 2}; pg8::StaticOrder S; S.init(M, D, F.G, F.bid);
        pg8::EpiStoreScaled E{OPROJ, D, 1.0f / 8192.0f};
        pg8::gemm_phase_f8<pg8::EpiStoreScaled, pg8::StaticOrder, true, true>(F.lds, g, S, E);
    }
    SEAM(5);
    if (((PHASE_MASK >> 6) & 1) && IN(6)) { phase_e1(F, A, OPROJ); }
    SEAM(6);
    if (((PHASE_MASK >> 7) & 1) && IN(7)) {
        pg8::Gemm g{WSP(bf16, WS_XN), WSP(bf16, WS_WUP), M, FF, D / 2}; pg8::StaticOrder S; S.init(M, FF, F.G, F.bid);
        pg8::EpiStoreF8 E{WSP(unsigned char, WS_SC), FF, 4.0f / (4096.0f * 4096.0f)};
        pg8::gemm_phase_f8<pg8::EpiStoreF8, pg8::StaticOrder, true, true>(F.lds, g, S, E);
    }
    SEAM(7);
    if (((PHASE_MASK >> 8) & 1) && IN(8)) {
        pg8::Gemm g{WSP(bf16, WS_SC), WSP(bf16, WS_WDOWN), M, D, FF / 2}; pg8::StaticOrder S; S.init(M, D, F.G, F.bid);
        pg8::EpiStoreScaled E{Y, D, 1.0f / 1024.0f};
        pg8::gemm_phase_f8<pg8::EpiStoreScaled, pg8::StaticOrder, true, true>(F.lds, g, S, E);
    }
    SEAM(8);
    if (((PHASE_MASK >> 9) & 1) && IN(9)) { phase_e2(F, A, Y); }
    if (PROBE_HI == 9) { __syncthreads(); pr_b = __builtin_amdgcn_s_memrealtime(); }
    if ((PROBE_LO >= 0 || PROBE_SEC > 0) && F.bid == 0 && F.tid == 0) {
        const unsigned long long t0 = __builtin_amdgcn_s_memrealtime(), span = PROBE_SEC > 0 ? F.pacc : pr_b - pr_a;
        while (__builtin_amdgcn_s_memrealtime() - t0 < span) __builtin_amdgcn_s_sleep(32);
    }
#undef IN
#undef SEAM
}

extern "C" void kernel_launch(void* const* d_in, const int* in_sizes, int n_in, void* d_out, int out_size, void* d_ws, size_t ws_size, hipStream_t stream) {
    static int grid = 0;
    if (grid == 0) {
        if (n_in != 19 || in_sizes[0] != M * D || out_size != M * D || ws_size < WS_END) {
            fprintf(stderr, "kernel_launch: unexpected shapes: n_in %d in0 %d out %d ws %zu (need %zu)\n", n_in, n_in > 0 ? in_sizes[0] : -1, out_size, ws_size, (size_t)WS_END); grid = -1; return; }
        int dev = 0, cus = 0, per_cu = 0;
        if (hipGetDevice(&dev) != hipSuccess || hipDeviceGetAttribute(&cus, hipDeviceAttributeMultiprocessorCount, dev) != hipSuccess) { fprintf(stderr, "kernel_launch: device query failed\n"); grid = -1; return; }
        if (hipFuncSetAttribute((const void*)mega_fwd, hipFuncAttributeMaxDynamicSharedMemorySize, LDS_BYTES) != hipSuccess) { fprintf(stderr, "kernel_launch: hipFuncSetAttribute failed\n"); grid = -1; return; }
        if (hipOccupancyMaxActiveBlocksPerMultiprocessor(&per_cu, (const void*)mega_fwd, NTHR, LDS_BYTES) != hipSuccess || per_cu < 1) { fprintf(stderr, "kernel_launch: occupancy query says %d\n", per_cu); per_cu = 1; }
        (void)hipGetLastError();
        grid = cus;
        fprintf(stderr, "kernel_launch: cus %d per_cu %d grid %d\n", cus, per_cu, grid);
    }
    if (grid < 0) return;
    if (hipMemsetAsync((char*)d_ws + WS_CTL, 0, CTL_ZERO_BYTES, stream) != hipSuccess) { fprintf(stderr, "kernel_launch: memset failed\n"); return; }
    Args a{};
    for (int i = 0; i < 19; ++i) a.in[i] = d_in[i];
    a.out = (float*)d_out; a.ws = (unsigned char*)d_ws;
#if MK_COOP
    a.ph_lo = 0; a.ph_hi = N_PHASES; a.coop = 1;
    void* kargs[] = {&a};
    hipError_t e = hipLaunchCooperativeKernel((const void*)mega_fwd, dim3(grid), dim3(NTHR), kargs, LDS_BYTES, stream);
    if (e != hipSuccess) fprintf(stderr, "kernel_launch: cooperative launch failed: %s (grid %d)\n", hipGetErrorString(e), grid);
#else
    for (int ph = 0; ph < N_PHASES; ++ph) {
        a.ph_lo = ph; a.ph_hi = ph + 1; a.coop = 0;
        hipLaunchKernelGGL(mega_fwd, dim3(grid), dim3(NTHR), LDS_BYTES, stream, a);
        const hipError_t le = hipPeekAtLastError();
        if (le != hipSuccess) { fprintf(stderr, "kernel_launch: launch %d failed: %s\n", ph, hipGetErrorName(le)); break; }
    }
#endif
}
```

```cpp
#include <hip/hip_runtime.h>
#include <hip/hip_cooperative_groups.h>
#include <cstdio>
#include <cstdint>
namespace cg = cooperative_groups;
#define DI __device__ __forceinline__
namespace pg8 {
#define PG8_LAS __attribute__((address_space(3)))
typedef unsigned short bf16_t;
typedef short bf16x8 __attribute__((ext_vector_type(8)));
typedef float f32x4 __attribute__((ext_vector_type(4)));
typedef unsigned u32x4 __attribute__((ext_vector_type(4)));
constexpr int BM = 256, BK = 64, HALF = 128, HTB = HALF * BK * 2  , STAGE_BYTES = 8 * HTB, NXCD = 8, WGM = 8;

__host__ __device__ __forceinline__ int lds_byte(int r, int c) { const int st = (r >> 4) * 2 + (c >> 5), rr = r & 15, cc = c & 31, ob = rr * 64 + cc * 2; return st * 1024 + (ob ^ (((ob >> 9) & 1) << 5)); }
__host__ __device__ __forceinline__ void stage_rc(int b, int& R, int& C) { const int st = b / 1024, sb = b % 1024, swz = sb ^ (((sb >> 9) & 1) << 5); R = (st >> 1) * 16 + swz / 64; C = (st & 1) * 32 + (swz % 64) / 2; }
__host__ __device__ __forceinline__ int perm32(int rho) { const int n = rho >> 4, i = rho & 15; return 8 * (i >> 2) + 4 * n + (i & 3); }

struct Unit { int pm, pn; };
struct Gemm { const bf16_t* A; const bf16_t* Bt; int M, N, K; };

struct StaticOrder {
    int nM, nN, nwg, G, c, rev;
    __host__ __device__ void init(int M, int N, int G_, int c_) { nM = M / BM; nN = N / BM; nwg = nM * nN; G = G_; c = c_; rev = 0; }
    __host__ __device__ bool next(int i, Unit& u) const {
        const long L = (long)i * G + c; if (L >= nwg) return false;
        int wgid = (int)L; { const int q = nwg / NXCD, r = nwg % NXCD, xcd = wgid % NXCD, off = wgid / NXCD; wgid = (xcd < r ? xcd * (q + 1) : r * (q + 1) + (xcd - r) * q) + off; }
        const int nig = WGM * nN, gid = wgid / nig, fm = gid * WGM, gsz = (nM - fm) < WGM ? (nM - fm) : WGM;
        u.pm = fm + ((wgid % nig) % gsz); u.pn = (wgid % nig) / gsz; if (rev) u.pm = nM - 1 - u.pm; return true;
    }
    __device__ __forceinline__ void a_ready(const Unit&) const {}
    __device__ __forceinline__ void done(const Unit&) const {}
};


typedef float f32x2 __attribute__((ext_vector_type(2)));
typedef unsigned u32x2 __attribute__((ext_vector_type(2)));
typedef __bf16 bf16x2_t __attribute__((ext_vector_type(2)));
__device__ __forceinline__ unsigned cvt_pk_bf16(float lo, float hi) { f32x2 v = {lo, hi}; bf16x2_t b = __builtin_convertvector(v, bf16x2_t); return __builtin_bit_cast(unsigned, b); }

template <int ACT  > struct EpiStore {
    static constexpr bool PERM = true, AFTER_DRAIN = false;
    bf16_t* O; int ldc;
    __device__ __forceinline__ void operator()(const f32x4 (&acc)[2][2][4][2], const Unit& u, int wr, int wc, int fr, int fq) const {
        const int row0 = u.pm * BM + wr * 64 + fr; const int col0 = u.pn * BM + wc * 32 + 8 * fq;
#pragma unroll
        for (int ai = 0; ai < 2; ++ai)
#pragma unroll
            for (int m = 0; m < 4; ++m) { bf16_t* rowp = O + (size_t)(row0 + ai * HALF + m * 16) * ldc + col0;
#pragma unroll
                for (int bj = 0; bj < 2; ++bj) { f32x4 v0 = acc[ai][bj][m][0], v1 = acc[ai][bj][m][1];
                    if (ACT == 1) {
#pragma unroll
                        for (int i = 0; i < 4; ++i) { const float a = v0[i] > 0.f ? v0[i] : 0.f, b = v1[i] > 0.f ? v1[i] : 0.f; v0[i] = a * a; v1[i] = b * b; } }
                    u32x4 w; w.x = cvt_pk_bf16(v0[0], v0[1]); w.y = cvt_pk_bf16(v0[2], v0[3]); w.z = cvt_pk_bf16(v1[0], v1[1]); w.w = cvt_pk_bf16(v1[2], v1[3]);
                    *(u32x4*)(rowp + bj * HALF) = w; } }
    }
};

struct EpiStoreF8 {
    static constexpr bool PERM = true, AFTER_DRAIN = false;
    unsigned char* O; int ldc; float scale;
    __device__ __forceinline__ void operator()(const f32x4 (&acc)[2][2][4][2], const Unit& u, int wr, int wc, int fr, int fq) const {
        const int row0 = u.pm * BM + wr * 64 + fr; const int col0 = u.pn * BM + 16 * (4 * wc + fq);
#pragma unroll
        for (int ai = 0; ai < 2; ++ai)
#pragma unroll
            for (int m = 0; m < 4; ++m) { unsigned char* rowp = O + (size_t)(row0 + ai * HALF + m * 16) * ldc + col0;
                unsigned wq[4];
#pragma unroll
                for (int bj = 0; bj < 2; ++bj) { f32x4 v0 = acc[ai][bj][m][0], v1 = acc[ai][bj][m][1];
#pragma unroll
                    for (int i = 0; i < 4; ++i) { const float a = v0[i] > 0.f ? v0[i] : 0.f, b = v1[i] > 0.f ? v1[i] : 0.f; v0[i] = fminf(a * a * scale, 448.f); v1[i] = fminf(b * b * scale, 448.f); }
                    unsigned x = (unsigned)__builtin_amdgcn_cvt_pk_fp8_f32(v0[0], v0[1], 0, false); x = (unsigned)__builtin_amdgcn_cvt_pk_fp8_f32(v0[2], v0[3], (int)x, true);
                    unsigned y = (unsigned)__builtin_amdgcn_cvt_pk_fp8_f32(v1[0], v1[1], 0, false); y = (unsigned)__builtin_amdgcn_cvt_pk_fp8_f32(v1[2], v1[3], (int)y, true);
                    wq[2 * bj] = x; wq[2 * bj + 1] = y; }
                const u32x4 w = {wq[0], wq[1], wq[2], wq[3]};
                __builtin_nontemporal_store(w, (u32x4*)rowp); }
    }
};
struct EpiStoreScaled {
    static constexpr bool PERM = true, AFTER_DRAIN = false;
    bf16_t* O; int ldc; float scale;
    __device__ __forceinline__ void operator()(const f32x4 (&acc)[2][2][4][2], const Unit& u, int wr, int wc, int fr, int fq) const {
        const int row0 = u.pm * BM + wr * 64 + fr; const int col0 = u.pn * BM + wc * 32 + 8 * fq;
#pragma unroll
        for (int ai = 0; ai < 2; ++ai)
#pragma unroll
            for (int m = 0; m < 4; ++m) { bf16_t* rowp = O + (size_t)(row0 + ai * HALF + m * 16) * ldc + col0;
#pragma unroll
                for (int bj = 0; bj < 2; ++bj) { const f32x4 v0 = acc[ai][bj][m][0] * scale, v1 = acc[ai][bj][m][1] * scale;
                    u32x4 w; w.x = cvt_pk_bf16(v0[0], v0[1]); w.y = cvt_pk_bf16(v0[2], v0[3]); w.z = cvt_pk_bf16(v1[0], v1[1]); w.w = cvt_pk_bf16(v1[2], v1[3]);
                    *(u32x4*)(rowp + bj * HALF) = w; } }
    }
};

struct EpiProj {
    static constexpr bool PERM = true, AFTER_DRAIN = false;
    bf16_t* P; float* MISC; const float* CS;
    __device__ __forceinline__ void operator()(const f32x4 (&acc)[2][2][4][2], const Unit& u, int wr, int wc, int fr, int fq) const {
        const int row0 = u.pm * BM + wr * 64 + fr; const int hb = u.pn * 4 + wc;
        constexpr unsigned long long ROPE_MASK = 0x00000007DFF333FFull;
        constexpr float QSCALE = 0.125f * 1.4426950408889634f;
        if (hb == 35) {
#pragma unroll
            for (int ai = 0; ai < 2; ++ai)
#pragma unroll
                for (int m = 0; m < 4; ++m) { float* mp = MISC + (size_t)(row0 + ai * HALF + m * 16) * 32 + 8 * fq; *(f32x4*)mp = acc[ai][0][m][0]; *(f32x4*)(mp + 4) = acc[ai][0][m][1]; }
        } else if ((ROPE_MASK >> hb) & 1ull) {
            const float sc = (hb < 8 || (hb >= 20 && hb < 28)) ? QSCALE : 1.0f;
#pragma unroll
            for (int am = 0; am < 4; ++am) {
                f32x4 cs[2][4];
#pragma unroll
                for (int mm = 0; mm < 2; ++mm) { const int ai = am >> 1, m = 2 * (am & 1) + mm; const float* cp = CS + (size_t)(row0 + ai * HALF + m * 16) * 64 + 16 * fq;
#pragma unroll
                    for (int k = 0; k < 4; ++k) cs[mm][k] = *(const f32x4*)(cp + 4 * k); }
#pragma unroll
                for (int mm = 0; mm < 2; ++mm) {
                    const int ai = am >> 1, m = 2 * (am & 1) + mm;
                    float o1[8], o2[8];
#pragma unroll
                    for (int i = 0; i < 8; ++i) { const float x1 = acc[ai][0][m][i >> 2][i & 3], x2 = acc[ai][1][m][i >> 2][i & 3];
                        const float c = cs[mm][i >> 1][2 * (i & 1)], sn = cs[mm][i >> 1][2 * (i & 1) + 1];
                        o1[i] = (x1 * c - x2 * sn) * sc; o2[i] = (x2 * c + x1 * sn) * sc; }
                    bf16_t* rp = P + (size_t)(row0 + ai * HALF + m * 16) * 2304 + hb * 64 + 8 * fq;
                    u32x4 a, b; a.x = cvt_pk_bf16(o1[0], o1[1]); a.y = cvt_pk_bf16(o1[2], o1[3]); a.z = cvt_pk_bf16(o1[4], o1[5]); a.w = cvt_pk_bf16(o1[6], o1[7]);
                    b.x = cvt_pk_bf16(o2[0], o2[1]); b.y = cvt_pk_bf16(o2[2], o2[3]); b.z = cvt_pk_bf16(o2[4], o2[5]); b.w = cvt_pk_bf16(o2[6], o2[7]);
                    __builtin_nontemporal_store(a, (u32x4*)rp); __builtin_nontemporal_store(b, (u32x4*)(rp + 32));
                }
            }
        } else {
#pragma unroll
            for (int ai = 0; ai < 2; ++ai)
#pragma unroll
                for (int m = 0; m < 4; ++m)
#pragma unroll
                    for (int bj = 0; bj < 2; ++bj) { const f32x4 v0 = acc[ai][bj][m][0], v1 = acc[ai][bj][m][1];
                        u32x4 w; w.x = cvt_pk_bf16(v0[0], v0[1]); w.y = cvt_pk_bf16(v0[2], v0[3]); w.z = cvt_pk_bf16(v1[0], v1[1]); w.w = cvt_pk_bf16(v1[2], v1[3]);
                        __builtin_nontemporal_store(w, (u32x4*)(P + (size_t)(row0 + ai * HALF + m * 16) * 2304 + hb * 64 + 32 * bj + 8 * fq)); }
        }
    }
};
template <class Epi, class Sched, bool ALIGN_EPI = false, bool SP2 = false>
__device__ __forceinline__ void gemm_phase(PG8_LAS unsigned char* lds, const Gemm g, const Sched& S, const Epi& E) {
    const int tid = threadIdx.x, wid = __builtin_amdgcn_readfirstlane(tid >> 6), lane = tid & 63, wr = wid >> 2, wc = wid & 3, fr = lane & 15, fq = lane >> 4;
    const int K = g.K, nt = K / BK;
    unsigned voffA[2], voffB[2];
#pragma unroll
    for (int i = 0; i < 2; ++i) { int R, C; stage_rc(tid * 16 + i * 8192, R, C); const int Rb = Epi::PERM ? ((R & ~31) + perm32(R & 31)) : R;
        voffA[i] = (unsigned)(R * K + C) * 2u; voffB[i] = (unsigned)(Rb * K + C) * 2u; }
    const size_t kstep = (size_t)(BK * 2);
    const size_t hstep = (size_t)HALF * K * 2;
    const size_t tstep = 2 * hstep;
    const unsigned ldsw = (unsigned)wid * 1024u;
    const int aoff = lds_byte(wr * 64 + fr, fq * 8), boff = lds_byte(wc * 32 + fr, fq * 8);
#define PG8_SA(b, h) (((b) * 2 + (h)) * HTB)
#define PG8_SB(b, h) ((4 + (b) * 2 + (h)) * HTB)
#define PG8_STAGE(bufoff, gbase, voff) do { _Pragma("unroll") for (int _i = 0; _i < 2; ++_i) \
        __builtin_amdgcn_global_load_lds((const unsigned*)((const char*)(gbase) + (voff)[_i]), (PG8_LAS unsigned*)(lds + (bufoff) + ldsw + _i * 8192), 16, 0, 0); } while (0)
#define PG8_LDA(dst, b, h) do { _Pragma("unroll") for (int m = 0; m < 4; ++m) _Pragma("unroll") for (int k = 0; k < 2; ++k) dst[m][k] = *(const PG8_LAS bf16x8*)(lds + PG8_SA(b, h) + aoff + m * 2048 + k * 1024); } while (0)
#define PG8_LDB(dst, b, h) do { _Pragma("unroll") for (int n = 0; n < 2; ++n) _Pragma("unroll") for (int k = 0; k < 2; ++k) dst[n][k] = *(const PG8_LAS bf16x8*)(lds + PG8_SB(b, h) + boff + n * 2048 + k * 1024); } while (0)
#define PG8_MMA(ai, bj, At, Bt) do { __builtin_amdgcn_s_setprio(1); _Pragma("unroll") for (int m = 0; m < 4; ++m) _Pragma("unroll") for (int n = 0; n < 2; ++n) _Pragma("unroll") for (int k = 0; k < 2; ++k) \
        acc[ai][bj][m][n] = __builtin_amdgcn_mfma_f32_16x16x32_bf16(Bt[n][k], At[m][k], acc[ai][bj][m][n], 0, 0, 0); __builtin_amdgcn_s_setprio(0); } while (0)
#define PG8_WAIT_V(n) asm volatile("s_waitcnt vmcnt(" #n ")" ::: "memory")
#define PG8_WAIT_L(n) asm volatile("s_waitcnt lgkmcnt(" #n ")" ::: "memory")
#define PG8_BAR __builtin_amdgcn_s_barrier()
#define PG8_SCHED __builtin_amdgcn_sched_barrier(0)
    Unit cur, nxt; int ui = 0;
    if (!S.next(0, cur)) return;
    f32x4 acc[2][2][4][2];
#pragma unroll
    for (int a = 0; a < 2; ++a)
#pragma unroll
        for (int b = 0; b < 2; ++b)
#pragma unroll
            for (int m = 0; m < 4; ++m)
#pragma unroll
                for (int n = 0; n < 2; ++n) acc[a][b][m][n] = (f32x4){0.f, 0.f, 0.f, 0.f};
    bf16x8 At[4][2], B0[2][2], B1[2][2];
    const char* cA = (const char*)g.A + (size_t)cur.pm * tstep; const char* cB = (const char*)g.Bt + (size_t)cur.pn * tstep;
    S.a_ready(cur);
    if constexpr (SP2) {
        PG8_STAGE(PG8_SB(0, 0), cB, voffB); PG8_STAGE(PG8_SB(0, 1), cB + hstep, voffB); PG8_STAGE(PG8_SA(0, 0), cA, voffA); PG8_STAGE(PG8_SA(0, 1), cA + hstep, voffA);
        if (wr == 1) PG8_BAR;
        PG8_WAIT_V(2); PG8_BAR;
        PG8_STAGE(PG8_SB(1, 0), cB + kstep, voffB); PG8_STAGE(PG8_SA(1, 0), cA + kstep, voffA); PG8_STAGE(PG8_SB(1, 1), cB + hstep + kstep, voffB);
        PG8_WAIT_V(6); PG8_BAR;
    } else {
        PG8_STAGE(PG8_SB(0, 0), cB, voffB); PG8_STAGE(PG8_SA(0, 0), cA, voffA); PG8_STAGE(PG8_SB(0, 1), cB + hstep, voffB); PG8_STAGE(PG8_SA(0, 1), cA + hstep, voffA);
        if (wr == 1) PG8_BAR;
        PG8_WAIT_V(4); PG8_BAR;
        PG8_STAGE(PG8_SB(1, 0), cB + kstep, voffB); PG8_STAGE(PG8_SA(1, 0), cA + kstep, voffA); PG8_STAGE(PG8_SB(1, 1), cB + hstep + kstep, voffB);
        PG8_WAIT_V(6); PG8_BAR;
    }
    for (;;) {
        const bool has_next = S.next(ui + 1, nxt);
        const char* nA = has_next ? (const char*)g.A + (size_t)nxt.pm * tstep : cA; const char* nB = has_next ? (const char*)g.Bt + (size_t)nxt.pn * tstep : cB;
        for (int t = 0; t < nt; t += 2) {
            const bool last = (t == nt - 2);
            const char* a1 = cA + (size_t)(t + 1) * kstep;
            const char* a2 = last ? nA : cA + (size_t)(t + 2) * kstep; const char* b2 = last ? nB : cB + (size_t)(t + 2) * kstep;
            const char* a3 = a2 + kstep; const char* b3 = b2 + kstep;
            if (last && has_next) S.a_ready(nxt);
            if constexpr (SP2) {
            PG8_LDB(B0, 0, 0); PG8_LDB(B1, 0, 1); PG8_SCHED; PG8_LDA(At, 0, 0); PG8_STAGE(PG8_SA(1, 1), a1 + hstep, voffA);
            PG8_WAIT_V(8); PG8_WAIT_L(0); PG8_BAR; PG8_MMA(0, 0, At, B0); PG8_MMA(0, 1, At, B1); PG8_BAR; PG8_SCHED;
            PG8_LDA(At, 0, 1); PG8_STAGE(PG8_SB(0, 0), b2, voffB); PG8_STAGE(PG8_SB(0, 1), b2 + hstep, voffB); PG8_STAGE(PG8_SA(0, 0), a2, voffA);
            PG8_WAIT_V(8); PG8_WAIT_L(0); PG8_BAR; PG8_MMA(1, 0, At, B0); PG8_MMA(1, 1, At, B1); PG8_BAR; PG8_SCHED;
            PG8_LDB(B0, 1, 0); PG8_LDB(B1, 1, 1); PG8_SCHED; PG8_LDA(At, 1, 0); PG8_STAGE(PG8_SA(0, 1), a2 + hstep, voffA);
            PG8_WAIT_V(8); PG8_WAIT_L(0); PG8_BAR; PG8_MMA(0, 0, At, B0); PG8_MMA(0, 1, At, B1); PG8_BAR; PG8_SCHED;
            PG8_LDA(At, 1, 1); PG8_STAGE(PG8_SB(1, 0), b3, voffB); PG8_STAGE(PG8_SB(1, 1), b3 + hstep, voffB); PG8_STAGE(PG8_SA(1, 0), a3, voffA);
            PG8_WAIT_V(8); PG8_WAIT_L(0); PG8_BAR; PG8_MMA(1, 0, At, B0); PG8_MMA(1, 1, At, B1); PG8_BAR; PG8_SCHED;
            } else {
            PG8_LDB(B0, 0, 0); PG8_SCHED; PG8_LDA(At, 0, 0); PG8_STAGE(PG8_SA(1, 1), a1 + hstep, voffA);
            PG8_WAIT_L(8); PG8_BAR; PG8_WAIT_L(0); PG8_MMA(0, 0, At, B0); PG8_BAR; PG8_SCHED;
            PG8_LDB(B1, 0, 1); PG8_STAGE(PG8_SB(0, 0), b2, voffB);
            PG8_BAR; PG8_WAIT_L(0); PG8_MMA(0, 1, At, B1); PG8_BAR;
            PG8_LDA(At, 0, 1); PG8_STAGE(PG8_SA(0, 0), a2, voffA);
            PG8_BAR; PG8_WAIT_L(0); PG8_MMA(1, 0, At, B0); PG8_BAR; PG8_SCHED;
            PG8_STAGE(PG8_SB(0, 1), b2 + hstep, voffB);
            PG8_WAIT_V(6); PG8_BAR; PG8_MMA(1, 1, At, B1); PG8_BAR;
            PG8_LDB(B0, 1, 0); PG8_SCHED; PG8_LDA(At, 1, 0); PG8_STAGE(PG8_SA(0, 1), a2 + hstep, voffA);
            PG8_WAIT_L(8); PG8_BAR; PG8_WAIT_L(0); PG8_MMA(0, 0, At, B0); PG8_BAR; PG8_SCHED;
            PG8_LDB(B1, 1, 1); PG8_STAGE(PG8_SB(1, 0), b3, voffB);
            PG8_BAR; PG8_WAIT_L(0); PG8_MMA(0, 1, At, B1); PG8_BAR;
            PG8_LDA(At, 1, 1); PG8_STAGE(PG8_SA(1, 0), a3, voffA);
            PG8_BAR; PG8_WAIT_L(0); PG8_MMA(1, 0, At, B0); PG8_BAR; PG8_SCHED;
            PG8_STAGE(PG8_SB(1, 1), b3 + hstep, voffB);
            PG8_WAIT_V(6); PG8_BAR; PG8_MMA(1, 1, At, B1); PG8_BAR;
            }
        }
        if constexpr (ALIGN_EPI) { if (wr == 0) PG8_BAR; }
        if constexpr (!Epi::AFTER_DRAIN) { E(acc, cur, wr, wc, fr, fq); S.done(cur); }
        if (!has_next) break;
#pragma unroll
        for (int a = 0; a < 2; ++a)
#pragma unroll
            for (int b = 0; b < 2; ++b)
#pragma unroll
                for (int m = 0; m < 4; ++m)
#pragma unroll
                    for (int n = 0; n < 2; ++n) acc[a][b][m][n] = (f32x4){0.f, 0.f, 0.f, 0.f};
        cur = nxt; cA = nA; cB = nB; ++ui;
        if constexpr (ALIGN_EPI) { if (wr == 1) PG8_BAR; }
    }
    PG8_WAIT_V(0);
    if constexpr (!ALIGN_EPI) { if (wr == 0) PG8_BAR; }
    PG8_BAR;
    if constexpr (Epi::AFTER_DRAIN) { E.fused(acc, cur, wr, wc, fr, fq, lds, wid, lane); S.done(cur); }
#undef PG8_SA
#undef PG8_SB
#undef PG8_STAGE
#undef PG8_LDA
#undef PG8_LDB
#undef PG8_MMA
#undef PG8_WAIT_V
#undef PG8_WAIT_L
#undef PG8_BAR
#undef PG8_SCHED
}
typedef int i32x8 __attribute__((ext_vector_type(8)));
template <class Epi, class Sched, bool ALIGN_EPI = false, bool SP2 = false>
__device__ __forceinline__ void gemm_phase_f8(PG8_LAS unsigned char* lds, const Gemm g, const Sched& S, const Epi& E) {
    const int tid = threadIdx.x, wid = __builtin_amdgcn_readfirstlane(tid >> 6), lane = tid & 63, wr = wid >> 2, wc = wid & 3, fr = lane & 15, fq = lane >> 4;
    const int K = g.K, nt = K / BK;
    unsigned voffA[2], voffB[2];
#pragma unroll
    for (int i = 0; i < 2; ++i) { int R, C; stage_rc(tid * 16 + i * 8192, R, C); const int Rb = Epi::PERM ? ((R & ~31) + perm32(R & 31)) : R;
        voffA[i] = (unsigned)(R * K + C) * 2u; voffB[i] = (unsigned)(Rb * K + C) * 2u; }
    const size_t kstep = (size_t)(BK * 2);
    const size_t hstep = (size_t)HALF * K * 2;
    const size_t tstep = 2 * hstep;
    const unsigned ldsw = (unsigned)wid * 1024u;
    const int aoff = lds_byte(wr * 64 + fr, fq * 16), boff = lds_byte(wc * 32 + fr, fq * 16);
#define PG8_SA(b, h) (((b) * 2 + (h)) * HTB)
#define PG8_SB(b, h) ((4 + (b) * 2 + (h)) * HTB)
#define PG8_STAGE(bufoff, gbase, voff) do { _Pragma("unroll") for (int _i = 0; _i < 2; ++_i) \
        __builtin_amdgcn_global_load_lds((const unsigned*)((const char*)(gbase) + (voff)[_i]), (PG8_LAS unsigned*)(lds + (bufoff) + ldsw + _i * 8192), 16, 0, 0); } while (0)
#define PG8_LDA(dst, b, h) do { _Pragma("unroll") for (int m = 0; m < 4; ++m) dst[m] = *(const PG8_LAS i32x8*)(lds + PG8_SA(b, h) + aoff + m * 2048); } while (0)
#define PG8_LDB(dst, b, h) do { _Pragma("unroll") for (int n = 0; n < 2; ++n) dst[n] = *(const PG8_LAS i32x8*)(lds + PG8_SB(b, h) + boff + n * 2048); } while (0)
#define PG8_MMA(ai, bj, At, Bt) do { __builtin_amdgcn_s_setprio(1); _Pragma("unroll") for (int m = 0; m < 4; ++m) _Pragma("unroll") for (int n = 0; n < 2; ++n) \
        asm volatile("v_mfma_scale_f32_16x16x128_f8f6f4 %0, %1, %2, %0, %3, %3 op_sel_hi:[0,0,0]" : "+v"(acc[ai][bj][m][n]) : "v"(Bt[n]), "v"(At[m]), "v"(f8scale)); __builtin_amdgcn_s_setprio(0); } while (0)
#define PG8_WAIT_V(n) asm volatile("s_waitcnt vmcnt(" #n ")" ::: "memory")
#define PG8_WAIT_L(n) asm volatile("s_waitcnt lgkmcnt(" #n ")" ::: "memory")
#define PG8_BAR __builtin_amdgcn_s_barrier()
#define PG8_SCHED __builtin_amdgcn_sched_barrier(0)
    Unit cur, nxt; int ui = 0;
    if (!S.next(0, cur)) return;
    f32x4 acc[2][2][4][2];
#pragma unroll
    for (int a = 0; a < 2; ++a)
#pragma unroll
        for (int b = 0; b < 2; ++b)
#pragma unroll
            for (int m = 0; m < 4; ++m)
#pragma unroll
                for (int n = 0; n < 2; ++n) acc[a][b][m][n] = (f32x4){0.f, 0.f, 0.f, 0.f};
    i32x8 At[4], B0[2], B1[2];
    const int f8scale = 0x7F7F7F7F;
    const char* cA = (const char*)g.A + (size_t)cur.pm * tstep; const char* cB = (const char*)g.Bt + (size_t)cur.pn * tstep;
    S.a_ready(cur);
    if constexpr (SP2) {
        PG8_STAGE(PG8_SB(0, 0), cB, voffB); PG8_STAGE(PG8_SB(0, 1), cB + hstep, voffB); PG8_STAGE(PG8_SA(0, 0), cA, voffA); PG8_STAGE(PG8_SA(0, 1), cA + hstep, voffA);
        if (wr == 1) PG8_BAR;
        PG8_WAIT_V(2); PG8_BAR;
        PG8_STAGE(PG8_SB(1, 0), cB + kstep, voffB); PG8_STAGE(PG8_SA(1, 0), cA + kstep, voffA); PG8_STAGE(PG8_SB(1, 1), cB + hstep + kstep, voffB);
        PG8_WAIT_V(6); PG8_BAR;
    } else {
        PG8_STAGE(PG8_SB(0, 0), cB, voffB); PG8_STAGE(PG8_SA(0, 0), cA, voffA); PG8_STAGE(PG8_SB(0, 1), cB + hstep, voffB); PG8_STAGE(PG8_SA(0, 1), cA + hstep, voffA);
        if (wr == 1) PG8_BAR;
        PG8_WAIT_V(4); PG8_BAR;
        PG8_STAGE(PG8_SB(1, 0), cB + kstep, voffB); PG8_STAGE(PG8_SA(1, 0), cA + kstep, voffA); PG8_STAGE(PG8_SB(1, 1), cB + hstep + kstep, voffB);
        PG8_WAIT_V(6); PG8_BAR;
    }
    for (;;) {
        const bool has_next = S.next(ui + 1, nxt);
        const char* nA = has_next ? (const char*)g.A + (size_t)nxt.pm * tstep : cA; const char* nB = has_next ? (const char*)g.Bt + (size_t)nxt.pn * tstep : cB;
        for (int t = 0; t < nt; t += 2) {
            const bool last = (t == nt - 2);
            const char* a1 = cA + (size_t)(t + 1) * kstep;
            const char* a2 = last ? nA : cA + (size_t)(t + 2) * kstep; const char* b2 = last ? nB : cB + (size_t)(t + 2) * kstep;
            const char* a3 = a2 + kstep; const char* b3 = b2 + kstep;
            if (last && has_next) S.a_ready(nxt);
            if constexpr (SP2) {
            PG8_LDB(B0, 0, 0); PG8_LDB(B1, 0, 1); PG8_SCHED; PG8_LDA(At, 0, 0); PG8_STAGE(PG8_SA(1, 1), a1 + hstep, voffA);
            PG8_WAIT_V(8); PG8_WAIT_L(0); PG8_BAR; PG8_MMA(0, 0, At, B0); PG8_MMA(0, 1, At, B1); PG8_BAR; PG8_SCHED;
            PG8_LDA(At, 0, 1); PG8_STAGE(PG8_SB(0, 0), b2, voffB); PG8_STAGE(PG8_SB(0, 1), b2 + hstep, voffB); PG8_STAGE(PG8_SA(0, 0), a2, voffA);
            PG8_WAIT_V(8); PG8_WAIT_L(0); PG8_BAR; PG8_MMA(1, 0, At, B0); PG8_MMA(1, 1, At, B1); PG8_BAR; PG8_SCHED;
            PG8_LDB(B0, 1, 0); PG8_LDB(B1, 1, 1); PG8_SCHED; PG8_LDA(At, 1, 0); PG8_STAGE(PG8_SA(0, 1), a2 + hstep, voffA);
            PG8_WAIT_V(8); PG8_WAIT_L(0); PG8_BAR; PG8_MMA(0, 0, At, B0); PG8_MMA(0, 1, At, B1); PG8_BAR; PG8_SCHED;
            PG8_LDA(At, 1, 1); PG8_STAGE(PG8_SB(1, 0), b3, voffB); PG8_STAGE(PG8_SB(1, 1), b3 + hstep, voffB); PG8_STAGE(PG8_SA(1, 0), a3, voffA);
            PG8_WAIT_V(8); PG8_WAIT_L(0); PG8_BAR; PG8_MMA(1, 0, At, B0); PG8_MMA(1, 1, At, B1); PG8_BAR; PG8_SCHED;
            } else {
            PG8_LDB(B0, 0, 0); PG8_SCHED; PG8_LDA(At, 0, 0); PG8_STAGE(PG8_SA(1, 1), a1 + hstep, voffA);
            PG8_WAIT_L(8); PG8_BAR; PG8_WAIT_L(0); PG8_MMA(0, 0, At, B0); PG8_BAR; PG8_SCHED;
            PG8_LDB(B1, 0, 1); PG8_STAGE(PG8_SB(0, 0), b2, voffB);
            PG8_BAR; PG8_WAIT_L(0); PG8_MMA(0, 1, At, B1); PG8_BAR;
            PG8_LDA(At, 0, 1); PG8_STAGE(PG8_SA(0, 0), a2, voffA);
            PG8_BAR; PG8_WAIT_L(0); PG8_MMA(1, 0, At, B0); PG8_BAR; PG8_SCHED;
            PG8_STAGE(PG8_SB(0, 1), b2 + hstep, voffB);
            PG8_WAIT_V(6); PG8_BAR; PG8_MMA(1, 1, At, B1); PG8_BAR;
            PG8_LDB(B0, 1, 0); PG8_SCHED; PG8_LDA(At, 1, 0); PG8_STAGE(PG8_SA(0, 1), a2 + hstep, voffA);
            PG8_WAIT_L(8); PG8_BAR; PG8_WAIT_L(0); PG8_MMA(0, 0, At, B0); PG8_BAR; PG8_SCHED;
            PG8_LDB(B1, 1, 1); PG8_STAGE(PG8_SB(1, 0), b3, voffB);
            PG8_BAR; PG8_WAIT_L(0); PG8_MMA(0, 1, At, B1); PG8_BAR;
            PG8_LDA(At, 1, 1); PG8_STAGE(PG8_SA(1, 0), a3, voffA);
            PG8_BAR; PG8_WAIT_L(0); PG8_MMA(1, 0, At, B0); PG8_BAR; PG8_SCHED;
            PG8_STAGE(PG8_SB(1, 1), b3 + hstep, voffB);
            PG8_WAIT_V(6); PG8_BAR; PG8_MMA(1, 1, At, B1); PG8_BAR;
            }
        }
        asm volatile("s_nop 15\n\ts_nop 15" ::: "memory");
        if constexpr (ALIGN_EPI) { if (wr == 0) PG8_BAR; }
        if constexpr (!Epi::AFTER_DRAIN) { E(acc, cur, wr, wc, fr, fq); S.done(cur); }
        if (!has_next) break;
#pragma unroll
        for (int a = 0; a < 2; ++a)
#pragma unroll
            for (int b = 0; b < 2; ++b)
#pragma unroll
                for (int m = 0; m < 4; ++m)
#pragma unroll
                    for (int n = 0; n < 2; ++n) acc[a][b][m][n] = (f32x4){0.f, 0.f, 0.f, 0.f};
        cur = nxt; cA = nA; cB = nB; ++ui;
        if constexpr (ALIGN_EPI) { if (wr == 1) PG8_BAR; }
    }
    PG8_WAIT_V(0);
    if constexpr (!ALIGN_EPI) { if (wr == 0) PG8_BAR; }
    PG8_BAR;
    if constexpr (Epi::AFTER_DRAIN) { E.fused(acc, cur, wr, wc, fr, fq, lds, wid, lane); S.done(cur); }
#undef PG8_SA
#undef PG8_SB
#undef PG8_STAGE
#undef PG8_LDA
#undef PG8_LDB
#undef PG8_MMA
#undef PG8_WAIT_V
#undef PG8_WAIT_L
#undef PG8_BAR
#undef PG8_SCHED
}

}

constexpr int NB = 32, T = 2048, D = 1024, M = NB * T, FF = 4096, NPROJ = 2304, PP = NPROJ;
constexpr int HB_QN = 0, HB_KC = 8, HB_VC = 10, HB_KSL = 12, HB_VSL = 14, HB_KW = 16, HB_VW = 18, HB_QD = 20, HB_KD = 28, HB_VD = 29, HB_QI = 30, HB_KI = 34, HB_MISC = 35;
constexpr int NWAVES = 8, NTHR = 512;
constexpr float RMS_EPS = 1e-6f;

constexpr size_t MiB = 1u << 20;
constexpr size_t WS_CTL = 0, CTL_ZERO_BYTES = 64 * 1024;
constexpr size_t WS_MOD = 1 * MiB;
constexpr size_t WS_BIASC = 1 * MiB + 800 * 1024;
constexpr size_t WS_CS = 2 * MiB;
constexpr size_t WS_WIN = 18 * MiB;
constexpr size_t WS_WOUT = 23 * MiB;
constexpr size_t WS_WUP = 25 * MiB;
constexpr size_t WS_WDOWN = 33 * MiB;
constexpr size_t WS_W1K = 41 * MiB, WS_W1V = 41 * MiB + 512 * 1024;
constexpr size_t WS_W2K = 42 * MiB, WS_W2V = 42 * MiB + 64 * 1024;
constexpr size_t WS_KCMP = 43 * MiB, WS_VCMP = 44 * MiB;
constexpr size_t WS_MISC = 45 * MiB;
constexpr size_t WS_X2B = 192 * MiB + 128 * MiB;
constexpr size_t WS_XN = 64 * MiB;
constexpr size_t WS_P = 192 * MiB;
constexpr size_t WS_SC = 480 * MiB;
constexpr size_t WS_END = 992 * MiB;
constexpr int SC_TILES_PER_B = 528;

constexpr int RING_BYTES = 131072;
constexpr int MISC_OFF = RING_BYTES + 320;
constexpr int LDS_BYTES = 161792;

#define LAS __attribute__((address_space(3)))
typedef unsigned short bf16;
typedef short bf16x8 __attribute__((ext_vector_type(8)));
typedef short s16x4 __attribute__((ext_vector_type(4)));
typedef float f32x2 __attribute__((ext_vector_type(2)));
typedef float f32x4 __attribute__((ext_vector_type(4)));
typedef float f32x16 __attribute__((ext_vector_type(16)));
typedef unsigned u32x4 __attribute__((ext_vector_type(4)));
typedef unsigned u32x2 __attribute__((ext_vector_type(2)));
typedef unsigned long long u64;
#define MFMA32(a, b, c) __builtin_amdgcn_mfma_f32_32x32x16_bf16((a), (b), (c), 0, 0, 0)
#define LDS_WAIT() asm volatile("s_waitcnt lgkmcnt(0)" ::: "memory")

DI unsigned pk2(float lo, float hi) { return pg8::cvt_pk_bf16(lo, hi); }
DI float bf2f(unsigned short v) { return __uint_as_float((unsigned)v << 16); }
DI int crow(int r, int hi) { return (r & 3) + 8 * (r >> 2) + 4 * hi; }
DI float wave_sum(float v) {
#pragma unroll
    for (int o = 1; o < 64; o <<= 1) v += __shfl_xor(v, o);
    return v;
}
DI int launder(int x) { asm volatile("" : "+v"(x)); return x; }
DI float fast_exp2(float x) { return __builtin_amdgcn_exp2f(x); }
DI float gelu_tanh(float x) {
    const float u = 0.7978845608028654f * (x + 0.044715f * x * x * x);
    const float e = __expf(2.0f * u);
    const float th = 1.0f - 2.0f / (e + 1.0f);
    return 0.5f * x * (1.0f + th);
}

struct Frame {
    LAS unsigned char* lds;
    volatile LAS unsigned* MISC;
    unsigned char* ws;
    int tid, lane, wave, G, bid;
    unsigned long long pacc;
};
#ifndef PROBE_SEC
#define PROBE_SEC 0
#endif
__device__ __forceinline__ unsigned long long probe_clock() { unsigned long long t; asm volatile("s_memrealtime %0\n\ts_waitcnt lgkmcnt(0)" : "=s"(t) :: "memory"); return t; }
#define SEC_BEGIN(k) unsigned long long _ps##k = 0; if (PROBE_SEC == (k)) _ps##k = probe_clock()
#define SEC_END(k) do { if (PROBE_SEC == (k)) F.pacc += probe_clock() - _ps##k; } while (0)
struct Args { const void* in[19]; float* out; unsigned char* ws; int ph_lo, ph_hi, coop, pad; };
#define WSP(type, off) ((type*)(F.ws + (off)))
#define INP(type, i) ((const type*)A.in[i])

DI unsigned xcc_id() { return (unsigned)__builtin_amdgcn_s_getreg((3 << 11) | 20) & 7u; }
DI int q_next(Frame& F, unsigned* ctr, int per_queue) {
    __syncthreads();
    if (F.tid == 0) {
        const unsigned own = xcc_id();
        int res = -1;
        for (unsigned k = 0; k < 8; ++k) {
            const unsigned q = (own + k) & 7u;
            if (k > 0 && __hip_atomic_load(ctr + 64 * q, __ATOMIC_RELAXED, __HIP_MEMORY_SCOPE_AGENT) >= (unsigned)per_queue) continue;
            const unsigned it = __hip_atomic_fetch_add(ctr + 64 * q, 1u, __ATOMIC_RELAXED, __HIP_MEMORY_SCOPE_AGENT);
            if (it < (unsigned)per_queue) { res = (int)(q * 65536u + it); break; }
        }
        F.MISC[0] = (unsigned)res;
    }
    __syncthreads();
    return (int)F.MISC[0];
}

DI int proj_src_col(int n) {
    const int pn = n >> 8, c = n & 255, hb = 4 * pn + ((c >> 5) & 3), p = 32 * (c >> 7) + (c & 31);
    if (hb == 35) return p < 24 ? 1280 + p : (p < 28 ? 2264 + (p - 24) : -1);
    const int base = hb < 20 ? 64 * hb : 1304 + 64 * (hb - 20);
    return base + p;
}
template <bool PERMUTE> DI void transpose_item(const float* W, int ldw, int K, int N, bf16* WT, LAS float* scr, int item, int lane) {
    const int nblk = N / 32, kb = item / nblk, nb = item % nblk, k0 = 64 * kb, n0 = 32 * nb;
    const int ncol = n0 + (lane & 31); const int src = PERMUTE ? proj_src_col(ncol) : ncol;
    float tv[32];
    const int srcc = src >= 0 ? src : 0;
#pragma unroll
    for (int i = 0; i < 32; ++i) { const int kk = 2 * i + (lane >> 5); tv[i] = W[(size_t)(k0 + kk) * ldw + srcc]; }
#pragma unroll
    for (int i = 0; i < 32; ++i) { const int kk = 2 * i + (lane >> 5); scr[kk * 33 + (lane & 31)] = src >= 0 ? tv[i] : 0.f; }
    LDS_WAIT();
    const int cch = lane & 7;
#pragma unroll
    for (int j = 0; j < 4; ++j) { const int n = (lane >> 3) + 8 * j; const LAS float* s = scr + (8 * cch) * 33 + n;
        u32x4 o; o.x = pk2(s[0 * 33], s[1 * 33]); o.y = pk2(s[2 * 33], s[3 * 33]); o.z = pk2(s[4 * 33], s[5 * 33]); o.w = pk2(s[6 * 33], s[7 * 33]);
        *(u32x4*)(WT + (size_t)(n0 + n) * K + k0 + 8 * cch) = o; }
    LDS_WAIT();
}
DI int perm16_src_col(int n) { const int c = n & 255; return (n & ~255) + 16 * (4 * ((c >> 5) & 3) + ((c >> 3) & 3)) + 8 * (c >> 7) + (c & 7); }
template <bool PERM16 = false>
DI void transpose_item_f8(const float* W, int ldw, int K, int N, unsigned char* WT, LAS float* scr, int item, int lane, float scale) {
    const int nblk = N / 32, kb = item / nblk, nb = item % nblk, k0 = 64 * kb, n0 = 32 * nb;
    const int ncol = PERM16 ? perm16_src_col(n0 + (lane & 31)) : n0 + (lane & 31);
    float tv[32];
#pragma unroll
    for (int i = 0; i < 32; ++i) { const int kk = 2 * i + (lane >> 5); tv[i] = __builtin_nontemporal_load(&W[(size_t)(k0 + kk) * ldw + ncol]); }
#pragma unroll
    for (int i = 0; i < 32; ++i) { const int kk = 2 * i + (lane >> 5); scr[kk * 33 + (lane & 31)] = fminf(fmaxf(tv[i] * scale, -448.f), 448.f); }
    LDS_WAIT();
    const int cch = lane & 7;
#pragma unroll
    for (int j = 0; j < 4; ++j) { const int n = (lane >> 3) + 8 * j; const LAS float* sp = scr + (8 * cch) * 33 + n;
        u32x2 o;
        o.x = (unsigned)__builtin_amdgcn_cvt_pk_fp8_f32(sp[0 * 33], sp[1 * 33], 0, false); o.x = (unsigned)__builtin_amdgcn_cvt_pk_fp8_f32(sp[2 * 33], sp[3 * 33], (int)o.x, true);
        o.y = (unsigned)__builtin_amdgcn_cvt_pk_fp8_f32(sp[4 * 33], sp[5 * 33], 0, false); o.y = (unsigned)__builtin_amdgcn_cvt_pk_fp8_f32(sp[6 * 33], sp[7 * 33], (int)o.y, true);
        *(u32x2*)(WT + (size_t)(n0 + n) * K + k0 + 8 * cch) = o; }
    LDS_WAIT();
}
DI void phase_p0(Frame& F, const Args& A) {
    const int gt = F.bid * NTHR + F.tid, NGT = F.G * NTHR;
    if (F.G >= 256 && F.bid >= 192 && F.bid < 256) {
        const int o = (F.bid - 192) * 4 + (F.wave >> 1), kv = o >> 7, j = o & 127, kh = F.wave & 1;
        const float* pe = kv ? INP(float, 11) : INP(float, 10); const float* w1 = kv ? INP(float, 14) : INP(float, 12);
        float p = 0.f;
#pragma unroll
        for (int i = 0; i < 16; ++i) { const int k = 1024 * kh + F.lane + 64 * i; p = fmaf(pe[k], w1[(size_t)k * 128 + j], p); }
        p = wave_sum(p);
        LAS float* red = (LAS float*)F.lds;
        if (F.lane == 0) red[F.wave] = p;
        __syncthreads();
        if (F.tid < 4) WSP(float, WS_BIASC)[(F.bid - 192) * 4 + F.tid] = red[2 * F.tid] + red[2 * F.tid + 1];
        __syncthreads();
    }
    for (int it = F.bid; it < (6 * D) / 32; it += F.G) {
        LAS float* cl = (LAS float*)(F.lds + (F.wave < 7 ? F.wave * 18432 : 131584));
        static_assert(7 * 18432 <= MISC_OFF && 131584 >= MISC_OFF + 128 && 131584 + 18432 <= LDS_BYTES, "P0 LDS map");
        const int k0 = 128 * F.wave;
        const int n = F.lane & 31, bh = F.lane >> 5;
        const float* wp = INP(float, 3) + (size_t)k0 * (6 * D) + it * 32 + n;
        float wv[128];
#pragma unroll
        for (int u = 0; u < 128; ++u) wv[u] = __builtin_nontemporal_load(&wp[(size_t)u * (6 * D)]);
#pragma unroll 16
        for (int e = F.lane; e < 128 * 32; e += 64) { const int kk = e & 127, bb = e >> 7; cl[kk * 36 + bb] = INP(float, 1)[bb * D + k0 + kk]; }
        LDS_WAIT();
        float acc[16];
#pragma unroll
        for (int i = 0; i < 16; ++i) acc[i] = 0.f;
        {
#pragma unroll
          for (int u = 0; u < 128; ++u) {
            const int kk = u; const float w = wv[u];
            const LAS f32x4* cr = (const LAS f32x4*)(cl + kk * 36 + 16 * bh);
            const f32x4 c0 = cr[0], c1 = cr[1], c2 = cr[2], c3 = cr[3];
#pragma unroll
            for (int i = 0; i < 4; ++i) { acc[i] = fmaf(c0[i], w, acc[i]); acc[4 + i] = fmaf(c1[i], w, acc[4 + i]); acc[8 + i] = fmaf(c2[i], w, acc[8 + i]); acc[12 + i] = fmaf(c3[i], w, acc[12 + i]); }
          }
        }
        __syncthreads();
        LAS float* pr = (LAS float*)F.lds + F.wave * 1024;
#pragma unroll
        for (int i = 0; i < 16; ++i) pr[(16 * bh + i) * 32 + n] = acc[i];
        __syncthreads();
        for (int e = F.tid; e < 1024; e += NTHR) {
            const LAS float* q = (const LAS float*)F.lds + e;
            const float sum = ((q[0] + q[1024]) + (q[2048] + q[3072])) + ((q[4096] + q[5120]) + (q[6144] + q[7168]));
            const int bb = e >> 5, nn = e & 31;
            WSP(float, WS_MOD)[(size_t)bb * (6 * D) + it * 32 + nn] = INP(float, 4)[it * 32 + nn] + sum;
        }
        __syncthreads();
    }
}

DI void prep_weights_rope(Frame& F, const Args& A) {
    LAS float* scr = (LAS float*)(F.lds + F.wave * 16384);
    const int gw = F.bid * NWAVES + F.wave, NGW = F.G * NWAVES;
    constexpr int I_IN = (D / 64) * (NPROJ / 32), I_OUT = (D / 64) * (D / 32), I_UP = (D / 64) * (FF / 32), I_DN = (FF / 64) * (D / 32), I_W1 = (2048 / 64) * (128 / 32), I_W2 = (128 / 64) * (64 / 32);
    constexpr int NITEMS = I_IN + I_OUT + I_UP + I_DN + 2 * I_W1 + 2 * I_W2;
    for (int it = gw; it < NITEMS; it += NGW) {
        int r = it;
        if (r < I_IN) { transpose_item<true>(INP(float, 9), 2268, D, NPROJ, WSP(bf16, WS_WIN), scr, r, F.lane); continue; } r -= I_IN;
        if (r < I_OUT) { transpose_item_f8(INP(float, 16), D, D, D, WSP(unsigned char, WS_WOUT), scr, r, F.lane, 128.0f); continue; } r -= I_OUT;
        if (r < I_UP) { transpose_item_f8<true>(INP(float, 17), FF, D, FF, WSP(unsigned char, WS_WUP), scr, r, F.lane, 128.0f); continue; } r -= I_UP;
        if (r < I_DN) { transpose_item_f8(INP(float, 18), D, FF, D, WSP(unsigned char, WS_WDOWN), scr, r, F.lane, 256.0f); continue; } r -= I_DN;
        if (r < I_W1) { transpose_item<false>(INP(float, 12), 128, 2048, 128, WSP(bf16, WS_W1K), scr, r, F.lane); continue; } r -= I_W1;
        if (r < I_W1) { transpose_item<false>(INP(float, 14), 128, 2048, 128, WSP(bf16, WS_W1V), scr, r, F.lane); continue; } r -= I_W1;
        if (r < I_W2) { transpose_item<false>(INP(float, 13), 64, 128, 64, WSP(bf16, WS_W2K), scr, r, F.lane); continue; } r -= I_W2;
        transpose_item<false>(INP(float, 15), 64, 128, 64, WSP(bf16, WS_W2V), scr, r, F.lane);
    }
    const int gt = F.bid * NTHR + F.tid, NGT = F.G * NTHR;
    for (int idx = gt; idx < M * 32; idx += NGT) {
        const int m = idx >> 5, d = idx & 31;
        const float inv = exp2f(-(float)d * (13.287712379549449f / 32.0f));
        const float ang = (float)INP(int, 2)[m] * inv;
        const float k = rintf(ang * 0.15915494309189535f);
        float r = fmaf(-k, 6.2831854820251465f, ang);
        r = fmaf(-k, -1.7484555e-7f, r);
        const float rev = r * 0.15915494309189535f;
        *(f32x2*)(WSP(float, WS_CS) + 2 * (size_t)idx) = (f32x2){__builtin_amdgcn_cosf(rev), __builtin_amdgcn_sinf(rev)};
    }
}

DI unsigned pk4_f8(f32x4 v) {
    v.x = fminf(fmaxf(v.x, -448.f), 448.f); v.y = fminf(fmaxf(v.y, -448.f), 448.f); v.z = fminf(fmaxf(v.z, -448.f), 448.f); v.w = fminf(fmaxf(v.w, -448.f), 448.f);
    int w = __builtin_amdgcn_cvt_pk_fp8_f32(v.x, v.y, 0, false); w = __builtin_amdgcn_cvt_pk_fp8_f32(v.z, v.w, w, true); return (unsigned)w; }
DI float sumsq4(const f32x4 (&v)[4]) { float s = 0.f;
#pragma unroll
    for (int j = 0; j < 4; ++j) s += (v[j].x * v[j].x + v[j].y * v[j].y) + (v[j].z * v[j].z + v[j].w * v[j].w);
    return s; }
DI void unpack_bf16x4(f32x4& o, u64 w) { o.x = bf2f((unsigned short)w); o.y = bf2f((unsigned short)(w >> 16)); o.z = bf2f((unsigned short)(w >> 32)); o.w = bf2f((unsigned short)(w >> 48)); }
DI void phase_e0(Frame& F, const Args& A) {
    const int gw = F.bid * NWAVES + F.wave, NGW = F.G * NWAVES;
    for (int r0 = gw * 32; r0 < M; r0 += NGW * 32) {
        const int b = r0 / T;
        const float* mod = WSP(float, WS_MOD) + (size_t)b * 6 * D;
        f32x4 ga[4], sh[4];
#pragma unroll
        for (int j = 0; j < 4; ++j) { const int col = 4 * F.lane + 256 * j;
            ga[j] = *(const f32x4*)(INP(float, 5) + col) * (*(const f32x4*)(mod + D + col) + 1.0f); sh[j] = *(const f32x4*)(mod + col); }
        f32x4 vn[4][4];
        {   const f32x4* xa = (const f32x4*)(INP(float, 0) + (size_t)r0 * D) + F.lane;
#pragma unroll
            for (int r = 0; r < 4; ++r)
#pragma unroll
                for (int j = 0; j < 4; ++j) vn[r][j] = __builtin_nontemporal_load(&xa[r * (D / 4) + 64 * j]); }
#pragma unroll 1
        for (int m = r0; m < r0 + 32; m += 4) {
            f32x4 v[4][4];
#pragma unroll
            for (int r = 0; r < 4; ++r)
#pragma unroll
                for (int j = 0; j < 4; ++j) v[r][j] = vn[r][j];
            if (m + 4 < r0 + 32) {
                const f32x4* xa = (const f32x4*)(INP(float, 0) + (size_t)(m + 4) * D) + F.lane;
#pragma unroll
                for (int r = 0; r < 4; ++r)
#pragma unroll
                    for (int j = 0; j < 4; ++j) vn[r][j] = __builtin_nontemporal_load(&xa[r * (D / 4) + 64 * j]);
            }
            u64* oa = (u64*)(WSP(bf16, WS_XN) + (size_t)m * D) + F.lane;
#pragma unroll
            for (int r = 0; r < 4; ++r) {
                const float rs = 1.0f / sqrtf(wave_sum(sumsq4(v[r])) * (1.0f / D) + RMS_EPS);
#pragma unroll
                for (int j = 0; j < 4; ++j) { const f32x4 h = v[r][j] * rs * ga[j] + sh[j]; oa[r * (D / 4) + 64 * j] = (u64)pk2(h.x, h.y) | ((u64)pk2(h.z, h.w) << 32); }
            }
        }
    }
    for (int o = F.bid; o < 256 && F.G < 256; o += F.G) {
        const int kv = o >> 7, j = o & 127;
        const float* pe = kv ? INP(float, 11) : INP(float, 10); const float* w1 = kv ? INP(float, 14) : INP(float, 12);
        float p = 0.f;
#pragma unroll
        for (int i = 0; i < 4; ++i) { const int k = F.tid + NTHR * i; p = fmaf(pe[k], w1[(size_t)k * 128 + j], p); }
        p = wave_sum(p);
        LAS float* red = (LAS float*)F.lds;
        if (F.lane == 0) red[F.wave] = p;
        __syncthreads();
        if (F.tid == 0) WSP(float, WS_BIASC)[o] = ((red[0] + red[1]) + (red[2] + red[3])) + ((red[4] + red[5]) + (red[6] + red[7]));
        __syncthreads();
    }
    prep_weights_rope(F, A);
}

DI void phase_e1(Frame& F, const Args& A, const bf16* OPROJ) {
    const int gw = F.bid * NWAVES + F.wave, NGW = F.G * NWAVES;
    for (int r0 = gw * 32; r0 < M; r0 += NGW * 32) {
        const int b = r0 / T;
        const float* mod = WSP(float, WS_MOD) + (size_t)b * 6 * D;
        f32x4 g1[4], g2[4], sh[4];
#pragma unroll
        for (int j = 0; j < 4; ++j) { const int col = 4 * F.lane + 256 * j;
            g1[j] = *(const f32x4*)(INP(float, 6) + col) * *(const f32x4*)(mod + 2 * D + col);
            g2[j] = *(const f32x4*)(INP(float, 7) + col) * (*(const f32x4*)(mod + 4 * D + col) + 1.0f); sh[j] = *(const f32x4*)(mod + 3 * D + col); }
#pragma unroll 1
        for (int m = r0; m < r0 + 32; m += 2) {
            const f32x4* xa = (const f32x4*)(INP(float, 0) + (size_t)m * D) + F.lane; const f32x4* xb = xa + D / 4;
            const u64* pa = (const u64*)(OPROJ + (size_t)m * D) + F.lane; const u64* pb = pa + D / 4;
            f32x4 xva[4], xvb[4], oa[4], ob[4];
#pragma unroll
            for (int j = 0; j < 4; ++j) { xva[j] = __builtin_nontemporal_load(&xa[64 * j]); xvb[j] = __builtin_nontemporal_load(&xb[64 * j]);
                unpack_bf16x4(oa[j], __builtin_nontemporal_load(&pa[64 * j])); unpack_bf16x4(ob[j], __builtin_nontemporal_load(&pb[64 * j])); }
            const float ra = 1.0f / sqrtf(wave_sum(sumsq4(oa)) * (1.0f / D) + RMS_EPS), rb = 1.0f / sqrtf(wave_sum(sumsq4(ob)) * (1.0f / D) + RMS_EPS);
            u64* outa = (u64*)(WSP(bf16, WS_X2B) + (size_t)m * D) + F.lane; u64* outb = outa + D / 4;
#pragma unroll
            for (int j = 0; j < 4; ++j) { xva[j] = xva[j] + g1[j] * (oa[j] * ra); xvb[j] = xvb[j] + g1[j] * (ob[j] * rb);
                __builtin_nontemporal_store((u64)pk2(xva[j].x, xva[j].y) | ((u64)pk2(xva[j].z, xva[j].w) << 32), &outa[64 * j]);
                __builtin_nontemporal_store((u64)pk2(xvb[j].x, xvb[j].y) | ((u64)pk2(xvb[j].z, xvb[j].w) << 32), &outb[64 * j]); }
            const float sa = 1.0f / sqrtf(wave_sum(sumsq4(xva)) * (1.0f / D) + RMS_EPS), sb = 1.0f / sqrtf(wave_sum(sumsq4(xvb)) * (1.0f / D) + RMS_EPS);
            unsigned* ha8 = (unsigned*)(WSP(unsigned char, WS_XN) + (size_t)m * D) + F.lane; unsigned* hb8 = ha8 + D / 4;
#pragma unroll
            for (int j = 0; j < 4; ++j) {
                const f32x4 ha = xva[j] * sa * g2[j] + sh[j], hb = xvb[j] * sb * g2[j] + sh[j];
                ha8[64 * j] = pk4_f8(ha * 32.0f); hb8[64 * j] = pk4_f8(hb * 32.0f);
            }
        }
    }
}
DI void phase_e2(Frame& F, const Args& A, const bf16* Y) {
    const int gw = F.bid * NWAVES + F.wave, NGW = F.G * NWAVES;
    for (int r0 = gw * 32; r0 < M; r0 += NGW * 32) {
        const int b = r0 / T;
        const float* mod = WSP(float, WS_MOD) + (size_t)b * 6 * D;
        f32x4 g1[4];
#pragma unroll
        for (int j = 0; j < 4; ++j) { const int col = 4 * F.lane + 256 * j; g1[j] = *(const f32x4*)(INP(float, 8) + col) * *(const f32x4*)(mod + 5 * D + col); }
#pragma unroll 1
        for (int m = r0; m < r0 + 32; m += 2) {
            const u64* pa = (const u64*)(Y + (size_t)m * D) + F.lane; const u64* pb = pa + D / 4;
            f32x4* outa = (f32x4*)(A.out + (size_t)m * D) + F.lane; f32x4* outb = outa + D / 4;
            const u64* xa8 = (const u64*)(WSP(bf16, WS_X2B) + (size_t)m * D) + F.lane; const u64* xb8 = xa8 + D / 4;
            f32x4 ya[4], yb[4], xa[4], xb[4];
#pragma unroll
            for (int j = 0; j < 4; ++j) { unpack_bf16x4(ya[j], __builtin_nontemporal_load(&pa[64 * j])); unpack_bf16x4(yb[j], __builtin_nontemporal_load(&pb[64 * j]));
                unpack_bf16x4(xa[j], __builtin_nontemporal_load(&xa8[64 * j])); unpack_bf16x4(xb[j], __builtin_nontemporal_load(&xb8[64 * j])); }
            const float ra = 1.0f / sqrtf(wave_sum(sumsq4(ya)) * (1.0f / D) + RMS_EPS), rb = 1.0f / sqrtf(wave_sum(sumsq4(yb)) * (1.0f / D) + RMS_EPS);
#pragma unroll
            for (int j = 0; j < 4; ++j) {
                __builtin_nontemporal_store(xa[j] + g1[j] * (ya[j] * ra), &outa[64 * j]); __builtin_nontemporal_store(xb[j] + g1[j] * (yb[j] * rb), &outb[64 * j]); }
        }
    }
}

constexpr int KT_BYTES = 64 * 128, VT_BYTES = 64 * 128;
DI int kt_off(int row, int chunk) { return row * 128 + ((chunk ^ ((row >> 1) & 7)) << 4); }
DI int vt_off(int row, int colbyte) { return row * 128 + (colbyte ^ (((row >> 1) & 1) << 6)); }
DI void glds16(const void* gsrc, unsigned lds_dst) { unsigned keep;
    asm volatile("s_mov_b32 %0, m0\n\ts_mov_b32 m0, %2\n\ts_nop 0\n\tglobal_load_lds_dwordx4 %1, off\n\ts_mov_b32 m0, %0" : "=&s"(keep) : "v"(gsrc), "s"(lds_dst) : "memory"); }
typedef short v4i16_t __attribute__((ext_vector_type(4)));
DI s16x4 vtr(LAS const unsigned char* p) { return __builtin_bit_cast(s16x4, __builtin_amdgcn_ds_read_tr16_b64_v4i16((LAS v4i16_t*)p)); }
DI bf16x8 pack8(const f32x16& p, const int base) {
    u32x4 w; w.x = pk2(p[base], p[base + 1]); w.y = pk2(p[base + 2], p[base + 3]); w.z = pk2(p[base + 4], p[base + 5]); w.w = pk2(p[base + 6], p[base + 7]);
    return __builtin_bit_cast(bf16x8, w);
}
struct LaneAddr { int kb[4], vb0, vb1; };
DI LaneAddr lane_addr(int lane) {
    const int r32 = lane & 31, hi = lane >> 5, a = lane & 15, g1 = (lane >> 4) & 1, swz = (a >> 3) & 1;
    const int common = (4 * hi + (a >> 2)) * 128 + 32 * g1 + 8 * (a & 3);
    LaneAddr la;
#pragma unroll
    for (int st = 0; st < 4; ++st) la.kb[st] = kt_off(r32, 2 * st + hi);
    la.vb0 = common + 64 * swz; la.vb1 = common + 64 * (1 - swz);
    return la;
}
DI f32x16 qk_block(LAS const unsigned char* lds, const int koff, const bf16x8 (&qr)[4], const LaneAddr& la) {
    f32x16 s;
#pragma unroll
    for (int i = 0; i < 16; ++i) s[i] = 0.f;
#pragma unroll
    for (int st = 0; st < 4; ++st) { const bf16x8 a = *(LAS const bf16x8*)(lds + la.kb[st] + koff); s = MFMA32(a, qr[st], s); }
    return s;
}
DI void pv_step(f32x16 (&o)[2], LAS const unsigned char* lds, const int voff, const bf16x8 pw, const LaneAddr& la) {
    { const s16x4 lo = vtr(lds + la.vb0 + voff), hh = vtr(lds + la.vb0 + (voff + 1024));
      const bf16x8 vf = __builtin_shufflevector(lo, hh, 0, 1, 2, 3, 4, 5, 6, 7); o[0] = MFMA32(vf, pw, o[0]); }
    { const s16x4 lo = vtr(lds + la.vb1 + voff), hh = vtr(lds + la.vb1 + (voff + 1024));
      const bf16x8 vf = __builtin_shufflevector(lo, hh, 0, 1, 2, 3, 4, 5, 6, 7); o[1] = MFMA32(vf, pw, o[1]); }
}
DI void mask_block(f32x16& s, unsigned w  ) {
#pragma unroll
    for (int r = 0; r < 16; ++r) { const int sh = (r & 3) + 8 * (r >> 2); if (!((w >> sh) & 1u)) s[r] = -INFINITY; }
}
DI float block_max(const f32x16& s) { float m = s[0];
#pragma unroll
    for (int r = 1; r < 16; ++r) m = fmaxf(m, s[r]);
    return m; }
DI float pl32_max(float m) { auto rr = __builtin_amdgcn_permlane32_swap(__float_as_uint(m), __float_as_uint(m), false, false); return fmaxf(__uint_as_float(rr[0]), __uint_as_float(rr[1])); }
DI void store_pair8(unsigned char* p, unsigned wa, unsigned wb, int hi) {
    auto rr = __builtin_amdgcn_permlane32_swap(wa, wb, false, false);
    *(u64*)(p + 8 * hi) = (u64)rr[0] | ((u64)rr[1] << 32);
}
DI float pl32_sum(float m) { auto rr = __builtin_amdgcn_permlane32_swap(__float_as_uint(m), __float_as_uint(m), false, false); return __uint_as_float(rr[0]) + __uint_as_float(rr[1]); }
constexpr float ATT_THR = 8.0f;
#define SBAR() __builtin_amdgcn_sched_barrier(0)
#define PIN(x) asm volatile("" : "+v"(x))
DI void qk_tile(f32x16& p0, f32x16& p1, const bf16x8 (&qr)[4], LAS const unsigned char* kbuf, const float cinit, const LaneAddr& la) {
#pragma unroll
    for (int i = 0; i < 16; ++i) { p0[i] = cinit; p1[i] = cinit; }
#pragma unroll
    for (int st = 0; st < 4; ++st) {
        const bf16x8 a0 = *(LAS const bf16x8*)(kbuf + la.kb[st]), a1 = *(LAS const bf16x8*)(kbuf + la.kb[st] + 4096);
        p0 = MFMA32(a0, qr[st], p0); p1 = MFMA32(a1, qr[st], p1);
    }
}
template <bool PC>
DI void softmax_decide(f32x16& p0, f32x16& p1, float mx, f32x16 (&o)[2], float& m_ref, float& l_run, f32x16& cvec) {
    mx = pl32_max(mx);
    if (__any(mx > ATT_THR)) {
        const float dl = fmaxf(mx, 0.f);
        m_ref += dl;
        const float f = fast_exp2(-dl);
        const float nm = -m_ref;
        l_run *= f;
#pragma unroll
        for (int r = 0; r < 16; ++r) { p0[r] -= dl; p1[r] -= dl; o[0][r] *= f; o[1][r] *= f; if (PC) cvec[r] = nm; }
    }
}
template <bool MASKED> DI float exp_masked(float x, unsigned w, const int sh) {
    const float e = fast_exp2(x);
    if (!MASKED) return e;
    return __uint_as_float(__float_as_uint(e) & (unsigned)__builtin_amdgcn_sbfe(w, sh, 1));
}
template <bool MASKED, int SH> DI float exp_masked_c(float x, unsigned w) {
    const float e = fast_exp2(x);
    if (!MASKED) return e;
    unsigned t; asm("v_bfe_i32 %0, %1, %2, 1" : "=v"(t) : "v"(w), "n"(SH));
    return __uint_as_float(__float_as_uint(e) & t);
}
template <bool MASKED>
DI void attn_tail(f32x16& p0, f32x16& p1, LAS const unsigned char* vbuf, f32x16 (&o)[2], float& l_run, u64 vb, const LaneAddr& la, int hi) {
    const unsigned w0 = (unsigned)vb >> (4 * hi), w1 = (unsigned)(vb >> 32) >> (4 * hi);
    float rs = 0.f;
#pragma unroll
    for (int r = 0; r < 16; ++r) { const int sh = (r & 3) + 8 * (r >> 2); p0[r] = exp_masked<MASKED>(p0[r], w0, sh); p1[r] = exp_masked<MASKED>(p1[r], w1, sh); rs += p0[r] + p1[r]; }
    l_run += rs;
    pv_step(o, vbuf, 0 * 128, pack8(p0, 0), la); pv_step(o, vbuf, 16 * 128, pack8(p0, 8), la);
    pv_step(o, vbuf, 32 * 128, pack8(p1, 0), la); pv_step(o, vbuf, 48 * 128, pack8(p1, 8), la);
}
template <bool MASKED>
DI void attn_step(const bf16x8 (&qr)[4], LAS const unsigned char* knext, LAS const unsigned char* vbuf, f32x16 (&o)[2], float& m_ref, float& l_run, f32x16& cvec,
                  f32x16& p0, f32x16& p1, const u64 vb, const float cinit_next, const LaneAddr& la, const int hi) {
    const unsigned w0 = (unsigned)vb >> (4 * hi), w1 = (unsigned)(vb >> 32) >> (4 * hi);
    LAS const unsigned char* v0 = vbuf + la.vb0; LAS const unsigned char* v1 = vbuf + la.vb1;
    bf16x8 kf[2];
    s16x4 vf[2][2];
    float rs = 0.f;
    unsigned pw[16];
    f32x16 n0, n1;
#define SHF(R) (((R) & 3) + 8 * ((R) >> 2))
#define EXPP(P, W, R) do { float a_ = P[R], b_ = P[(R) + 1]; PIN(a_); PIN(b_); a_ = exp_masked_c<MASKED, SHF(R)>(a_, W); b_ = exp_masked_c<MASKED, SHF((R) + 1)>(b_, W); \
        rs += a_; rs += b_; pw[((&P == &p1) ? 8 : 0) + (R) / 2] = pk2(a_, b_); } while (0)
#define KRD(B, ST) do { kf[(ST) & 1] = *(LAS const bf16x8*)(knext + la.kb[ST] + (B) * 4096); } while (0)
#define VRD(M) do { LAS const unsigned char* vp_ = ((M) & 1) ? v1 : v0; vf[(M) & 1][0] = vtr(vp_ + ((M) >> 1) * 2048); vf[(M) & 1][1] = vtr(vp_ + (((M) >> 1) * 2048 + 1024)); } while (0)
#define PVM(M, PW) do { const u32x4 pw_ = {pw[4 * (PW)], pw[4 * (PW) + 1], pw[4 * (PW) + 2], pw[4 * (PW) + 3]}; \
        o[(M) & 1] = MFMA32(__builtin_shufflevector(vf[(M) & 1][0], vf[(M) & 1][1], 0, 1, 2, 3, 4, 5, 6, 7), __builtin_bit_cast(bf16x8, pw_), o[(M) & 1]); } while (0)
#define MX2(N, B) do { mx = fmaxf(fmaxf(mx, N[B]), N[(B) + 1]); } while (0)
    KRD(0, 0); KRD(0, 1);
    if (!MASKED) {
#pragma unroll
        for (int i = 0; i < 16; ++i) cvec[i] = cinit_next;
    }
    EXPP(p0, w0, 0); EXPP(p0, w0, 2); PIN(rs); SBAR();
    n0 = MFMA32(kf[0], qr[0], cvec); KRD(0, 2); EXPP(p0, w0, 4); EXPP(p0, w0, 6); PIN(rs); SBAR();
    n0 = MFMA32(kf[1], qr[1], n0); KRD(0, 3); EXPP(p0, w0, 8); PIN(rs); SBAR();
    n0 = MFMA32(kf[0], qr[2], n0); VRD(0);    EXPP(p0, w0, 10); EXPP(p0, w0, 12); PIN(rs); SBAR();
    n0 = MFMA32(kf[1], qr[3], n0); VRD(1);    EXPP(p0, w0, 14); PIN(rs); SBAR();
    PVM(0, 0); VRD(2);    EXPP(p1, w1, 0); PIN(rs); SBAR();
    PVM(1, 0); VRD(3);    EXPP(p1, w1, 2); PIN(rs); SBAR();
    PVM(2, 1); KRD(1, 0); EXPP(p1, w1, 4); PIN(rs); SBAR();
    PVM(3, 1); KRD(1, 1); EXPP(p1, w1, 6); PIN(rs); SBAR();
    float mx = n0[0];
    n1 = MFMA32(kf[0], qr[0], cvec); KRD(1, 2); EXPP(p1, w1, 8);  MX2(n0, 0); MX2(n0, 2);   PIN(rs); PIN(mx); SBAR();
    n1 = MFMA32(kf[1], qr[1], n1); KRD(1, 3); EXPP(p1, w1, 10); MX2(n0, 4); MX2(n0, 6);   PIN(rs); PIN(mx); SBAR();
    n1 = MFMA32(kf[0], qr[2], n1); VRD(4);    EXPP(p1, w1, 12); MX2(n0, 8); MX2(n0, 10);  PIN(rs); PIN(mx); SBAR();
    n1 = MFMA32(kf[1], qr[3], n1); VRD(5);    EXPP(p1, w1, 14); MX2(n0, 12); MX2(n0, 14); PIN(rs); PIN(mx); SBAR();
    PVM(4, 2); VRD(6); MX2(n1, 0); MX2(n1, 2);   PIN(mx); SBAR();
    PVM(5, 2); VRD(7); MX2(n1, 4); MX2(n1, 6);   PIN(mx); SBAR();
    PVM(6, 3); MX2(n1, 8); MX2(n1, 10);  PIN(mx); SBAR();
    PVM(7, 3); MX2(n1, 12); MX2(n1, 14); PIN(mx); SBAR();
    l_run += rs;
#undef SHF
#undef EXPP
#undef KRD
#undef VRD
#undef PVM
#undef MX2
    softmax_decide<MASKED>(n0, n1, mx, o, m_ref, l_run, cvec);
    p0 = n0; p1 = n1;
}
DI u64 causal_bits(int ql) { return ql >= 63 ? ~0ull : ((1ull << (ql + 1)) - 1ull); }

DI void compress_item(Frame& F, int item) {
    const int kv = item & 1, half = (item >> 1) & 1, g = (item >> 2) & 1, b = item >> 3;
    const int lane = launder(F.lane), r32 = lane & 31, hi = lane >> 5, wid = F.wave;
    const bf16* Pb = WSP(bf16, WS_P) + (size_t)b * T * PP + ((kv ? HB_VC : HB_KC) + g) * 64;
    const bf16* W1 = kv ? WSP(bf16, WS_W1V) : WSP(bf16, WS_W1K); const bf16* W2 = kv ? WSP(bf16, WS_W2V) : WSP(bf16, WS_W2K);
    const float* bias = WSP(float, WS_BIASC) + kv * 128;
    bf16* OUT = (kv ? WSP(bf16, WS_VCMP) : WSP(bf16, WS_KCMP)) + (size_t)((b * 2 + g) * 128) * 64;
    LAS unsigned char* H1 = F.lds + 131584;
    LAS float* PART = (LAS float*)F.lds;
    static_assert(131072 <= MISC_OFF && 131584 >= MISC_OFF + 128 && 131584 + 64 * 272 <= 160512, "compress LDS map");
    {
        const int nh = wid & 1, kq = wid >> 1;
        const bf16* arow[2]; const bf16* brow[2];
#pragma unroll
        for (int mt = 0; mt < 2; ++mt) { const int n = 64 * half + 32 * mt + r32, nc = n < 126 ? n : 126; arow[mt] = Pb + (size_t)(16 * nc) * PP + hi * 8; }
#pragma unroll
        for (int nt = 0; nt < 2; ++nt) brow[nt] = W1 + (size_t)(64 * nh + 32 * nt + r32) * 2048 + hi * 8;
        f32x16 acc[2][2];
#pragma unroll
        for (int i = 0; i < 16; ++i) { acc[0][0][i] = 0.f; acc[0][1][i] = 0.f; acc[1][0][i] = 0.f; acc[1][1][i] = 0.f; }
#pragma unroll 8
        for (int l = 8 * kq; l < 8 * kq + 8; ++l) {
#pragma unroll
            for (int ss = 0; ss < 4; ++ss) {
                const bf16x8 a0 = *(const bf16x8*)(arow[0] + (size_t)l * PP + ss * 16), a1 = *(const bf16x8*)(arow[1] + (size_t)l * PP + ss * 16);
                const bf16x8 b0 = *(const bf16x8*)(brow[0] + (4 * l + ss) * 16), b1 = *(const bf16x8*)(brow[1] + (4 * l + ss) * 16);
                acc[0][0] = MFMA32(a0, b0, acc[0][0]); acc[0][1] = MFMA32(a0, b1, acc[0][1]);
                acc[1][0] = MFMA32(a1, b0, acc[1][0]); acc[1][1] = MFMA32(a1, b1, acc[1][1]);
            }
        }
#pragma unroll
        for (int t = 0; t < 4; ++t)
#pragma unroll
            for (int r = 0; r < 16; ++r) PART[((wid * 4 + t) * 16 + r) * 64 + lane] = acc[t >> 1][t & 1][r];
    }
    __syncthreads();
    {
        const int nh = wid & 1, t = wid >> 1, mt = t >> 1, nt = t & 1;
        const float bj = bias[64 * nh + 32 * nt + r32];
#pragma unroll
        for (int r = 0; r < 16; ++r) {
            float v = 0.f;
#pragma unroll
            for (int kq = 0; kq < 4; ++kq) v += PART[(((nh + 2 * kq) * 4 + t) * 16 + r) * 64 + lane];
            const float h = gelu_tanh(v + bj);
            *(LAS unsigned short*)(H1 + (32 * mt + crow(r, hi)) * 272 + (64 * nh + 32 * nt + r32) * 2) = (unsigned short)(pk2(h, 0.f) & 0xffffu);
        }
    }
    __syncthreads();
    if (wid < 4) {
        const int mh = wid & 1, dh = wid >> 1;
        f32x16 acc;
#pragma unroll
        for (int i = 0; i < 16; ++i) acc[i] = 0.f;
        LAS const unsigned char* ar = H1 + (32 * mh + r32) * 272 + hi * 16;
        const bf16* br = W2 + (size_t)(32 * dh + r32) * 128 + hi * 8;
#pragma unroll
        for (int st = 0; st < 8; ++st) {
            const bf16x8 a = *(LAS const bf16x8*)(ar + st * 32);
            const bf16x8 bb = *(const bf16x8*)(br + st * 16);
            acc = MFMA32(a, bb, acc);
        }
#pragma unroll
        for (int r = 0; r < 16; ++r) OUT[(size_t)(64 * half + 32 * mh + crow(r, hi)) * 64 + 32 * dh + r32] = (bf16)(pk2(acc[r], 0.f) & 0xffffu);
    }
    __syncthreads();
}


constexpr int KR_OFF = 0, VR_OFF = 3 * KT_BYTES, TILE_BUFS = 3 * KT_BYTES + 3 * VT_BYTES;
#define WAIT_VM_BAR(N) asm volatile("s_waitcnt vmcnt(" #N ") lgkmcnt(0)\n\ts_barrier" ::: "memory")
DI void wait_vm_bar(int c) { if (c >= 2) WAIT_VM_BAR(2); else if (c == 1) WAIT_VM_BAR(1); else WAIT_VM_BAR(0); }
template <bool ALWAYS_MASKED, bool PRE, class MaskF>
DI void run_tiles(Frame& F, unsigned tmask, const bf16* Kg0, const bf16* Vg0,
                  const bf16x8 (&qr)[4], f32x16 (&o)[2], float& m_ref, float& l_run, const MaskF mf, const LaneAddr& la, const int tid) {
    if (tmask == 0u) return;
    const int hi = (tid >> 5) & 1, lane = tid & 63, wid = F.wave;
    const int drow = 8 * wid + (lane >> 3), dch = lane & 7;
    const bf16* ksrc = Kg0 + (size_t)drow * PP + ((dch ^ ((drow >> 1) & 7)) << 3);
    const bf16* vsrc = Vg0 + (size_t)drow * PP + ((dch ^ (((drow >> 1) & 1) << 2)) << 3);
    const unsigned lds0 = (unsigned)(size_t)F.lds + (unsigned)wid * 1024u;
#define POP(J) do { J = -1; if (tmask) { J = __builtin_ctz(tmask); tmask &= tmask - 1u; } } while (0)
#define DMA_K(J, ST) glds16(ksrc + (size_t)(64 * (J)) * PP, (unsigned)__builtin_amdgcn_readfirstlane(lds0 + KR_OFF + (ST) * KT_BYTES))
#define DMA_V(J, ST) glds16(vsrc + (size_t)(64 * (J)) * PP, (unsigned)__builtin_amdgcn_readfirstlane(lds0 + VR_OFF + (ST) * VT_BYTES))
    int tA, tB, tC, tD;
    POP(tA); POP(tB); POP(tC);
    if (!PRE) {
        WAIT_VM_BAR(0);
        DMA_K(tA, 0); DMA_V(tA, 0);
        if (tB >= 0) { DMA_K(tB, 1); DMA_V(tB, 1); }
        if (tC >= 0) DMA_K(tC, 2);
    }
    WAIT_VM_BAR(0);
    u64 vb = mf(tA);
    bool rl = !ALWAYS_MASKED && __all(vb == 0ull || vb == ~0ull);
    f32x16 p0, p1, cvec;
#pragma unroll
    for (int i = 0; i < 16; ++i) cvec[i] = -m_ref;
    qk_tile(p0, p1, qr, F.lds + KR_OFF, (rl && vb == 0ull) ? -INFINITY : -m_ref, la);
    softmax_decide<ALWAYS_MASKED>(p0, p1, fmaxf(block_max(p0), block_max(p1)), o, m_ref, l_run, cvec);
    int s0 = 0, s1 = 1, s2 = 2;
    int cprev = 0;
    for (;;) {
        SEC_BEGIN(11);
        SEC_BEGIN(16);
        wait_vm_bar(cprev);
        SEC_END(16);
        SEC_BEGIN(17);
        POP(tD);
        int c = 0;
        if (tD >= 0) { DMA_K(tD, s0); ++c; }
        if (tC >= 0) { DMA_V(tC, s2); ++c; }
        cprev = c;
        SEC_END(17);
        LAS const unsigned char* vcur = F.lds + VR_OFF + s0 * VT_BYTES;
        SEC_END(11);
        if (tB < 0) {
            if (rl) attn_tail<false>(p0, p1, vcur, o, l_run, vb, la, hi); else attn_tail<true>(p0, p1, vcur, o, l_run, vb, la, hi);
            break;
        }
        SEC_BEGIN(12);
        const u64 vbn = mf(tB);
        const bool rln = !ALWAYS_MASKED && __all(vbn == 0ull || vbn == ~0ull);
        const float cn = (rln && vbn == 0ull) ? -INFINITY : -m_ref;
        LAS const unsigned char* knext = F.lds + KR_OFF + s1 * KT_BYTES;
        if (ALWAYS_MASKED) attn_step<true>(qr, knext, vcur, o, m_ref, l_run, cvec, p0, p1, vb, cn, la, hi);
        else if (rl) attn_step<false>(qr, knext, vcur, o, m_ref, l_run, cvec, p0, p1, vb, cn, la, hi);
        else {
            attn_tail<true>(p0, p1, vcur, o, l_run, vb, la, hi);
            qk_tile(p0, p1, qr, knext, cn, la);
            softmax_decide<false>(p0, p1, fmaxf(block_max(p0), block_max(p1)), o, m_ref, l_run, cvec);
        }
        vb = vbn; rl = rln;
        SEC_END(12);
        tA = tB; tB = tC; tC = tD;
        { const int t = s0; s0 = s1; s1 = s2; s2 = t; }
    }
    asm volatile("s_waitcnt vmcnt(0)" ::: "memory");
    l_run = pl32_sum(l_run);
#undef POP
#undef DMA_K
#undef DMA_V
}
DI void tiles_prefetch(Frame& F, unsigned tmask, const bf16* Kg0, const bf16* Vg0, const int tid) {
    const int lane = tid & 63, wid = F.wave;
    const int drow = 8 * wid + (lane >> 3), dch = lane & 7;
    const bf16* ksrc = Kg0 + (size_t)drow * PP + ((dch ^ ((drow >> 1) & 7)) << 3);
    const bf16* vsrc = Vg0 + (size_t)drow * PP + ((dch ^ (((drow >> 1) & 1) << 2)) << 3);
    const unsigned lds0 = (unsigned)(size_t)F.lds + (unsigned)wid * 1024u;
    int tA = -1, tB = -1, tC = -1;
    if (tmask) { tA = __builtin_ctz(tmask); tmask &= tmask - 1u; }
    if (tmask) { tB = __builtin_ctz(tmask); tmask &= tmask - 1u; }
    if (tmask) { tC = __builtin_ctz(tmask); }
    if (tA >= 0) { glds16(ksrc + (size_t)(64 * tA) * PP, (unsigned)__builtin_amdgcn_readfirstlane(lds0 + KR_OFF)); glds16(vsrc + (size_t)(64 * tA) * PP, (unsigned)__builtin_amdgcn_readfirstlane(lds0 + VR_OFF)); }
    if (tB >= 0) { glds16(ksrc + (size_t)(64 * tB) * PP, (unsigned)__builtin_amdgcn_readfirstlane(lds0 + KR_OFF + KT_BYTES)); glds16(vsrc + (size_t)(64 * tB) * PP, (unsigned)__builtin_amdgcn_readfirstlane(lds0 + VR_OFF + VT_BYTES)); }
    if (tC >= 0) glds16(ksrc + (size_t)(64 * tC) * PP, (unsigned)__builtin_amdgcn_readfirstlane(lds0 + KR_OFF + 2 * KT_BYTES));
}
struct SlcMask { unsigned sel; int tb, ql; DI u64 operator()(int j) const { return ((sel >> j) & 1u) ? (j == tb ? causal_bits(ql) : ~0ull) : 0ull; } };
struct WinMask { int tb, ql; DI u64 operator()(int j) const { return j == tb ? causal_bits(ql) : (j == tb - 8 ? ~causal_bits(ql) : ~0ull); } };
struct DsaMask { LAS const u64* row; DI u64 operator()(int j) const { return row[j]; } };

constexpr int NSA_KC = TILE_BUFS, NSA_VC = NSA_KC + 128 * 128, NSA_IMP = NSA_VC + 128 * 128,
              NSA_SELM = NSA_IMP + 4 * 64 * 33 * 4, NSA_UM = NSA_SELM + 256, NSA_VS = NSA_UM + 16, NSA_END = NSA_VS + 8 * 2 * 32 * 4,
              NSA_PARK = NSA_KC;
static_assert(NSA_END <= RING_BYTES && NSA_PARK + 8 * 8192 <= NSA_SELM, "NSA LDS map");

DI void nsa_unit(Frame& F, int b, int g, int tb) {
    const int tid = launder(F.tid), lane = tid & 63, r32 = lane & 31, hi = lane >> 5, wid = F.wave;
    const int r = wid & 3, th = wid >> 2, hq = 4 * g + r, ql = 32 * th + r32, t = 64 * tb + ql;
    const size_t rowg = (size_t)b * T + t;
    LAS unsigned char* KC = F.lds + NSA_KC; LAS unsigned char* VC = F.lds + NSA_VC;
    const LaneAddr la = lane_addr(lane);
    LAS float* IMP = (LAS float*)(F.lds + NSA_IMP); LAS unsigned* SELM = (LAS unsigned*)(F.lds + NSA_SELM); LAS unsigned* UM = (LAS unsigned*)(F.lds + NSA_UM);
    SEC_BEGIN(1);
    const int jlo = tb >= 8 ? tb - 8 : 0;
    const unsigned wmask = (tb == 31 ? ~0u : ((2u << tb) - 1u)) & ~((1u << jlo) - 1u);
    tiles_prefetch(F, wmask, WSP(bf16, WS_P) + (size_t)b * T * PP + (HB_KW + g) * 64, WSP(bf16, WS_P) + (size_t)b * T * PP + (HB_VW + g) * 64, tid);
    bf16x8 qr[4];
#pragma unroll
    for (int st = 0; st < 4; ++st) qr[st] = *(const bf16x8*)(WSP(bf16, WS_P) + rowg * PP + hq * 64 + 16 * st + 8 * hi);
    float gate[3];
#pragma unroll
    for (int br = 0; br < 3; ++br) { const float xg = WSP(float, WS_MISC)[rowg * 32 + hq * 3 + br]; gate[br] = 1.0f / (1.0f + __expf(-xg)); }
    f32x16 ot[2];
#pragma unroll
    for (int i = 0; i < 16; ++i) { ot[0][i] = 0.f; ot[1][i] = 0.f; }
    {
        const bf16* kc = WSP(bf16, WS_KCMP) + (size_t)((b * 2 + g) * 128) * 64; const bf16* vc = WSP(bf16, WS_VCMP) + (size_t)((b * 2 + g) * 128) * 64;
#pragma unroll
        for (int ps = 0; ps < 2; ++ps) { const int row = (tid >> 3) + 64 * ps, ch = tid & 7;
            const u32x4 kk = *(const u32x4*)(kc + row * 64 + ch * 8), vv = *(const u32x4*)(vc + row * 64 + ch * 8);
            *(LAS u32x4*)(KC + kt_off(row, ch)) = kk; *(LAS u32x4*)(VC + vt_off(row, ch * 16)) = vv; }
        if (tid == 0) UM[0] = 0u;
    }
    __syncthreads();
    {
        const int nq = (t - 31) >> 4;
        float mx = -INFINITY;
#pragma unroll 1
        for (int c = 0; c < 4; ++c) {
            const f32x16 s = qk_block(F.lds, NSA_KC + c * 32 * 128, qr, la);
#pragma unroll
            for (int rg = 0; rg < 16; ++rg) if (32 * c + crow(rg, hi) <= nq) mx = fmaxf(mx, s[rg]);
        }
        mx = fmaxf(mx, __shfl_xor(mx, 32));
        const float ms = fmaxf(mx, -1e30f);
        float l = 0.f, carry = 0.f;
        LAS float* irow = IMP + (r * 64 + ql) * 33;
        f32x16 oc[2];
#pragma unroll
        for (int i = 0; i < 16; ++i) { oc[0][i] = 0.f; oc[1][i] = 0.f; }
#pragma unroll 1
        for (int c = 0; c < 4; ++c) {
            f32x16 p = qk_block(F.lds, NSA_KC + c * 32 * 128, qr, la);
#pragma unroll
            for (int rg = 0; rg < 16; ++rg) { p[rg] = (32 * c + crow(rg, hi) <= nq) ? fast_exp2(p[rg] - ms) : 0.f; l += p[rg]; }
            float sw[4];
#pragma unroll
            for (int u = 0; u < 4; ++u) sw[u] = __shfl_xor(p[4 * u + 3], 32);
#pragma unroll
            for (int u = 0; u < 4; ++u) {
                const float quad = (p[4 * u] + p[4 * u + 1]) + (p[4 * u + 2] + p[4 * u + 3]);
                const float prevlo = u > 0 ? sw[u > 0 ? u - 1 : 0] : carry;
                irow[8 * c + 2 * u + hi] = quad + (hi ? sw[u] : prevlo);
            }
            carry = sw[3];
            pv_step(oc, F.lds, NSA_VC + (32 * c) * 128, pack8(p, 0), la); pv_step(oc, F.lds, NSA_VC + (32 * c + 16) * 128, pack8(p, 8), la);
        }
        l += __shfl_xor(l, 32);
        const float inv = l > 0.f ? 1.0f / l : 0.f;
#pragma unroll
        for (int i = 0; i < 16; ++i) irow[2 * i + hi] *= inv;
        const float gs = gate[0] * inv;
#pragma unroll
        for (int i = 0; i < 16; ++i) { ot[0][i] = gs * oc[0][i]; ot[1][i] = gs * oc[1][i]; }
    }
    __syncthreads();
    if (tb < 16) {
        if (tid < 64) SELM[tid] = (2u << tb) - 1u;
        if (tid == 0) UM[0] = (2u << tb) - 1u;
    } else {
        const int j = lane & 31;
        unsigned um = 0u;
#pragma unroll 1
        for (int ps = 0; ps < 4; ++ps) {
            const int tq = wid * 8 + ps * 2 + hi;
            float v = ((IMP[(0 * 64 + tq) * 33 + j] + IMP[(1 * 64 + tq) * 33 + j]) + IMP[(2 * 64 + tq) * 33 + j]) + IMP[(3 * 64 + tq) * 33 + j];
            if (j > tb) v = -INFINITY; else if (j == 0 || j == tb || j == tb - 1) v = INFINITY;
            LAS float* vs = (LAS float*)(F.lds + NSA_VS) + (wid * 2 + hi) * 32;
            vs[j] = v;
            LDS_WAIT();
            int rank = 0;
#pragma unroll
            for (int k4 = 0; k4 < 8; ++k4) {
                const f32x4 o4 = *(LAS const f32x4*)(vs + 4 * k4);
#pragma unroll
                for (int c = 0; c < 4; ++c) { const int k = 4 * k4 + c; const float ov = o4[c]; rank += (ov > v || (ov == v && k < j)) ? 1 : 0; }
            }
            const u64 bm = __ballot(rank < 16 && j <= tb);
            if (j == 0) SELM[tq] = hi ? (unsigned)(bm >> 32) : (unsigned)bm;
            um |= (unsigned)bm | (unsigned)(bm >> 32);
        }
        if (lane == 0) __hip_atomic_fetch_or(UM, um, __ATOMIC_RELAXED, __HIP_MEMORY_SCOPE_WORKGROUP);
    }
    __syncthreads();
    const unsigned umask = UM[0];
    SEC_END(1);
    SEC_BEGIN(2);
    LAS f32x4* park = (LAS f32x4*)(F.lds + NSA_PARK + wid * 8192) + lane;
#pragma unroll
    for (int u = 0; u < 4; ++u) { park[64 * u] = (f32x4){ot[0][4 * u], ot[0][4 * u + 1], ot[0][4 * u + 2], ot[0][4 * u + 3]}; park[64 * (4 + u)] = (f32x4){ot[1][4 * u], ot[1][4 * u + 1], ot[1][4 * u + 2], ot[1][4 * u + 3]}; }
    const unsigned sel = SELM[ql];
    const bf16* Pb = WSP(bf16, WS_P) + (size_t)b * T * PP;
    {
        f32x16 o[2];
#pragma unroll
        for (int i = 0; i < 16; ++i) { o[0][i] = 0.f; o[1][i] = 0.f; }
        float m_run = 0.f, l_run = 0.f;
        WinMask mf{tb, ql};
        run_tiles<false, true>(F, wmask, Pb + (HB_KW + g) * 64, Pb + (HB_VW + g) * 64, qr, o, m_run, l_run, mf, la, tid);
        float l = l_run;
        const float sc = l > 0.f ? gate[2] / l : 0.f;
#pragma unroll
        for (int u = 0; u < 4; ++u) {
            f32x4 a = park[64 * u], c = park[64 * (4 + u)];
#pragma unroll
            for (int i = 0; i < 4; ++i) { a[i] += sc * o[0][4 * u + i]; c[i] += sc * o[1][4 * u + i]; }
            park[64 * u] = a; park[64 * (4 + u)] = c;
        }
    }
    SEC_END(2);
    SEC_BEGIN(3);
    {
        f32x16 o[2];
#pragma unroll
        for (int i = 0; i < 16; ++i) { o[0][i] = 0.f; o[1][i] = 0.f; }
        float m_run = 0.f, l_run = 0.f;
        SlcMask mf{sel, tb, ql};
        run_tiles<false, false>(F, umask, Pb + (HB_KSL + g) * 64, Pb + (HB_VSL + g) * 64, qr, o, m_run, l_run, mf, la, tid);
        float l = l_run;
        const float sc = l > 0.f ? gate[1] / l : 0.f;
#pragma unroll
        for (int u = 0; u < 4; ++u) {
            const f32x4 a = park[64 * u], c = park[64 * (4 + u)];
#pragma unroll
            for (int i = 0; i < 4; ++i) { ot[0][4 * u + i] = a[i] + sc * o[0][4 * u + i]; ot[1][4 * u + i] = c[i] + sc * o[1][4 * u + i]; }
        }
    }
    SEC_END(3);
    unsigned char* orow = WSP(unsigned char, WS_XN) + rowg * D + hq * 64;
#pragma unroll
    for (int db = 0; db < 2; ++db)
#pragma unroll
        for (int u = 0; u < 4; u += 2) store_pair8(orow + 32 * db + 8 * u, pk4_f8((f32x4){ot[db][4 * u], ot[db][4 * u + 1], ot[db][4 * u + 2], ot[db][4 * u + 3]} * 64.0f),
                                                   pk4_f8((f32x4){ot[db][4 * u + 4], ot[db][4 * u + 5], ot[db][4 * u + 6], ot[db][4 * u + 7]} * 64.0f), hi);
}

constexpr int DSA_ROW = 8208, DSA_MB = 131584, DSA_HIST = DSA_MB + 32 * 33 * 8, DSA_RMAX = DSA_HIST + 8 * 2560, DSA_END = DSA_RMAX + 32 * 4;
static_assert(16 * DSA_ROW <= MISC_OFF && DSA_MB >= MISC_OFF + 128 && DSA_END <= LDS_BYTES, "DSA LDS map");
typedef float f32x4v __attribute__((ext_vector_type(4)));
#define MFMA16(a, b, c) __builtin_amdgcn_mfma_f32_16x16x32_bf16((a), (b), (c), 0, 0, 0)

DI void dsa_scores16(Frame& F, const bf16* Pb, size_t rowq0, int KB, int lane, int wid) {
    const int q = lane & 15, kg = lane >> 4;
    bf16x8 qf[4][2];
#pragma unroll
    for (int h = 0; h < 4; ++h)
#pragma unroll
        for (int st = 0; st < 2; ++st) qf[h][st] = *(const bf16x8*)(Pb + (rowq0 + q) * PP + (HB_QI + h) * 64 + 32 * st + 8 * kg);
    const float idx_scale = 0.5f * 0.125f;
    const f32x4 wv = *(const f32x4*)(WSP(float, WS_MISC) + (rowq0 + q) * 32 + 24);
    const float w0 = wv[0] * idx_scale, w1 = wv[1] * idx_scale, w2 = wv[2] * idx_scale, w3 = wv[3] * idx_scale;
    LAS unsigned char* rowp = F.lds + q * DSA_ROW;
    const bf16* kbase = Pb + (rowq0 - (rowq0 % T) + q) * PP + HB_KI * 64 + 8 * kg;
    bf16x8 ka[4][2], kn[4][2];
    if (wid < KB) {
#pragma unroll
        for (int blk = 0; blk < 4; ++blk)
#pragma unroll
            for (int st = 0; st < 2; ++st) ka[blk][st] = *(const bf16x8*)(kbase + (size_t)(64 * wid + 16 * blk) * PP + 32 * st);
    }
    for (int kb = wid; kb < KB; kb += 8) {
        if (kb + 8 < KB) {
#pragma unroll
            for (int blk = 0; blk < 4; ++blk)
#pragma unroll
                for (int st = 0; st < 2; ++st) kn[blk][st] = *(const bf16x8*)(kbase + (size_t)(64 * (kb + 8) + 16 * blk) * PP + 32 * st);
        }
        const int g = kb >> 2, e = kb & 3;
#pragma unroll
        for (int blk = 0; blk < 4; ++blk) {
            f32x4v sc;
#pragma unroll
            for (int h = 0; h < 4; ++h) {
                f32x4v acc = {0.f, 0.f, 0.f, 0.f};
                acc = MFMA16(ka[blk][0], qf[h][0], acc); acc = MFMA16(ka[blk][1], qf[h][1], acc);
                const float wh = h == 0 ? w0 : (h == 1 ? w1 : (h == 2 ? w2 : w3));
#pragma unroll
                for (int i = 0; i < 4; ++i) { const float rl = fmaxf(acc[i], 0.f); sc[i] = h == 0 ? wh * rl : fmaf(wh, rl, sc[i]); }
            }
#pragma unroll
            for (int i = 0; i < 4; ++i) *(LAS float*)(rowp + ((g * 64 + 16 * blk + 4 * kg + i) * 4 + e) * 4) = sc[i];
        }
#pragma unroll
        for (int blk = 0; blk < 4; ++blk) { ka[blk][0] = kn[blk][0]; ka[blk][1] = kn[blk][1]; }
    }
}
DI void dsa_scores32(Frame& F, const bf16* Pb, size_t rowq0, int KB, int lane, int wid, f32x4v (&held)[16], LAS unsigned* rowmax) {
    const int q = lane & 15, kg = lane >> 4;
    const int tq0 = (int)(rowq0 % T) + q;
    float rmax[2] = {0.f, 0.f};
    bf16x8 qf[2][4][2];
#pragma unroll
    for (int qb = 0; qb < 2; ++qb)
#pragma unroll
        for (int h = 0; h < 4; ++h)
#pragma unroll
            for (int st = 0; st < 2; ++st) qf[qb][h][st] = *(const bf16x8*)(Pb + (rowq0 + 16 * qb + q) * PP + (HB_QI + h) * 64 + 32 * st + 8 * kg);
    const float idx_scale = 0.5f * 0.125f;
    float w[2][4];
#pragma unroll
    for (int qb = 0; qb < 2; ++qb) { const f32x4 wv = *(const f32x4*)(WSP(float, WS_MISC) + (rowq0 + 16 * qb + q) * 32 + 24);
#pragma unroll
        for (int h = 0; h < 4; ++h) w[qb][h] = wv[h] * idx_scale; }
    LAS unsigned char* rowp = F.lds + q * DSA_ROW;
    const bf16* kbase = Pb + (rowq0 - (rowq0 % T) + q) * PP + HB_KI * 64 + 8 * kg;
    const int nitems = 4 * ((KB + 3) >> 2), lastrow = 4 * KB - 1;
    constexpr int NPF = 2;
    bf16x8 kf[NPF][2];
#define LOADK(S, DST) do { const int id_ = wid + 8 * ((S) >> 2); int rb_ = 4 * (4 * (id_ >> 2) + ((S) & 3)) + (id_ & 3); rb_ = rb_ < lastrow ? rb_ : lastrow; \
        const bf16* p_ = kbase + (size_t)(16 * rb_) * PP; DST[0] = *(const bf16x8*)p_; DST[1] = *(const bf16x8*)(p_ + 32); } while (0)
#pragma unroll
    for (int p = 0; p < NPF; ++p) LOADK(p, kf[p]);
    f32x4v tsc[4];
#pragma unroll
    for (int S = 0; S < 16; ++S) {
        const int it = S >> 2, e = S & 3;
        const int id = wid + 8 * it, g = id >> 2, blk = id & 3, kb = 4 * g + e;
        const bf16x8 k0 = kf[S % NPF][0], k1 = kf[S % NPF][1];
        if (S + NPF < 16) LOADK(S + NPF, kf[S % NPF]);
        if (id < nitems && kb < KB) {
            f32x4v sc[2];
#pragma unroll
            for (int qb = 0; qb < 2; ++qb)
#pragma unroll
                for (int h = 0; h < 4; ++h) {
                    f32x4v acc = {0.f, 0.f, 0.f, 0.f};
                    acc = MFMA16(k0, qf[qb][h][0], acc); acc = MFMA16(k1, qf[qb][h][1], acc);
#pragma unroll
                    for (int i = 0; i < 4; ++i) { const float rl = fmaxf(acc[i], 0.f); sc[qb][i] = h == 0 ? w[qb][h] * rl : fmaf(w[qb][h], rl, sc[qb][i]); }
                }
            tsc[e] = sc[0];
            held[S] = sc[1];
            if (kb == KB - 1) {
#pragma unroll
                for (int qb = 0; qb < 2; ++qb)
#pragma unroll
                    for (int i = 0; i < 4; ++i) if (64 * kb + 16 * blk + 4 * kg + i <= tq0 + 16 * qb) rmax[qb] = fmaxf(rmax[qb], fabsf(sc[qb][i]));
            } else {
#pragma unroll
                for (int qb = 0; qb < 2; ++qb) rmax[qb] = fmaxf(fmaxf(rmax[qb], fmaxf(fabsf(sc[qb][0]), fabsf(sc[qb][1]))), fmaxf(fabsf(sc[qb][2]), fabsf(sc[qb][3])));
            }
        } else tsc[e] = (f32x4v){0.f, 0.f, 0.f, 0.f};
        if (e == 3 && id < nitems) {
#pragma unroll
            for (int i = 0; i < 4; ++i) *(LAS f32x4v*)(rowp + (g * 64 + 16 * blk + 4 * kg + i) * 16) = (f32x4v){tsc[0][i], tsc[1][i], tsc[2][i], tsc[3][i]};
        }
    }
#undef LOADK
    __hip_atomic_fetch_max(rowmax + q, __float_as_uint(rmax[0]), __ATOMIC_RELAXED, __HIP_MEMORY_SCOPE_WORKGROUP);
    __hip_atomic_fetch_max(rowmax + 16 + q, __float_as_uint(rmax[1]), __ATOMIC_RELAXED, __HIP_MEMORY_SCOPE_WORKGROUP);
}
DI void dsa_write_held(Frame& F, int KB, int lane, int wid, const f32x4v (&held)[16]) {
    const int q = lane & 15, kg = lane >> 4, nitems = 4 * ((KB + 3) >> 2);
    LAS unsigned char* rowp = F.lds + q * DSA_ROW;
#pragma unroll
    for (int it = 0; it < 4; ++it) {
        const int id = wid + 8 * it;
        if (id < nitems) {
            const int g = id >> 2, blk = id & 3;
#pragma unroll
            for (int i = 0; i < 4; ++i) *(LAS f32x4v*)(rowp + (g * 64 + 16 * blk + 4 * kg + i) * 16) = (f32x4v){held[4 * it][i], held[4 * it + 1][i], held[4 * it + 2][i], held[4 * it + 3][i]};
        }
    }
}
template <int CTRL> DI int dpp_mov0(int x) { return __builtin_amdgcn_update_dpp(0, x, CTRL, 0xF, 0xF, false); }
DI int wave_incl_scan(int v, int lane) {
    const int rl = lane & 15;
    int t;
    t = v + dpp_mov0<0x111>(v); if (rl >= 1) v = t;
    t = v + dpp_mov0<0x112>(v); if (rl >= 2) v = t;
    t = v + dpp_mov0<0x114>(v); if (rl >= 4) v = t;
    t = v + dpp_mov0<0x118>(v); if (rl >= 8) v = t;
    t = v + dpp_mov0<0x142>(v); if ((lane & 31) >= 16) v = t;
    t = v + dpp_mov0<0x143>(v); if (lane >= 32) v = t;
    return v;
}
template <int CTRL> DI float dpp_movf(float x) { return __int_as_float(__builtin_amdgcn_update_dpp(0, __float_as_int(x), CTRL, 0xF, 0xF, false)); }
DI float wave_max_nonneg(float v, int lane) {
    v = fmaxf(v, dpp_movf<0x111>(v)); v = fmaxf(v, dpp_movf<0x112>(v)); v = fmaxf(v, dpp_movf<0x114>(v)); v = fmaxf(v, dpp_movf<0x118>(v));
    v = fmaxf(v, dpp_movf<0x142>(v)); v = fmaxf(v, dpp_movf<0x143>(v));
    return __int_as_float(__builtin_amdgcn_readlane(__float_as_int(v), 63));
}
DI void dsa_select3(Frame& F, const int t0q, const int KB, LAS unsigned* hist, LAS u32x4* keysA, LAS u32x4* keysB, LAS u64* mrowA, LAS u64* mrowB, LAS unsigned* rowmax, int lane) {
    SEC_BEGIN(24);
    const int G4 = (KB + 3) >> 2;
    LAS u32x4* keys[2] = {keysA, keysB};
    LAS u64* mrow[2] = {mrowA, mrowB};
    float scl[2];
#pragma unroll
    for (int q = 0; q < 2; ++q) { const float mx = __uint_as_float(rowmax[q]); scl[q] = mx > 0.f ? 8388606.0f / mx : 0.f; }
    { u32x4 z = {0u, 0u, 0u, 0u}; *(LAS u32x4*)(hist + 4 * lane) = z; *(LAS u32x4*)(hist + 320 + 4 * lane) = z; }
    LDS_WAIT();
    if (lane < 2) rowmax[lane] = 0u;
    SEC_END(24);
    SEC_BEGIN(20);
#pragma unroll 2
    for (int g = 0; g < G4; ++g) {
#pragma unroll
        for (int q = 0; q < 2; ++q) {
            u32x4 kk = keys[q][g * 64 + lane];
#pragma unroll
            for (int e = 0; e < 4; ++e) {
                const int i = 4 * g + e;
                const bool adm = 64 * i + lane <= t0q + q;
                const unsigned k = adm ? (unsigned)(__float2int_rn(__uint_as_float(kk[e]) * scl[q]) + 8388608) : 0u;
                kk[e] = k;
                LAS unsigned* dst = hist + 320 * q + (adm ? (k >> 16) : 256u + lane);
                __hip_atomic_fetch_add(dst, 1u, __ATOMIC_RELAXED, __HIP_MEMORY_SCOPE_WORKGROUP);
            }
            keys[q][g * 64 + lane] = kk;
        }
    }
    LDS_WAIT();
    SEC_END(20);
    SEC_BEGIN(21);
    unsigned lo[2], hi[2]; int need[2];
    {
        u32x4 cc[2];
#pragma unroll
        for (int q = 0; q < 2; ++q) cc[q] = *(LAS u32x4*)(hist + 320 * q + 4 * lane);
        LDS_WAIT();
#pragma unroll
        for (int q = 0; q < 2; ++q) {
            const int tot = (int)(cc[q].x + cc[q].y + cc[q].z + cc[q].w);
            const int pre = wave_incl_scan(tot, lane);
            const int total = __builtin_amdgcn_readlane(pre, 63);
            const int suf = total - pre + tot;
            const u64 bal = __ballot(suf >= 256);
            const int L = __popcll(bal) - 1;
            int cum = suf - tot, dsel;
            if (cum + (int)cc[q].w >= 256) dsel = 3;
            else { cum += (int)cc[q].w;
                if (cum + (int)cc[q].z >= 256) dsel = 2;
                else { cum += (int)cc[q].z;
                    if (cum + (int)cc[q].y >= 256) dsel = 1;
                    else { cum += (int)cc[q].y; dsel = 0; } } }
            const unsigned dig = (unsigned)__builtin_amdgcn_readlane(4 * lane + dsel, L);
            need[q] = 256 - __builtin_amdgcn_readlane(cum, L);
            lo[q] = dig == 0u ? 1u : (dig << 16); hi[q] = (dig + 1u) << 16;
        }
    }
    SEC_END(21);
    SEC_BEGIN(22);
    unsigned mlo[2] = {0u, 0u}, mhi[2] = {0u, 0u}; int ncand[2] = {0, 0};
#pragma unroll 2
    for (int g = 0; g < G4; ++g) {
#pragma unroll
        for (int q = 0; q < 2; ++q) {
            const u32x4 kk = keys[q][g * 64 + lane];
#pragma unroll
            for (int e = 0; e < 4; ++e) {
                const int i = 4 * g + e;
                const unsigned k = kk[e];
                const bool gt = k >= hi[q], eq = !gt && k >= lo[q];
                const u64 bgt = __ballot(gt), beq = __ballot(eq);
                if (lane == i) { mlo[q] = (unsigned)bgt; mhi[q] = (unsigned)(bgt >> 32); }
                if (beq != 0ull) {
                    if (eq) {
                        const int pos = ncand[q] + (int)__builtin_amdgcn_mbcnt_hi((unsigned)(beq >> 32), __builtin_amdgcn_mbcnt_lo((unsigned)beq, 0u));
                        ((LAS unsigned*)keys[q])[pos] = (((k & 0xFFFFu) << 11) | (unsigned)(2047 - (64 * i + lane))) + 1u;
                    }
                    ncand[q] += __popcll(beq);
                }
            }
        }
    }
#pragma unroll
    for (int q = 0; q < 2; ++q) if (lane < KB) mrow[q][lane] = ((u64)mhi[q] << 32) | (u64)mlo[q];
    LDS_WAIT();
    SEC_END(22);
    SEC_BEGIN(23);
#pragma unroll
    for (int q = 0; q < 2; ++q) {
        LAS unsigned* list = (LAS unsigned*)keys[q];
        const int n = ncand[q];
        unsigned x = 1u;
        if (need[q] < n) {
            x = 0u;
            if (n <= 64) {
                const unsigned c = lane < n ? list[lane] : 0u;
#pragma unroll 1
                for (int b = 27; b >= 0; --b) { const unsigned trial = x | (1u << b); if (__popcll(__ballot(c >= trial)) >= need[q]) x = trial; }
            } else if (n <= 256) {
                unsigned c[4];
#pragma unroll
                for (int j = 0; j < 4; ++j) c[j] = 64 * j + lane < n ? list[64 * j + lane] : 0u;
#pragma unroll 1
                for (int b = 27; b >= 0; --b) { const unsigned trial = x | (1u << b);
                    const int cnt = (__popcll(__ballot(c[0] >= trial)) + __popcll(__ballot(c[1] >= trial))) + (__popcll(__ballot(c[2] >= trial)) + __popcll(__ballot(c[3] >= trial)));
                    if (cnt >= need[q]) x = trial; }
            } else {
#pragma unroll 1
                for (int b = 27; b >= 0; --b) { const unsigned trial = x | (1u << b); int cnt = 0;
                    for (int base = 0; base < n; base += 64) { const unsigned c = base + lane < n ? list[base + lane] : 0u; cnt += __popcll(__ballot(c >= trial)); }
                    if (cnt >= need[q]) x = trial; }
            }
        }
        for (int base = 0; base < n; base += 64) {
            const unsigned c = base + lane < n ? list[base + lane] : 0u;
            if (c >= x) { const unsigned pos = 2047u - ((c - 1u) & 2047u);
                __hip_atomic_fetch_or((LAS unsigned*)mrow[q] + (pos >> 5), 1u << (pos & 31u), __ATOMIC_RELAXED, __HIP_MEMORY_SCOPE_WORKGROUP); }
        }
    }
    SEC_END(23);
}
DI void dsa_unit(Frame& F, int b, int qb32) {
    const int tid = launder(F.tid), lane = tid & 63, r32 = lane & 31, hi = lane >> 5, wid = F.wave;
    const int t0 = 32 * qb32, KB = (qb32 >> 1) + 1;
    const LaneAddr la = lane_addr(lane);
    LAS u64* MB = (LAS u64*)(F.lds + DSA_MB); LAS unsigned* HIST = (LAS unsigned*)(F.lds + DSA_HIST) + wid * 640;
    LAS unsigned* RMAX = (LAS unsigned*)(F.lds + DSA_RMAX);
    const bf16* P0 = WSP(bf16, WS_P);
    const size_t rowg = (size_t)b * T + t0 + r32;
    bf16x8 qr[4];
#pragma unroll
    for (int st = 0; st < 4; ++st) qr[st] = *(const bf16x8*)(WSP(bf16, WS_P) + rowg * PP + (HB_QD + wid) * 64 + 16 * st + 8 * hi);
    SEC_BEGIN(4);
    if (t0 + 31 < 256) {
        for (int qq = 0; qq < 4; ++qq) { const int qi = wid * 4 + qq, t = t0 + qi;
            for (int i = 0; i < KB; ++i) { const u64 bm = __ballot(64 * i + lane <= t); if (lane == 0) MB[qi * 33 + i] = bm; } }
    } else {
        f32x4v held[16];
        { SEC_BEGIN(6); dsa_scores32(F, P0, (size_t)b * T + t0, KB, lane, wid, held, RMAX); LDS_WAIT(); SEC_END(6); }
#pragma unroll 1
        for (int rnd = 0; rnd < 2; ++rnd) {
            if (rnd == 1) { dsa_write_held(F, KB, lane, wid, held); LDS_WAIT(); }
            __syncthreads();
            SEC_BEGIN(7);
            {
                const int ql = 2 * wid, qi = 16 * rnd + ql;
                dsa_select3(F, t0 + qi, KB, HIST, (LAS u32x4*)(F.lds + ql * DSA_ROW), (LAS u32x4*)(F.lds + (ql + 1) * DSA_ROW), MB + qi * 33, MB + (qi + 1) * 33, RMAX + qi, lane);
            }
            LDS_WAIT(); SEC_END(7);
            __syncthreads();
        }
    }
    __syncthreads();
    SEC_END(4);
    SEC_BEGIN(5);
    f32x16 o[2];
#pragma unroll
    for (int i = 0; i < 16; ++i) { o[0][i] = 0.f; o[1][i] = 0.f; }
    float m_run = 0.f, l_run = 0.f;
    const bf16* Pb = WSP(bf16, WS_P) + (size_t)b * T * PP;
    const unsigned tmask = KB >= 32 ? ~0u : ((1u << KB) - 1u);
    DsaMask mf{MB + r32 * 33};
    run_tiles<true, false>(F, tmask, Pb + HB_KD * 64, Pb + HB_VD * 64, qr, o, m_run, l_run, mf, la, tid);
    const float l = l_run;
    const float sc = l > 0.f ? 1.0f / l : 0.f;
    unsigned char* orow = WSP(unsigned char, WS_XN) + rowg * D + 512 + wid * 64;
    const float sc64 = sc * 64.0f;
#pragma unroll
    for (int db = 0; db < 2; ++db)
#pragma unroll
        for (int u = 0; u < 4; u += 2) store_pair8(orow + 32 * db + 8 * u, pk4_f8((f32x4){o[db][4 * u], o[db][4 * u + 1], o[db][4 * u + 2], o[db][4 * u + 3]} * sc64),
                                                   pk4_f8((f32x4){o[db][4 * u + 4], o[db][4 * u + 5], o[db][4 * u + 6], o[db][4 * u + 7]} * sc64), hi);
    SEC_END(5);
}
DI void phase_a1(Frame& F) {
    unsigned* ctr = WSP(unsigned, WS_CTL) + 512;
    if (F.tid < 32) ((LAS unsigned*)(F.lds + DSA_RMAX))[F.tid] = 0u;
    for (;;) {
        SEC_BEGIN(15);
        const int r = q_next(F, ctr, 32 + 256);
        SEC_END(15);
        if (r < 0) break;
        const int x = r >> 16, it = r & 65535;
        if (it < 32) { SEC_BEGIN(14); compress_item(F, (it & 7) + 8 * (x + 8 * (it >> 3))); SEC_END(14); }
        else { SEC_BEGIN(13); const int u = it - 32; dsa_unit(F, x + 8 * (u & 3), 63 - (u >> 2)); SEC_END(13); }
    }
}
DI void phase_a2(Frame& F) {
    unsigned* ctr = WSP(unsigned, WS_CTL) + 1024;
    for (;;) {
        const int r = q_next(F, ctr, 256);
        if (r < 0) break;
        const int x = r >> 16, it = r & 65535;
        const int pair = x + 8 * (it & 7);
        nsa_unit(F, pair >> 1, pair & 1, 31 - (it >> 3));
    }
}

#define XB_TMO      128
#define XB_XCNT(j)  (256  + 64 * (j))
#define XB_XSUB(j)  (1280 + 64 * (j))
#define XB_XGEN(j)  (2304 + 64 * (j))
#define XB_TOP      3328
#define XB_TOPGEN   3392
#define XCD_BAR_WORDS 3456
#define XB_SPIN_CAP (1u << 18)

__device__ __forceinline__ unsigned xb_ld(unsigned* p)              { return __hip_atomic_load(p, __ATOMIC_RELAXED, __HIP_MEMORY_SCOPE_AGENT); }
__device__ __forceinline__ unsigned xb_add(unsigned* p, unsigned v) { return __hip_atomic_fetch_add(p, v, __ATOMIC_RELAXED, __HIP_MEMORY_SCOPE_AGENT); }
__device__ __forceinline__ unsigned xb_xcc_id() { return (unsigned)__builtin_amdgcn_s_getreg((3 << 11) | 20) & 0xFu; }
#define XB_SPIN(cond, bar) do { unsigned _sp = 0; while (cond) { __builtin_amdgcn_s_sleep(1); \
    if ((++_sp & 255u) == 0u) { if (xb_ld(&(bar)[XB_TMO])) break; if (_sp > XB_SPIN_CAP) { atomicAdd(&(bar)[XB_TMO], 1u); break; } } } } while (0)

struct XcdBarrier {
    unsigned* bar; unsigned x;
    volatile LAS unsigned* st;
};

__device__ __forceinline__ XcdBarrier xcd_barrier_post(unsigned* bar, volatile LAS unsigned* st) {
    XcdBarrier b; b.bar = bar; b.x = xb_xcc_id(); b.st = st;
    if (threadIdx.x == 0) (void)xb_add(&bar[XB_XCNT(b.x)], 1u);
    return b;
}
__device__ __forceinline__ void xcd_barrier_complete(unsigned* bar, unsigned x, unsigned& nloc, unsigned& nx) {
    const unsigned G = gridDim.x * gridDim.y * gridDim.z;
    unsigned sum, cnt, mine, sp = 0u;
    for (;;) {
        sum = 0u; cnt = 0u; mine = 0u;
#pragma unroll
        for (unsigned j = 0; j < 16; ++j) { const unsigned c = xb_ld(&bar[XB_XCNT(j)]); sum += c; cnt += (c > 0u) ? 1u : 0u; mine = (j == x) ? c : mine; }
        if (sum == G) break;
        __builtin_amdgcn_s_sleep(1);
        if ((++sp & 255u) == 0u) { if (xb_ld(&bar[XB_TMO])) break; if (sp > XB_SPIN_CAP) { atomicAdd(&bar[XB_TMO], 1u); break; } }
    }
    nloc = mine > 0u ? mine : 1u; nx = cnt > 0u ? cnt : 1u;
}

__device__ __forceinline__ void xcd_barrier(const XcdBarrier& b) {
    asm volatile("s_waitcnt vmcnt(0)" ::: "memory");
    __syncthreads();
    if (threadIdx.x == 0) {
        unsigned* bar = b.bar;
        __builtin_amdgcn_s_waitcnt(0);
        unsigned nloc = b.st[0], nx = b.st[1];
        if (nloc == 0u) { xcd_barrier_complete(bar, b.x, nloc, nx); b.st[0] = nloc; b.st[1] = nx; }
        const unsigned old = xb_add(&bar[XB_XSUB(b.x)], 1u);
        const unsigned gen = old / nloc;
        if (old + 1u == (gen + 1u) * nloc) {
            __builtin_amdgcn_fence(__ATOMIC_RELEASE, "agent");
            asm volatile("s_waitcnt vmcnt(0)" ::: "memory");
            const unsigned og = xb_add(&bar[XB_TOP], 1u);
            const unsigned tg = og / nx;
            if (og + 1u == (tg + 1u) * nx) xb_add(&bar[XB_TOPGEN], 1u);
            else XB_SPIN(xb_ld(&bar[XB_TOPGEN]) == tg, bar);
            __builtin_amdgcn_fence(__ATOMIC_ACQUIRE, "agent");
            xb_add(&bar[XB_XGEN(b.x)], 1u);
            asm volatile("s_waitcnt vmcnt(0)" ::: "memory");
        } else {
            XB_SPIN(xb_ld(&bar[XB_XGEN(b.x)]) == gen, bar);
            __builtin_amdgcn_fence(__ATOMIC_ACQUIRE, "agent");
            asm volatile("s_waitcnt vmcnt(0)" ::: "memory");
        }
    }
    __syncthreads();
}


constexpr int CW_BAR = 4096;
constexpr int N_PHASES = 10;
#ifndef PHASE_MASK
#define PHASE_MASK 0x3FF
#endif
#ifndef PROBE_LO
#define PROBE_LO -1
#endif
#ifndef PROBE_HI
#define PROBE_HI -1
#endif
#ifndef MK_COOP
#define MK_COOP 1
#endif

__global__ void __launch_bounds__(NTHR, 2) mega_fwd(Args args) {
    extern __shared__ __attribute__((aligned(16))) unsigned char lds_raw[];
    Frame F;
    F.lds = (LAS unsigned char*)lds_raw;
    F.MISC = (volatile LAS unsigned*)(F.lds + MISC_OFF);
    F.tid = threadIdx.x; F.lane = F.tid & 63; F.wave = __builtin_amdgcn_readfirstlane(F.tid >> 6);
    F.G = gridDim.x; F.bid = blockIdx.x; F.pacc = 0ull;
    if (F.tid < 32) F.MISC[F.tid] = 0u;
    __syncthreads();
    F.ws = args.ws;
    const Args& A = args;
    bf16* OPROJ = WSP(bf16, WS_P); bf16* Y = WSP(bf16, WS_P);

    const int lo = args.ph_lo, hi = args.ph_hi;
    XcdBarrier xbar; xbar.bar = WSP(unsigned, WS_CTL) + CW_BAR; xbar.x = 0; xbar.st = nullptr;
    if (args.coop) {
        unsigned* ctl = WSP(unsigned, WS_CTL);
        for (int i = F.bid * NTHR + F.tid; i < (int)(CTL_ZERO_BYTES / 4); i += F.G * NTHR) ctl[i] = 0u;
    }
#define IN(k) (lo <= (k) && (k) < hi)
    unsigned long long pr_a = 0ull, pr_b = 0ull;
#define SEAM(k) do { if (IN(k) && IN((k) + 1)) { if (args.coop) { if ((k) == 0) cg::this_grid().sync(); else xcd_barrier(xbar); } } \
        if (PROBE_LO == (k) + 1) pr_a = __builtin_amdgcn_s_memrealtime(); if (PROBE_HI == (k)) pr_b = __builtin_amdgcn_s_memrealtime(); } while (0)
    if (PROBE_LO == 0) pr_a = __builtin_amdgcn_s_memrealtime();

    if (((PHASE_MASK >> 0) & 1) && IN(0)) { phase_p0(F, A); }
    SEAM(0);
    if (args.coop) xbar = xcd_barrier_post(WSP(unsigned, WS_CTL) + CW_BAR, F.MISC + 8);
    if (((PHASE_MASK >> 1) & 1) && IN(1)) { phase_e0(F, A); }
    SEAM(1);
    if (((PHASE_MASK >> 2) & 1) && IN(2)) {
        pg8::Gemm g{WSP(bf16, WS_XN), WSP(bf16, WS_WIN), M, NPROJ, D}; pg8::StaticOrder S; S.init(M, NPROJ, F.G, F.bid);
        pg8::EpiProj E{WSP(bf16, WS_P), WSP(float, WS_MISC), WSP(float, WS_CS)};
        pg8::gemm_phase<pg8::EpiProj, pg8::StaticOrder, true, true>(F.lds, g, S, E);
    }
    SEAM(2);
    if (((PHASE_MASK >> 3) & 1) && IN(3)) { phase_a1(F); }
    SEAM(3);
    if (((PHASE_MASK >> 4) & 1) && IN(4)) { phase_a2(F); }
    SEAM(4);
    if (((PHASE_MASK >> 5) & 1) && IN(5)) {
        pg8::Gemm g{WSP(bf16, WS_XN), WSP(bf16, WS_WOUT), M, D, D / 2}; pg8::StaticOrder S; S.init(M, D, F.G, F.bid);
        pg8::EpiStoreScaled E{OPROJ, D, 1.0f / 8192.0f};
        pg8::gemm_phase_f8<pg8::EpiStoreScaled, pg8::StaticOrder, true, true>(F.lds, g, S, E);
    }
    SEAM(5);
    if (((PHASE_MASK >> 6) & 1) && IN(6)) { phase_e1(F, A, OPROJ); }
    SEAM(6);
    if (((PHASE_MASK >> 7) & 1) && IN(7)) {
        pg8::Gemm g{WSP(bf16, WS_XN), WSP(bf16, WS_WUP), M, FF, D / 2}; pg8::StaticOrder S; S.init(M, FF, F.G, F.bid);
        pg8::EpiStoreF8 E{WSP(unsigned char, WS_SC), FF, 4.0f / (4096.0f * 4096.0f)};
        pg8::gemm_phase_f8<pg8::EpiStoreF8, pg8::StaticOrder, true, true>(F.lds, g, S, E);
    }
    SEAM(7);
    if (((PHASE_MASK >> 8) & 1) && IN(8)) {
        pg8::Gemm g{WSP(bf16, WS_SC), WSP(bf16, WS_WDOWN), M, D, FF / 2}; pg8::StaticOrder S; S.init(M, D, F.G, F.bid); S.rev = 1;
        pg8::EpiStoreScaled E{Y, D, 1.0f / 1024.0f};
        pg8::gemm_phase_f8<pg8::EpiStoreScaled, pg8::StaticOrder, true, true>(F.lds, g, S, E);
    }
    SEAM(8);
    if (((PHASE_MASK >> 9) & 1) && IN(9)) { phase_e2(F, A, Y); }
    if (PROBE_HI == 9) { __syncthreads(); pr_b = __builtin_amdgcn_s_memrealtime(); }
    if ((PROBE_LO >= 0 || PROBE_SEC > 0) && F.bid == 0 && F.tid == 0) {
        const unsigned long long t0 = __builtin_amdgcn_s_memrealtime(), span = PROBE_SEC > 0 ? F.pacc : pr_b - pr_a;
        while (__builtin_amdgcn_s_memrealtime() - t0 < span) __builtin_amdgcn_s_sleep(32);
    }
#undef IN
#undef SEAM
}

extern "C" void kernel_launch(void* const* d_in, const int* in_sizes, int n_in, void* d_out, int out_size, void* d_ws, size_t ws_size, hipStream_t stream) {
    static int grid = 0;
    if (grid == 0) {
        if (n_in != 19 || in_sizes[0] != M * D || out_size != M * D || ws_size < WS_END) {
            fprintf(stderr, "kernel_launch: unexpected shapes: n_in %d in0 %d out %d ws %zu (need %zu)\n", n_in, n_in > 0 ? in_sizes[0] : -1, out_size, ws_size, (size_t)WS_END); grid = -1; return; }
        int dev = 0, cus = 0, per_cu = 0;
        if (hipGetDevice(&dev) != hipSuccess || hipDeviceGetAttribute(&cus, hipDeviceAttributeMultiprocessorCount, dev) != hipSuccess) { fprintf(stderr, "kernel_launch: device query failed\n"); grid = -1; return; }
        if (hipFuncSetAttribute((const void*)mega_fwd, hipFuncAttributeMaxDynamicSharedMemorySize, LDS_BYTES) != hipSuccess) { fprintf(stderr, "kernel_launch: hipFuncSetAttribute failed\n"); grid = -1; return; }
        if (hipOccupancyMaxActiveBlocksPerMultiprocessor(&per_cu, (const void*)mega_fwd, NTHR, LDS_BYTES) != hipSuccess || per_cu < 1) { fprintf(stderr, "kernel_launch: occupancy query says %d\n", per_cu); per_cu = 1; }
        (void)hipGetLastError();
        grid = cus;
        fprintf(stderr, "kernel_launch: cus %d per_cu %d grid %d\n", cus, per_cu, grid);
    }
    if (grid < 0) return;
#if !MK_COOP
    if (hipMemsetAsync((char*)d_ws + WS_CTL, 0, CTL_ZERO_BYTES, stream) != hipSuccess) { fprintf(stderr, "kernel_launch: memset failed\n"); return; }
#endif
    Args a{};
    for (int i = 0; i < 19; ++i) a.in[i] = d_in[i];
    a.out = (float*)d_out; a.ws = (unsigned char*)d_ws;
#if MK_COOP
    a.ph_lo = 0; a.ph_hi = N_PHASES; a.coop = 1;
    void* kargs[] = {&a};
    hipError_t e = hipLaunchCooperativeKernel((const void*)mega_fwd, dim3(grid), dim3(NTHR), kargs, LDS_BYTES, stream);
    if (e != hipSuccess) fprintf(stderr, "kernel_launch: cooperative launch failed: %s (grid %d)\n", hipGetErrorString(e), grid);
#else
    for (int ph = 0; ph < N_PHASES; ++ph) {
        a.ph_lo = ph; a.ph_hi = ph + 1; a.coop = 0;
        hipLaunchKernelGGL(mega_fwd, dim3(grid), dim3(NTHR), LDS_BYTES, stream, a);
        const hipError_t le = hipPeekAtLastError();
        if (le != hipSuccess) { fprintf(stderr, "kernel_launch: launch %d failed: %s\n", ph, hipGetErrorName(le)); break; }
    }
#endif
}
```
